# Optimizing an MI355X kernel written in HIP

```python
import math
import jax, jax.numpy as jnp
from jax import lax
import numpy as np

D_MODEL = 1024
BATCH = 4
SEQ = 4096
DEPTH = 1

DA_HEADS = 4
DA_QK_DIM = 64
DA_V_DIM = 2 * DA_QK_DIM
DA_WIDTH = DA_HEADS * DA_V_DIM
DA_QK_COLS = DA_HEADS * 2 * DA_QK_DIM
DA_QBLOCK = 128
ML_HEADS = 4
ML_HEAD_DIM = 128
ML_WIDTH = ML_HEADS * ML_HEAD_DIM
ML_CHUNK = 64
ML_CONV = 4
MIX_WIDTH = DA_WIDTH + ML_WIDTH
IN_SIZES = (DA_QK_COLS, DA_QK_COLS, DA_WIDTH, ML_WIDTH, ML_WIDTH, ML_WIDTH, ML_WIDTH, ML_HEADS, ML_HEADS)
IN_COLS = DA_QK_COLS * 2 + DA_WIDTH + ML_WIDTH * 4 + ML_HEADS * 2
PEER_HEADS = 8
PEER_NKEYS = 128
PEER_EXPERTS = PEER_NKEYS * PEER_NKEYS
PEER_KEY_DIM = 256
PEER_HALF = PEER_KEY_DIM // 2
PEER_TOPK = 16
PEER_BLOCK = 128

NORM_EPS = 1e-6
SUBLN_EPS = 1e-5
NEG_INF = -1e30

kernel_name = 'hybrid_diffattn_mlstm_peer'


def _rmsnorm(x, g, eps=NORM_EPS):
    xf = x.astype(jnp.float32)
    y = xf * lax.rsqrt(jnp.mean(xf * xf, axis=-1, keepdims=True) + eps)
    return (y * g.astype(jnp.float32)).astype(x.dtype)


def _alibi_slopes(n):
    start = 2.0 ** (-8.0 / n)
    return jnp.asarray(np.array([start ** (h + 1) for h in range(n)], dtype=np.float32))


def _causal_dwconv(u, w, b):
    c = u.shape[-1]
    y = lax.conv_general_dilated(u, w[:, None, :].astype(u.dtype), window_strides=(1,),
                                 padding=[(w.shape[0] - 1, 0)],
                                 dimension_numbers=('NWC', 'WIO', 'NWC'),
                                 feature_group_count=c)
    return y + b.astype(u.dtype)


def _diff_attention(q, k, v, lam):
    bsz, seq = q.shape[0], q.shape[1]
    nb = seq // DA_QBLOCK
    scale = DA_QK_DIM ** -0.5
    qh = q.transpose(0, 2, 3, 1, 4)
    kh = k.transpose(0, 2, 3, 1, 4)
    vh = v.transpose(0, 2, 1, 3)
    qb = qh.reshape(bsz, DA_HEADS, 2, nb, DA_QBLOCK, DA_QK_DIM).transpose(3, 0, 1, 2, 4, 5)
    slopes = _alibi_slopes(DA_HEADS)
    kpos = jnp.arange(seq, dtype=jnp.int32)

    def block(args):
        qblk, start = args
        dist = (start + jnp.arange(DA_QBLOCK, dtype=jnp.int32))[:, None] - kpos[None, :]
        s = jnp.einsum('bhcqd,bhckd->bhcqk', qblk, kh).astype(jnp.float32) * scale
        s = s - (slopes[:, None, None] * dist.astype(jnp.float32))[None, :, None]
        s = jnp.where(dist >= 0, s, NEG_INF)
        p = jax.nn.softmax(s, axis=-1)
        a = p[:, :, 0] - lam * p[:, :, 1]
        return jnp.einsum('bhqk,bhkd->bhqd', a.astype(vh.dtype), vh)

    out = lax.map(block, (qb, jnp.arange(nb, dtype=jnp.int32) * DA_QBLOCK))
    return out.transpose(1, 0, 3, 2, 4).reshape(bsz, seq, DA_HEADS, DA_V_DIM)


def _mlstm(q, k, v, i_pre, f_pre):
    f32 = jnp.float32
    bsz, seq = q.shape[0], q.shape[1]
    L = ML_CHUNK
    nc = seq // L

    def chunk_vec(t):
        return t.astype(f32).reshape(bsz, nc, L, ML_HEADS, ML_HEAD_DIM).transpose(1, 0, 3, 2, 4)

    def chunk_gate(t):
        return t.astype(f32).reshape(bsz, nc, L, ML_HEADS).transpose(1, 0, 3, 2)

    qc = chunk_vec(q)
    kc = chunk_vec(k) * (ML_HEAD_DIM ** -0.5)
    vc = chunk_vec(v)
    ic = chunk_gate(i_pre)
    fc = chunk_gate(jax.nn.log_sigmoid(f_pre.astype(f32)))
    tri = jnp.tril(jnp.ones((L, L), dtype=bool))

    def step(carry, xs):
        C, n, m = carry
        qt, kt, vt, it, ft = xs
        b = jnp.cumsum(ft, axis=-1)
        D = jnp.where(tri, b[..., :, None] - b[..., None, :] + it[..., None, :], NEG_INF)
        inter = b + m[..., None]
        mt = jnp.maximum(inter, jnp.max(D, axis=-1))
        w_intra = jnp.exp(D - mt[..., None])
        w_inter = jnp.exp(inter - mt)
        s = jnp.einsum('bhtd,bhsd->bhts', qt, kt) * w_intra
        num = w_inter[..., None] * jnp.einsum('bhtd,bhdv->bhtv', qt, C) + jnp.einsum('bhts,bhsv->bhtv', s, vt)
        den = w_inter * jnp.einsum('bhtd,bhd->bht', qt, n) + jnp.sum(s, axis=-1)
        h = num / jnp.maximum(jnp.abs(den), jnp.exp(-mt))[..., None]
        m_new = mt[..., -1]
        ws = jnp.exp(b[..., -1:] - b + it - m_new[..., None])
        decay = jnp.exp(b[..., -1] + m - m_new)
        C = decay[..., None, None] * C + jnp.einsum('bhs,bhsd,bhsv->bhdv', ws, kt, vt)
        n = decay[..., None] * n + jnp.einsum('bhs,bhsd->bhd', ws, kt)
        return (C, n, m_new), h

    c0 = jnp.zeros((bsz, ML_HEADS, ML_HEAD_DIM, ML_HEAD_DIM), f32)
    n0 = jnp.zeros((bsz, ML_HEADS, ML_HEAD_DIM), f32)
    m0 = jnp.full((bsz, ML_HEADS), NEG_INF, f32)
    _, h = lax.scan(step, (c0, n0, m0), (qc, kc, vc, ic, fc))
    return h.transpose(1, 0, 3, 2, 4).reshape(bsz, seq, ML_HEADS, ML_HEAD_DIM)


def _peer(xn, w_pq, sub_keys, u_emb, v_emb):
    bsz, seq, d = xn.shape
    t = bsz * seq
    xt = xn.reshape(t, d)
    q = (xt @ w_pq).reshape(t, PEER_HEADS, 2, PEER_HALF)
    scores = jnp.einsum('thcd,hcnd->thcn', q, sub_keys).astype(jnp.float32)
    s1, i1 = lax.top_k(scores[:, :, 0], PEER_TOPK)
    s2, i2 = lax.top_k(scores[:, :, 1], PEER_TOPK)
    kk = PEER_TOPK * PEER_TOPK
    cand_s = (s1[..., :, None] + s2[..., None, :]).reshape(t, PEER_HEADS, kk)
    cand_i = (i1[..., :, None] * PEER_NKEYS + i2[..., None, :]).reshape(t, PEER_HEADS, kk)
    top_s, pos = lax.top_k(cand_s, PEER_TOPK)
    eidx = jnp.take_along_axis(cand_i, pos, axis=-1)
    gate = jax.nn.softmax(top_s, axis=-1).astype(xn.dtype)
    nb = t // PEER_BLOCK

    def block(args):
        xb, eb, gb = args
        act = jax.nn.gelu(jnp.einsum('thkd,td->thk', u_emb[eb], xb), approximate=False)
        return jnp.einsum('thk,thkd->td', gb * act, v_emb[eb])

    out = lax.map(block, (xt.reshape(nb, PEER_BLOCK, d),
                          eidx.reshape(nb, PEER_BLOCK, PEER_HEADS, PEER_TOPK),
                          gate.reshape(nb, PEER_BLOCK, PEER_HEADS, PEER_TOPK)))
    return out.reshape(bsz, seq, d)


def setup_inputs(seed: int = 0) -> dict:
    key = jax.random.key(seed)
    ks = jax.random.split(key, 20)
    nrm = jax.random.normal
    f32 = jnp.float32
    x = nrm(ks[0], (BATCH, SEQ, D_MODEL), f32)
    norm1_g = 1.0 + 0.01 * nrm(ks[1], (DEPTH, D_MODEL), f32)
    w_in = nrm(ks[2], (DEPTH, D_MODEL, IN_COLS), f32) * D_MODEL ** -0.5
    conv_w = nrm(ks[3], (DEPTH, ML_CONV, 2 * ML_WIDTH), f32) * ML_CONV ** -0.5
    conv_b = 0.01 * nrm(ks[4], (DEPTH, 2 * ML_WIDTH), f32)
    b_igate = 0.1 * nrm(ks[5], (DEPTH, ML_HEADS), f32)
    b_fgate = jnp.linspace(3.0, 6.0, ML_HEADS, dtype=f32)[None, :] + 0.01 * nrm(ks[6], (DEPTH, ML_HEADS), f32)
    lam_q1 = 0.1 * nrm(ks[7], (DEPTH, DA_QK_DIM), f32)
    lam_k1 = 0.1 * nrm(ks[8], (DEPTH, DA_QK_DIM), f32)
    lam_q2 = 0.1 * nrm(ks[9], (DEPTH, DA_QK_DIM), f32)
    lam_k2 = 0.1 * nrm(ks[10], (DEPTH, DA_QK_DIM), f32)
    da_subln_g = 1.0 + 0.01 * nrm(ks[11], (DEPTH, DA_V_DIM), f32)
    ml_norm_g = 1.0 + 0.01 * nrm(ks[12], (DEPTH, ML_WIDTH), f32)
    w_out = nrm(ks[13], (DEPTH, MIX_WIDTH, D_MODEL), f32) * MIX_WIDTH ** -0.5
    norm2_g = 1.0 + 0.01 * nrm(ks[14], (DEPTH, D_MODEL), f32)
    w_pq = nrm(ks[15], (DEPTH, D_MODEL, PEER_HEADS * PEER_KEY_DIM), f32) * D_MODEL ** -0.5
    sub_keys = nrm(ks[16], (DEPTH, PEER_HEADS, 2, PEER_NKEYS, PEER_HALF), f32) * PEER_HALF ** -0.5
    u_emb = nrm(ks[17], (DEPTH, PEER_EXPERTS, D_MODEL), f32) * D_MODEL ** -0.5
    v_emb = nrm(ks[18], (DEPTH, PEER_EXPERTS, D_MODEL), f32) * PEER_HEADS ** -0.5
    final_g = 1.0 + 0.01 * nrm(ks[19], (D_MODEL,), f32)
    return {'x': x, 'norm1_g': norm1_g, 'w_in': w_in, 'conv_w': conv_w, 'conv_b': conv_b,
            'b_igate': b_igate, 'b_fgate': b_fgate, 'lam_q1': lam_q1, 'lam_k1': lam_k1,
            'lam_q2': lam_q2, 'lam_k2': lam_k2, 'da_subln_g': da_subln_g, 'ml_norm_g': ml_norm_g,
            'w_out': w_out, 'norm2_g': norm2_g, 'w_pq': w_pq, 'sub_keys': sub_keys,
            'u_emb': u_emb, 'v_emb': v_emb, 'final_g': final_g}


def reference(x, norm1_g, w_in, conv_w, conv_b, b_igate, b_fgate, lam_q1, lam_k1, lam_q2, lam_k2,
              da_subln_g, ml_norm_g, w_out, norm2_g, w_pq, sub_keys, u_emb, v_emb, final_g):
    bsz, seq = x.shape[0], x.shape[1]
    split_at = np.cumsum(np.array(IN_SIZES))[:-1].tolist()
    for l in range(DEPTH):
        lam_init = 0.8 - 0.6 * math.exp(-0.3 * l)
        h = _rmsnorm(x, norm1_g[l])
        proj = h @ w_in[l]
        da_q, da_k, da_v, ml_q, ml_k, ml_v, ml_o, ml_i, ml_f = jnp.split(proj, split_at, axis=-1)
        lam = (jnp.exp(jnp.sum(lam_q1[l] * lam_k1[l]).astype(jnp.float32))
               - jnp.exp(jnp.sum(lam_q2[l] * lam_k2[l]).astype(jnp.float32)) + lam_init)
        a = _diff_attention(da_q.reshape(bsz, seq, DA_HEADS, 2, DA_QK_DIM),
                            da_k.reshape(bsz, seq, DA_HEADS, 2, DA_QK_DIM),
                            da_v.reshape(bsz, seq, DA_HEADS, DA_V_DIM), lam)
        a = (_rmsnorm(a, da_subln_g[l], SUBLN_EPS) * (1.0 - lam_init)).reshape(bsz, seq, DA_WIDTH)
        qk = jax.nn.silu(_causal_dwconv(jnp.concatenate([ml_q, ml_k], axis=-1), conv_w[l], conv_b[l]))
        mq, mk = jnp.split(qk, 2, axis=-1)
        hm = _mlstm(mq.reshape(bsz, seq, ML_HEADS, ML_HEAD_DIM),
                    mk.reshape(bsz, seq, ML_HEADS, ML_HEAD_DIM),
                    ml_v.reshape(bsz, seq, ML_HEADS, ML_HEAD_DIM),
                    ml_i + b_igate[l], ml_f + b_fgate[l]).astype(x.dtype)
        hm = _rmsnorm(hm, ml_norm_g[l].reshape(ML_HEADS, ML_HEAD_DIM))
        hm = (hm * jax.nn.sigmoid(ml_o).reshape(bsz, seq, ML_HEADS, ML_HEAD_DIM)).reshape(bsz, seq, ML_WIDTH)
        x = x + jnp.concatenate([a, hm], axis=-1) @ w_out[l]
        x = x + _peer(_rmsnorm(x, norm2_g[l]), w_pq[l], sub_keys[l], u_emb[l], v_emb[l])
    return _rmsnorm(x, final_g)
```

```cpp
#define MK_N_LAUNCHES 1
#include <hip/hip_runtime.h>
#include <cstdio>
#include <cstdint>
namespace pg8 {
#define PG8_LAS __attribute__((address_space(3)))
typedef unsigned short bf16_t;
typedef short bf16x8 __attribute__((ext_vector_type(8)));
typedef float f32x4 __attribute__((ext_vector_type(4)));
typedef unsigned u32x4 __attribute__((ext_vector_type(4)));
constexpr int BM = 256, BK = 64, HALF = 128, HTB = HALF * BK * 2  , STAGE_BYTES = 8 * HTB, NXCD = 8, WGM = 8;

__host__ __device__ __forceinline__ int lds_byte(int r, int c) { const int st = (r >> 4) * 2 + (c >> 5), rr = r & 15, cc = c & 31, ob = rr * 64 + cc * 2; return st * 1024 + (ob ^ (((ob >> 9) & 1) << 5)); }
__host__ __device__ __forceinline__ void stage_rc(int b, int& R, int& C) { const int st = b / 1024, sb = b % 1024, swz = sb ^ (((sb >> 9) & 1) << 5); R = (st >> 1) * 16 + swz / 64; C = (st & 1) * 32 + (swz % 64) / 2; }
__host__ __device__ __forceinline__ int perm32(int rho) { const int n = rho >> 4, i = rho & 15; return 8 * (i >> 2) + 4 * n + (i & 3); }

struct Unit { int pm, pn; };
struct Gemm { const bf16_t* A; const bf16_t* Bt; int M, N, K; };

struct StaticOrder {
    int nM, nN, nwg, G, c;
    __host__ __device__ void init(int M, int N, int G_, int c_) { nM = M / BM; nN = N / BM; nwg = nM * nN; G = G_; c = c_; }
    __host__ __device__ bool next(int i, Unit& u) const {
        const long L = (long)i * G + c; if (L >= nwg) return false;
        int wgid = (int)L; { const int q = nwg / NXCD, r = nwg % NXCD, xcd = wgid % NXCD, off = wgid / NXCD; wgid = (xcd < r ? xcd * (q + 1) : r * (q + 1) + (xcd - r) * q) + off; }
        const int nig = WGM * nN, gid = wgid / nig, fm = gid * WGM, gsz = (nM - fm) < WGM ? (nM - fm) : WGM;
        u.pm = fm + ((wgid % nig) % gsz); u.pn = (wgid % nig) / gsz; return true;
    }
    __device__ __forceinline__ void a_ready(const Unit&) const {}
    __device__ __forceinline__ void done(const Unit&) const {}
};

__device__ __forceinline__ unsigned cvt_pk_bf16(float lo, float hi) { unsigned r; asm volatile("v_cvt_pk_bf16_f32 %0, %1, %2" : "=v"(r) : "v"(lo), "v"(hi)); return r; }
typedef float f32x2 __attribute__((ext_vector_type(2)));
typedef unsigned u32x2e __attribute__((ext_vector_type(2)));
struct EpiBf16S {
    static constexpr bool PERM = true, AFTER_DRAIN = false;
    bf16_t* O; int ldc; int split_cols; size_t split_stride; float scale0; const float* ssp; float eps;
    __device__ __forceinline__ void operator()(const f32x4 (&acc)[2][2][4][2], const Unit& u, int wr, int wc, int fr, int fq) const {
        const int row0 = u.pm * BM + wr * 64 + fr; int colt = u.pn * BM; bf16_t* base = O;
        float sc = 1.f; if (split_cols) { const int t = colt / split_cols; base += (size_t)t * split_stride; colt -= t * split_cols; if (t == 0) sc = scale0; }
        const int col0 = colt + wc * 32 + 8 * fq;
#pragma unroll
        for (int ai = 0; ai < 2; ++ai)
#pragma unroll
            for (int m = 0; m < 4; ++m) { const int row = row0 + ai * HALF + m * 16; bf16_t* rowp = base + (size_t)row * ldc + col0;
                float rs = sc;
                if (ssp) { const f32x4* sp = (const f32x4*)(ssp + (size_t)row * 16); const f32x4 a = sp[0], b = sp[1], c = sp[2], d = sp[3];
                    const float s = ((a[0] + a[1]) + (a[2] + a[3])) + ((b[0] + b[1]) + (b[2] + b[3])) + ((c[0] + c[1]) + (c[2] + c[3])) + ((d[0] + d[1]) + (d[2] + d[3]));
                    rs *= 1.0f / sqrtf(s * (1.0f / 1024.0f) + eps); }
#pragma unroll
                for (int bj = 0; bj < 2; ++bj) { const f32x4 v0 = acc[ai][bj][m][0] * rs, v1 = acc[ai][bj][m][1] * rs;
                    u32x4 w; w.x = cvt_pk_bf16(v0[0], v0[1]); w.y = cvt_pk_bf16(v0[2], v0[3]); w.z = cvt_pk_bf16(v1[0], v1[1]); w.w = cvt_pk_bf16(v1[2], v1[3]);
                    *(u32x4*)(rowp + bj * HALF) = w; } }
    }
};
struct EpiResid {
    static constexpr bool PERM = false, AFTER_DRAIN = false;
    const float* resid; float* out; bf16_t* outb; float* ssp; int ldc;
    __device__ __forceinline__ void operator()(const f32x4 (&acc)[2][2][4][2], const Unit& u, int wr, int wc, int fr, int fq) const {
        const int col0 = u.pn * BM + wc * 32 + 4 * fq;
#pragma unroll
        for (int ai = 0; ai < 2; ++ai)
#pragma unroll
            for (int m = 0; m < 4; ++m) { const int r = u.pm * BM + ai * HALF + wr * 64 + m * 16 + fr; const size_t off = (size_t)r * ldc + col0; float s = 0.f;
#pragma unroll
                for (int bj = 0; bj < 2; ++bj)
#pragma unroll
                    for (int n = 0; n < 2; ++n) { const f32x4 x = *(const f32x4*)(resid + off + bj * HALF + n * 16) + acc[ai][bj][m][n];
                        *(f32x4*)(out + off + bj * HALF + n * 16) = x; s += (x[0] * x[0] + x[1] * x[1]) + (x[2] * x[2] + x[3] * x[3]);
                        u32x2e w; w.x = cvt_pk_bf16(x[0], x[1]); w.y = cvt_pk_bf16(x[2], x[3]); *(u32x2e*)(outb + off + bj * HALF + n * 16) = w; }
                s += __shfl_xor(s, 16); s += __shfl_xor(s, 32);
                if (fq == 0) ssp[(size_t)r * 16 + u.pn * 4 + wc] = s; }
    }
};
template <class Epi, class Sched, bool ALIGN_EPI = false, bool SP2 = false>
__device__ __forceinline__ void gemm_phase(PG8_LAS unsigned char* lds, const Gemm g, const Sched& S, const Epi& E) {
    const int tid = threadIdx.x, wid = __builtin_amdgcn_readfirstlane(tid >> 6), lane = tid & 63, wr = wid >> 2, wc = wid & 3, fr = lane & 15, fq = lane >> 4;
    const int K = g.K, nt = K / BK;
    unsigned voffA[2], voffB[2];
#pragma unroll
    for (int i = 0; i < 2; ++i) { int R, C; stage_rc(tid * 16 + i * 8192, R, C); const int Rb = Epi::PERM ? ((R & ~31) + perm32(R & 31)) : R;
        voffA[i] = (unsigned)(R * K + C) * 2u; voffB[i] = (unsigned)(Rb * K + C) * 2u; }
    const size_t kstep = (size_t)(BK * 2);
    const size_t hstep = (size_t)HALF * K * 2;
    const size_t tstep = 2 * hstep;
    const unsigned ldsw = (unsigned)wid * 1024u;
    const int aoff = lds_byte(wr * 64 + fr, fq * 8), boff = lds_byte(wc * 32 + fr, fq * 8);
#define PG8_SA(b, h) (((b) * 2 + (h)) * HTB)
#define PG8_SB(b, h) ((4 + (b) * 2 + (h)) * HTB)
#define PG8_STAGE(bufoff, gbase, voff) do { _Pragma("unroll") for (int _i = 0; _i < 2; ++_i) \
        __builtin_amdgcn_global_load_lds((const unsigned*)((const char*)(gbase) + (voff)[_i]), (PG8_LAS unsigned*)(lds + (bufoff) + ldsw + _i * 8192), 16, 0, 0); } while (0)
#define PG8_LDA(dst, b, h) do { _Pragma("unroll") for (int m = 0; m < 4; ++m) _Pragma("unroll") for (int k = 0; k < 2; ++k) dst[m][k] = *(const PG8_LAS bf16x8*)(lds + PG8_SA(b, h) + aoff + m * 2048 + k * 1024); } while (0)
#define PG8_LDB(dst, b, h) do { _Pragma("unroll") for (int n = 0; n < 2; ++n) _Pragma("unroll") for (int k = 0; k < 2; ++k) dst[n][k] = *(const PG8_LAS bf16x8*)(lds + PG8_SB(b, h) + boff + n * 2048 + k * 1024); } while (0)
#define PG8_MMA(ai, bj, At, Bt) do { __builtin_amdgcn_s_setprio(1); _Pragma("unroll") for (int m = 0; m < 4; ++m) _Pragma("unroll") for (int n = 0; n < 2; ++n) _Pragma("unroll") for (int k = 0; k < 2; ++k) \
        acc[ai][bj][m][n] = __builtin_amdgcn_mfma_f32_16x16x32_bf16(Bt[n][k], At[m][k], acc[ai][bj][m][n], 0, 0, 0); __builtin_amdgcn_s_setprio(0); } while (0)
#define PG8_WAIT_V(n) asm volatile("s_waitcnt vmcnt(" #n ")" ::: "memory")
#define PG8_WAIT_L(n) asm volatile("s_waitcnt lgkmcnt(" #n ")" ::: "memory")
#define PG8_BAR __builtin_amdgcn_s_barrier()
#define PG8_SCHED __builtin_amdgcn_sched_barrier(0)
    Unit cur, nxt; int ui = 0;
    if (!S.next(0, cur)) return;
    f32x4 acc[2][2][4][2];
#pragma unroll
    for (int a = 0; a < 2; ++a)
#pragma unroll
        for (int b = 0; b < 2; ++b)
#pragma unroll
            for (int m = 0; m < 4; ++m)
#pragma unroll
                for (int n = 0; n < 2; ++n) acc[a][b][m][n] = (f32x4){0.f, 0.f, 0.f, 0.f};
    bf16x8 At[4][2], B0[2][2], B1[2][2];
    const char* cA = (const char*)g.A + (size_t)cur.pm * tstep; const char* cB = (const char*)g.Bt + (size_t)cur.pn * tstep;
    S.a_ready(cur);
    if constexpr (SP2) {
        PG8_STAGE(PG8_SB(0, 0), cB, voffB); PG8_STAGE(PG8_SB(0, 1), cB + hstep, voffB); PG8_STAGE(PG8_SA(0, 0), cA, voffA); PG8_STAGE(PG8_SA(0, 1), cA + hstep, voffA);
        if (wr == 1) PG8_BAR;
        PG8_WAIT_V(2); PG8_BAR;
        PG8_STAGE(PG8_SB(1, 0), cB + kstep, voffB); PG8_STAGE(PG8_SA(1, 0), cA + kstep, voffA); PG8_STAGE(PG8_SB(1, 1), cB + hstep + kstep, voffB);
        PG8_WAIT_V(6); PG8_BAR;
    } else {
        PG8_STAGE(PG8_SB(0, 0), cB, voffB); PG8_STAGE(PG8_SA(0, 0), cA, voffA); PG8_STAGE(PG8_SB(0, 1), cB + hstep, voffB); PG8_STAGE(PG8_SA(0, 1), cA + hstep, voffA);
        if (wr == 1) PG8_BAR;
        PG8_WAIT_V(4); PG8_BAR;
        PG8_STAGE(PG8_SB(1, 0), cB + kstep, voffB); PG8_STAGE(PG8_SA(1, 0), cA + kstep, voffA); PG8_STAGE(PG8_SB(1, 1), cB + hstep + kstep, voffB);
        PG8_WAIT_V(6); PG8_BAR;
    }
    for (;;) {
        const bool has_next = S.next(ui + 1, nxt);
        const char* nA = has_next ? (const char*)g.A + (size_t)nxt.pm * tstep : cA; const char* nB = has_next ? (const char*)g.Bt + (size_t)nxt.pn * tstep : cB;
        for (int t = 0; t < nt; t += 2) {
            const bool last = (t == nt - 2);
            const char* a1 = cA + (size_t)(t + 1) * kstep;
            const char* a2 = last ? nA : cA + (size_t)(t + 2) * kstep; const char* b2 = last ? nB : cB + (size_t)(t + 2) * kstep;
            const char* a3 = a2 + kstep; const char* b3 = b2 + kstep;
            if (last && has_next) S.a_ready(nxt);
            if constexpr (SP2) {
            PG8_LDB(B0, 0, 0); PG8_LDB(B1, 0, 1); PG8_SCHED; PG8_LDA(At, 0, 0); PG8_STAGE(PG8_SA(1, 1), a1 + hstep, voffA);
            PG8_WAIT_V(8); PG8_WAIT_L(0); PG8_BAR; PG8_MMA(0, 0, At, B0); PG8_MMA(0, 1, At, B1); PG8_BAR; PG8_SCHED;
            PG8_LDA(At, 0, 1); PG8_STAGE(PG8_SB(0, 0), b2, voffB); PG8_STAGE(PG8_SB(0, 1), b2 + hstep, voffB); PG8_STAGE(PG8_SA(0, 0), a2, voffA);
            PG8_WAIT_V(8); PG8_WAIT_L(0); PG8_BAR; PG8_MMA(1, 0, At, B0); PG8_MMA(1, 1, At, B1); PG8_BAR; PG8_SCHED;
            PG8_LDB(B0, 1, 0); PG8_LDB(B1, 1, 1); PG8_SCHED; PG8_LDA(At, 1, 0); PG8_STAGE(PG8_SA(0, 1), a2 + hstep, voffA);
            PG8_WAIT_V(8); PG8_WAIT_L(0); PG8_BAR; PG8_MMA(0, 0, At, B0); PG8_MMA(0, 1, At, B1); PG8_BAR; PG8_SCHED;
            PG8_LDA(At, 1, 1); PG8_STAGE(PG8_SB(1, 0), b3, voffB); PG8_STAGE(PG8_SB(1, 1), b3 + hstep, voffB); PG8_STAGE(PG8_SA(1, 0), a3, voffA);
            PG8_WAIT_V(8); PG8_WAIT_L(0); PG8_BAR; PG8_MMA(1, 0, At, B0); PG8_MMA(1, 1, At, B1); PG8_BAR; PG8_SCHED;
            } else {
            PG8_LDB(B0, 0, 0); PG8_SCHED; PG8_LDA(At, 0, 0); PG8_STAGE(PG8_SA(1, 1), a1 + hstep, voffA);
            PG8_WAIT_L(8); PG8_BAR; PG8_WAIT_L(0); PG8_MMA(0, 0, At, B0); PG8_BAR; PG8_SCHED;
            PG8_LDB(B1, 0, 1); PG8_STAGE(PG8_SB(0, 0), b2, voffB);
            PG8_BAR; PG8_WAIT_L(0); PG8_MMA(0, 1, At, B1); PG8_BAR;
            PG8_LDA(At, 0, 1); PG8_STAGE(PG8_SA(0, 0), a2, voffA);
            PG8_BAR; PG8_WAIT_L(0); PG8_MMA(1, 0, At, B0); PG8_BAR; PG8_SCHED;
            PG8_STAGE(PG8_SB(0, 1), b2 + hstep, voffB);
            PG8_WAIT_V(6); PG8_BAR; PG8_MMA(1, 1, At, B1); PG8_BAR;
            PG8_LDB(B0, 1, 0); PG8_SCHED; PG8_LDA(At, 1, 0); PG8_STAGE(PG8_SA(0, 1), a2 + hstep, voffA);
            PG8_WAIT_L(8); PG8_BAR; PG8_WAIT_L(0); PG8_MMA(0, 0, At, B0); PG8_BAR; PG8_SCHED;
            PG8_LDB(B1, 1, 1); PG8_STAGE(PG8_SB(1, 0), b3, voffB);
            PG8_BAR; PG8_WAIT_L(0); PG8_MMA(0, 1, At, B1); PG8_BAR;
            PG8_LDA(At, 1, 1); PG8_STAGE(PG8_SA(1, 0), a3, voffA);
            PG8_BAR; PG8_WAIT_L(0); PG8_MMA(1, 0, At, B0); PG8_BAR; PG8_SCHED;
            PG8_STAGE(PG8_SB(1, 1), b3 + hstep, voffB);
            PG8_WAIT_V(6); PG8_BAR; PG8_MMA(1, 1, At, B1); PG8_BAR;
            }
        }
        if constexpr (ALIGN_EPI) { if (wr == 0) PG8_BAR; }
        if constexpr (!Epi::AFTER_DRAIN) { E(acc, cur, wr, wc, fr, fq); S.done(cur); }
        if (!has_next) break;
#pragma unroll
        for (int a = 0; a < 2; ++a)
#pragma unroll
            for (int b = 0; b < 2; ++b)
#pragma unroll
                for (int m = 0; m < 4; ++m)
#pragma unroll
                    for (int n = 0; n < 2; ++n) acc[a][b][m][n] = (f32x4){0.f, 0.f, 0.f, 0.f};
        cur = nxt; cA = nA; cB = nB; ++ui;
        if constexpr (ALIGN_EPI) { if (wr == 1) PG8_BAR; }
    }
    PG8_WAIT_V(0);
    if constexpr (!ALIGN_EPI) { if (wr == 0) PG8_BAR; }
    PG8_BAR;
    if constexpr (Epi::AFTER_DRAIN) { E.fused(acc, cur, wr, wc, fr, fq, lds, wid, lane); S.done(cur); }
#undef PG8_SA
#undef PG8_SB
#undef PG8_STAGE
#undef PG8_LDA
#undef PG8_LDB
#undef PG8_MMA
#undef PG8_WAIT_V
#undef PG8_WAIT_L
#undef PG8_BAR
#undef PG8_SCHED
}
}
#define GAS __attribute__((address_space(1)))
#define LAS __attribute__((address_space(3)))
typedef unsigned short bf16;
typedef unsigned v4u __attribute__((ext_vector_type(4)));
typedef float f32x4 __attribute__((ext_vector_type(4)));
typedef short bf16x8 __attribute__((ext_vector_type(8)));
typedef GAS unsigned gu32;
typedef GAS unsigned long long gu64;
#define RLX_AGENT __ATOMIC_RELAXED, __HIP_MEMORY_SCOPE_AGENT
#define LDS_WAIT() asm volatile("s_waitcnt lgkmcnt(0)" ::: "memory")
#define VM_WAIT() asm volatile("s_waitcnt vmcnt(0)" ::: "memory")
__device__ __forceinline__ unsigned long long rt() { return __builtin_amdgcn_s_memrealtime(); }
__device__ __forceinline__ unsigned f2bf(float f) { unsigned u = __builtin_bit_cast(unsigned, f); return (u + 0x7fffu + ((u >> 16) & 1u)) >> 16; }
__device__ __forceinline__ unsigned pk2(float lo, float hi) { return f2bf(lo) | (f2bf(hi) << 16); }

#define XB_TMO      128
#define XB_XCNT(j)  (256  + 64 * (j))
#define XB_XSUB(j)  (1280 + 64 * (j))
#define XB_XGEN(j)  (2304 + 64 * (j))
#define XB_TOP      3328
#define XB_TOPGEN   3392
#define XCD_BAR_WORDS 3456
#define XB_SPIN_CAP (1u << 18)

__device__ __forceinline__ unsigned xb_ld(unsigned* p)              { return __hip_atomic_load(p, __ATOMIC_RELAXED, __HIP_MEMORY_SCOPE_AGENT); }
__device__ __forceinline__ unsigned xb_add(unsigned* p, unsigned v) { return __hip_atomic_fetch_add(p, v, __ATOMIC_RELAXED, __HIP_MEMORY_SCOPE_AGENT); }
__device__ __forceinline__ unsigned xb_xcc_id() { return (unsigned)__builtin_amdgcn_s_getreg((3 << 11) | 20) & 0xFu; }
#define XB_SPIN(cond, bar) do { unsigned _sp = 0; while (cond) { __builtin_amdgcn_s_sleep(1); \
    if ((++_sp & 255u) == 0u) { if (xb_ld(&(bar)[XB_TMO])) break; if (_sp > XB_SPIN_CAP) { atomicAdd(&(bar)[XB_TMO], 1u); break; } } } } while (0)

struct XcdBarrier {
    unsigned* bar; unsigned x;
    volatile LAS unsigned* st;
};

__device__ __forceinline__ XcdBarrier xcd_barrier_post(unsigned* bar, volatile LAS unsigned* st) {
    XcdBarrier b; b.bar = bar; b.x = xb_xcc_id(); b.st = st;
    if (threadIdx.x == 0) (void)xb_add(&bar[XB_XCNT(b.x)], 1u);
    return b;
}
__device__ __forceinline__ void xcd_barrier_complete(unsigned* bar, unsigned x, unsigned& nloc, unsigned& nx) {
    const unsigned G = gridDim.x * gridDim.y * gridDim.z;
    unsigned sum, cnt, mine, sp = 0u;
    for (;;) {
        sum = 0u; cnt = 0u; mine = 0u;
#pragma unroll
        for (unsigned j = 0; j < 16; ++j) { const unsigned c = xb_ld(&bar[XB_XCNT(j)]); sum += c; cnt += (c > 0u) ? 1u : 0u; mine = (j == x) ? c : mine; }
        if (sum == G) break;
        __builtin_amdgcn_s_sleep(1);
        if ((++sp & 255u) == 0u) { if (xb_ld(&bar[XB_TMO])) break; if (sp > XB_SPIN_CAP) { atomicAdd(&bar[XB_TMO], 1u); break; } }
    }
    nloc = mine > 0u ? mine : 1u; nx = cnt > 0u ? cnt : 1u;
}

__device__ __forceinline__ void xcd_barrier(const XcdBarrier& b) {
    asm volatile("s_waitcnt vmcnt(0)" ::: "memory");
    __syncthreads();
    if (threadIdx.x == 0) {
        unsigned* bar = b.bar;
        __builtin_amdgcn_s_waitcnt(0);
        unsigned nloc = b.st[0], nx = b.st[1];
        if (nloc == 0u) { xcd_barrier_complete(bar, b.x, nloc, nx); b.st[0] = nloc; b.st[1] = nx; }
        const unsigned old = xb_add(&bar[XB_XSUB(b.x)], 1u);
        const unsigned gen = old / nloc;
        if (old + 1u == (gen + 1u) * nloc) {
            __builtin_amdgcn_fence(__ATOMIC_RELEASE, "agent");
            asm volatile("s_waitcnt vmcnt(0)" ::: "memory");
            const unsigned og = xb_add(&bar[XB_TOP], 1u);
            const unsigned tg = og / nx;
            if (og + 1u == (tg + 1u) * nx) xb_add(&bar[XB_TOPGEN], 1u);
            else XB_SPIN(xb_ld(&bar[XB_TOPGEN]) == tg, bar);
            __builtin_amdgcn_fence(__ATOMIC_ACQUIRE, "agent");
            xb_add(&bar[XB_XGEN(b.x)], 1u);
            asm volatile("s_waitcnt vmcnt(0)" ::: "memory");
        } else {
            XB_SPIN(xb_ld(&bar[XB_XGEN(b.x)]) == gen, bar);
            __builtin_amdgcn_fence(__ATOMIC_ACQUIRE, "agent");
            asm volatile("s_waitcnt vmcnt(0)" ::: "memory");
        }
    }
    __syncthreads();
}

constexpr int NWAVES = 8, NTHR = NWAVES * 64;
constexpr int BATCH = 4, SEQ = 4096, DM = 1024, M = BATCH * SEQ;
constexpr int NPROJ = 3584, INCOLS = 3592;
constexpr int PW = 512;
constexpr int NEXP = 16384, PHEADS = 8, PTOPK = 16;
constexpr float LOG2E = 1.4426950408889634f;
constexpr float NORM_EPS = 1e-6f, SUBLN_EPS = 1e-5f;
constexpr float LAM_INIT = 0.2f;
constexpr float QSCALE = 0.125f * LOG2E;
constexpr float MLK_SCALE = 0.08838834764831845f;

constexpr size_t MiB = 1u << 20;
constexpr size_t WS_CTL = 0, CTL_ZERO_BYTES = 1 * MiB;
constexpr size_t WS_GI = 1 * MiB, WS_GLF = WS_GI + 256 * 1024, WS_A2 = WS_GLF + 256 * 1024, WS_M2 = WS_A2 + 256 * 1024;
constexpr size_t WS_NB2 = 2 * MiB, WS_MLOC = WS_NB2 + 256 * 1024, WS_DN = WS_MLOC + 4096;
constexpr size_t WS_SSP = 3 * MiB;
constexpr size_t WS_WIN = 4 * MiB, WS_WOUT = 11 * MiB, WS_WPQ = 13 * MiB, WS_SUBK = 17 * MiB;
constexpr size_t WS_H1 = 20 * MiB;
constexpr size_t WS_PROJ = 52 * MiB;
constexpr size_t PROJ_STRIDE = (size_t)M * PW;
constexpr size_t WS_X1 = 52 * MiB, WS_X1B = 116 * MiB, WS_QPB = 148 * MiB, WS_PE = 116 * MiB;
constexpr size_t WS_DCT = 164 * MiB;
constexpr size_t WS_UB = 192 * MiB, WS_VB = 224 * MiB, WS_END = 256 * MiB;
constexpr int CW_ERR = 16, CW_BAR = 4096;

constexpr int RING_BYTES = 131072;
constexpr int MISC_OFF = RING_BYTES;
constexpr int WSCR_OFF = MISC_OFF + 512;
constexpr int XTRA_OFF = WSCR_OFF + 8 * 512;
constexpr int LDS_BYTES = 163840;

struct Frame {
    LAS unsigned char* lds; unsigned char* ldsg;
    volatile LAS unsigned* MISC;
    gu32* ctl;
    int tid, lane, wave, vcu, G;
    const float* in[20]; float* out; unsigned char* ws;
};
#define WSP(T, off) ((T*)(F.ws + (off)))

__device__ __forceinline__ float bf2f(unsigned short b) { return __builtin_bit_cast(float, (unsigned)b << 16); }
__device__ __forceinline__ float wave_sum(float v) {
#pragma unroll
    for (int o = 1; o < 64; o <<= 1) v += __shfl_xor(v, o);
    return v;
}
__device__ __forceinline__ float wave_max(float v) {
#pragma unroll
    for (int o = 1; o < 64; o <<= 1) v = fmaxf(v, __shfl_xor(v, o));
    return v;
}

__device__ __forceinline__ void p0_transpose_item(const float* W, int ldw, int K, int nblk, bf16* WT, const float* kscale, LAS float* scr, int item, int lane) {
    const int kb = item / nblk, nb = item % nblk, k0 = 64 * kb, n0 = 32 * nb;
#pragma unroll 8
    for (int i = 0; i < 32; ++i) { const int kk = 2 * i + (lane >> 5); float v = W[(size_t)(k0 + kk) * ldw + n0 + (lane & 31)]; if (kscale) v *= kscale[k0 + kk]; scr[kk * 33 + (lane & 31)] = v; }
    LDS_WAIT(); asm volatile("" ::: "memory");
    const int c = lane & 7;
#pragma unroll
    for (int j = 0; j < 4; ++j) { const int n = (lane >> 3) + 8 * j; const LAS float* s = scr + (8 * c) * 33 + n;
        v4u o; o.x = pk2(s[0 * 33], s[1 * 33]); o.y = pk2(s[2 * 33], s[3 * 33]); o.z = pk2(s[4 * 33], s[5 * 33]); o.w = pk2(s[6 * 33], s[7 * 33]);
        *(GAS v4u*)(WT + (size_t)(n0 + n) * K + k0 + 8 * c) = o; }
    LDS_WAIT(); asm volatile("" ::: "memory");
}
__device__ __forceinline__ float log_sigmoid(float f) { return fminf(f, 0.f) - log1pf(expf(-fabsf(f))); }

__device__ __forceinline__ void p0_prologue(Frame& F) {
    const float* x = F.in[0]; const float* g1 = F.in[1]; const float* w_in = F.in[2]; const float* w_out = F.in[13]; const float* g2 = F.in[14]; const float* w_pq = F.in[15];
    LAS float* wg = (LAS float*)(F.lds + 98304);
    for (int e = F.tid; e < 8192; e += NTHR) wg[e] = w_in[(size_t)(e >> 3) * INCOLS + NPROJ + (e & 7)];
    LAS float* scr = (LAS float*)(F.lds + F.wave * 8448);
    const int gw = F.vcu * NWAVES + F.wave, NGW = F.G * NWAVES;
    constexpr int I_IN = 16 * (NPROJ / 32), I_OUT = 16 * 32, I_PQ = 16 * 64, NITEMS = I_IN + I_OUT + I_PQ;
    for (int it = gw; it < NITEMS; it += NGW) {
        int r = it;
        if (r < I_IN) { p0_transpose_item(w_in, INCOLS, DM, NPROJ / 32, WSP(bf16, WS_WIN), nullptr, scr, r, F.lane); continue; } r -= I_IN;
        if (r < I_OUT) { p0_transpose_item(w_out, DM, DM, 32, WSP(bf16, WS_WOUT), nullptr, scr, r, F.lane); continue; } r -= I_OUT;
        p0_transpose_item(w_pq, 2048, DM, 64, WSP(bf16, WS_WPQ), g2, scr, r, F.lane);
    }
    __syncthreads();
    {
        const float* b_i = F.in[5]; const float* b_f = F.in[6];
        float* GI = WSP(float, WS_GI); float* GLF = WSP(float, WS_GLF); bf16* H1 = WSP(bf16, WS_H1);
        f32x4 gv[4];
#pragma unroll
        for (int j = 0; j < 4; ++j) gv[j] = ((const f32x4*)g1)[F.lane + 64 * j];
        for (int m = gw; m < M; m += NGW) {
            const f32x4* xr = (const f32x4*)(x + (size_t)m * DM) + F.lane;
            f32x4 v[4]; float s = 0.f;
#pragma unroll
            for (int j = 0; j < 4; ++j) { v[j] = xr[64 * j]; s += (v[j][0] * v[j][0] + v[j][1] * v[j][1]) + (v[j][2] * v[j][2] + v[j][3] * v[j][3]); }
            const float rstd = 1.0f / sqrtf(wave_sum(s) * (1.f / DM) + NORM_EPS);
            float ga[8];
#pragma unroll
            for (int g = 0; g < 8; ++g) ga[g] = 0.f;
            unsigned long long* o8 = (unsigned long long*)(H1 + (size_t)m * DM) + F.lane;
#pragma unroll
            for (int j = 0; j < 4; ++j) { v[j] = v[j] * rstd * gv[j];
                o8[64 * j] = (unsigned long long)pk2(v[j][0], v[j][1]) | ((unsigned long long)pk2(v[j][2], v[j][3]) << 32);
#pragma unroll
                for (int i = 0; i < 4; ++i) { const int e = 4 * F.lane + 256 * j + i; const f32x4 w0 = *(const LAS f32x4*)(wg + e * 8), w1 = *(const LAS f32x4*)(wg + e * 8 + 4);
                    ga[0] += v[j][i] * w0[0]; ga[1] += v[j][i] * w0[1]; ga[2] += v[j][i] * w0[2]; ga[3] += v[j][i] * w0[3];
                    ga[4] += v[j][i] * w1[0]; ga[5] += v[j][i] * w1[1]; ga[6] += v[j][i] * w1[2]; ga[7] += v[j][i] * w1[3]; } }
#pragma unroll
            for (int g = 0; g < 8; ++g) ga[g] = wave_sum(ga[g]);
            if (F.lane == 0) { const int b = m / SEQ, t = m % SEQ;
#pragma unroll
                for (int hh = 0; hh < 4; ++hh) { GI[(size_t)(b * 4 + hh) * SEQ + t] = ga[hh] + b_i[hh]; GLF[(size_t)(b * 4 + hh) * SEQ + t] = log_sigmoid(ga[4 + hh] + b_f[hh]); } }
        }
    }
    {
        const long gt = (long)F.vcu * NTHR + F.tid, NGT = (long)F.G * NTHR;
        const float* sk = F.in[16]; const float* ue = F.in[17]; const float* ve = F.in[18];
        bf16* SK = WSP(bf16, WS_SUBK); bf16* UB = WSP(bf16, WS_UB); bf16* VB = WSP(bf16, WS_VB);
        for (long i = gt; i < 262144 / 8; i += NGT) { const f32x4 a = ((const f32x4*)sk)[2 * i], b = ((const f32x4*)sk)[2 * i + 1];
            v4u o; o.x = pk2(a[0], a[1]); o.y = pk2(a[2], a[3]); o.z = pk2(b[0], b[1]); o.w = pk2(b[2], b[3]); ((v4u*)SK)[i] = o; }
        constexpr long NE8 = (long)NEXP * DM / 8;
        for (long i = gt; i < NE8; i += NGT) { const int d = (int)((i * 8) & (DM - 1));
            const f32x4 a = ((const f32x4*)ue)[2 * i], b = ((const f32x4*)ue)[2 * i + 1]; const f32x4 ga = *(const f32x4*)(g2 + d), gb = *(const f32x4*)(g2 + d + 4);
            v4u o; o.x = pk2(a[0] * ga[0], a[1] * ga[1]); o.y = pk2(a[2] * ga[2], a[3] * ga[3]); o.z = pk2(b[0] * gb[0], b[1] * gb[1]); o.w = pk2(b[2] * gb[2], b[3] * gb[3]); ((v4u*)UB)[i] = o; }
        for (long i = gt; i < NE8; i += NGT) { const f32x4 a = ((const f32x4*)ve)[2 * i], b = ((const f32x4*)ve)[2 * i + 1];
            v4u o; o.x = pk2(a[0], a[1]); o.y = pk2(a[2], a[3]); o.z = pk2(b[0], b[1]); o.w = pk2(b[2], b[3]); ((v4u*)VB)[i] = o; }
    }
}

__device__ __forceinline__ void gate_scan(Frame& F, int bh) {
    const float* gi = WSP(float, WS_GI) + (size_t)bh * SEQ + 64 * F.lane; const float* glf = WSP(float, WS_GLF) + (size_t)bh * SEQ + 64 * F.lane;
    float* A2 = WSP(float, WS_A2) + (size_t)bh * SEQ + 64 * F.lane; float* M2 = WSP(float, WS_M2) + (size_t)bh * SEQ + 64 * F.lane; float* NB2 = WSP(float, WS_NB2) + (size_t)bh * SEQ + 64 * F.lane;
    float tot = 0.f;
    for (int j = 0; j < 16; ++j) { const f32x4 v = ((const f32x4*)glf)[j]; tot += v[0]; tot += v[1]; tot += v[2]; tot += v[3]; }
    float inc = tot;
#pragma unroll
    for (int o = 1; o < 64; o <<= 1) { const float u = __shfl_up(inc, o); if (F.lane >= o) inc += u; }
    const float boff = inc - tot;
    float B = boff, lm = -3.0e38f;
    for (int j = 0; j < 16; ++j) { const f32x4 v = ((const f32x4*)glf)[j], iv = ((const f32x4*)gi)[j];
#pragma unroll
        for (int i = 0; i < 4; ++i) { B += v[i]; lm = fmaxf(lm, iv[i] - B); } }
    float incm = lm;
#pragma unroll
    for (int o = 1; o < 64; o <<= 1) { const float u = __shfl_up(incm, o); if (F.lane >= o) incm = fmaxf(incm, u); }
    float pm = __shfl_up(incm, 1); if (F.lane == 0) pm = -3.0e38f;
    B = boff; float Mx = pm;
    for (int j = 0; j < 16; ++j) { const f32x4 v = ((const f32x4*)glf)[j], iv = ((const f32x4*)gi)[j]; f32x4 oa, om, ob;
#pragma unroll
        for (int i = 0; i < 4; ++i) { B += v[i]; const float a = iv[i] - B; Mx = fmaxf(Mx, a); oa[i] = a * LOG2E; om[i] = Mx * LOG2E; ob[i] = -(B + Mx) * LOG2E; }
        ((f32x4*)A2)[j] = oa; ((f32x4*)M2)[j] = om; ((f32x4*)NB2)[j] = ob; }
}

namespace att {
using s16x4 = __attribute__((ext_vector_type(4))) short;
using f32x16 = __attribute__((ext_vector_type(16))) float;
using u32x4 = __attribute__((ext_vector_type(4))) unsigned;
constexpr int SHM_T = 64 * 128 * 2;
#define KSWZ(row, colB) ((row) * 256 + ((colB) ^ (((row) & 7) << 4)))
#define SBAR() __builtin_amdgcn_sched_barrier(0)
#define MFMA32(a, b, c) __builtin_amdgcn_mfma_f32_32x32x16_bf16((a), (b), (c), 0, 0, 0)
__device__ __forceinline__ int crow(int r, int hi) { return (r & 3) + 8 * (r >> 2) + 4 * hi; }
__device__ __forceinline__ unsigned cvtpk(float lo, float hi) { unsigned r; asm volatile("v_cvt_pk_bf16_f32 %0, %1, %2" : "=v"(r) : "v"(lo), "v"(hi)); return r; }
__device__ __forceinline__ int v_st(int k, int c) { const int kk = (k & ~0xC) | ((k & 4) << 1) | ((k & 8) >> 1); return ((kk >> 3) * 4 + (c >> 5)) * 512 + ((kk & 7) * 32 + (c & 31)) * 2; }
__device__ __forceinline__ int v_rd_base(int lane) { return ((lane & 3) << 3) | (((lane >> 2) & 3) << 6) | (((lane >> 4) & 1) << 5) | (((lane >> 5) & 1) << 8); }
constexpr int v_rd_off(int d0, int ks, int half) { return d0 * 512 + ks * 4096 + half * 2048; }
template <int OFF> __device__ __forceinline__ s16x4 tr_read(int vb) { s16x4 r; asm volatile("ds_read_b64_tr_b16 %0, %1 offset:%2" : "=&v"(r) : "v"(vb), "i"(OFF) : "memory"); return r; }
#define PKF(L, H) (bf16x8){L[0], L[1], L[2], L[3], H[0], H[1], H[2], H[3]}
template <int D0, int KS> __device__ __forceinline__ bf16x8 tr_frag(int vb) {
    const s16x4 l = tr_read<v_rd_off(D0, KS, 0)>(vb), h = tr_read<v_rd_off(D0, KS, 1)>(vb); asm volatile("s_waitcnt lgkmcnt(0)" ::: "memory"); return PKF(l, h); }
template <int D0> __device__ __forceinline__ void pv_one(f32x16& od, int vb, bf16x8 pa0, bf16x8 pa1, bf16x8 pa2, bf16x8 pa3) {
    const s16x4 l0 = tr_read<v_rd_off(D0, 0, 0)>(vb), h0 = tr_read<v_rd_off(D0, 0, 1)>(vb), l1 = tr_read<v_rd_off(D0, 1, 0)>(vb), h1 = tr_read<v_rd_off(D0, 1, 1)>(vb);
    const s16x4 l2 = tr_read<v_rd_off(D0, 2, 0)>(vb), h2 = tr_read<v_rd_off(D0, 2, 1)>(vb), l3 = tr_read<v_rd_off(D0, 3, 0)>(vb), h3 = tr_read<v_rd_off(D0, 3, 1)>(vb);
    asm volatile("s_waitcnt lgkmcnt(0)" ::: "memory"); SBAR();
    od = MFMA32(pa0, PKF(l0, h0), od); od = MFMA32(pa1, PKF(l1, h1), od); od = MFMA32(pa2, PKF(l2, h2), od); od = MFMA32(pa3, PKF(l3, h3), od);
}
__device__ __forceinline__ void pv_d0(f32x16* o, int vb, bf16x8 pa0, bf16x8 pa1, bf16x8 pa2, bf16x8 pa3) {
    pv_one<0>(o[0], vb, pa0, pa1, pa2, pa3); pv_one<1>(o[1], vb, pa0, pa1, pa2, pa3); pv_one<2>(o[2], vb, pa0, pa1, pa2, pa3); pv_one<3>(o[3], vb, pa0, pa1, pa2, pa3);
}
__device__ __forceinline__ void pack_p(const f32x16& p0, const f32x16& p1, bf16x8& pa0, bf16x8& pa1, bf16x8& pa2, bf16x8& pa3) {
#define PK4(P, BASE, OUT) do { unsigned a0 = cvtpk(P[BASE + 0], P[BASE + 1]), a1 = cvtpk(P[BASE + 2], P[BASE + 3]);   \
    unsigned b0 = cvtpk(P[BASE + 4], P[BASE + 5]), b1 = cvtpk(P[BASE + 6], P[BASE + 7]);                              \
    auto r0 = __builtin_amdgcn_permlane32_swap(a0, b0, false, false); auto r1 = __builtin_amdgcn_permlane32_swap(a1, b1, false, false); \
    u32x4 w = {r0[0], r1[0], r0[1], r1[1]}; OUT = __builtin_bit_cast(bf16x8, w); } while (0)
    PK4(p0, 0, pa0); PK4(p0, 8, pa1); PK4(p1, 0, pa2); PK4(p1, 8, pa3);
#undef PK4
}
__device__ __forceinline__ float half_swap_max(float v) { auto rr = __builtin_amdgcn_permlane32_swap(__float_as_uint(v), __float_as_uint(v), false, false); return fmaxf(__uint_as_float(rr[0]), __uint_as_float(rr[1])); }
__device__ __forceinline__ float half_swap_add(float v) { auto rr = __builtin_amdgcn_permlane32_swap(__float_as_uint(v), __float_as_uint(v), false, false); return __uint_as_float(rr[0]) + __uint_as_float(rr[1]); }
__device__ __forceinline__ float half_sum32(float v) {
#pragma unroll
    for (int o = 1; o < 32; o <<= 1) v += __shfl_xor(v, o);
    return v;
}

constexpr float THR2 = 10.f;
__device__ __forceinline__ void partialSM(f32x16& p0, f32x16& p1, float& m_reg, float& alpha, float Tj, bool domask, int key0, int qrow, int hi) {
    if (domask) {
#pragma unroll
        for (int r = 0; r < 16; ++r) { const int kv = key0 + crow(r, hi); if (kv > qrow) p0[r] = -INFINITY; if (kv + 32 > qrow) p1[r] = -INFINITY; }
    }
    float pmax = p0[0];
#pragma unroll
    for (int r = 1; r < 16; ++r) pmax = fmaxf(pmax, p0[r]);
#pragma unroll
    for (int r = 0; r < 16; ++r) pmax = fmaxf(pmax, p1[r]);
    pmax = half_swap_max(pmax) + Tj;
    float mn;
    if (__builtin_expect(__all(pmax - m_reg <= THR2), 1)) { mn = m_reg; alpha = 1.f; }
    else { mn = fmaxf(m_reg, pmax); alpha = __builtin_amdgcn_exp2f(m_reg - mn); m_reg = mn; }
    const float off = Tj - mn;
#pragma unroll
    for (int r = 0; r < 16; ++r) p0[r] += off;
#pragma unroll
    for (int r = 0; r < 16; ++r) p1[r] += off;
#pragma unroll
    for (int r = 0; r < 16; ++r) p0[r] = __builtin_amdgcn_exp2f(p0[r]);
}
__device__ __forceinline__ void finishSM(f32x16& p0, f32x16& p1, float alpha, float& l_reg, bf16x8& pa0, bf16x8& pa1, bf16x8& pa2, bf16x8& pa3) {
#pragma unroll
    for (int r = 0; r < 16; ++r) p1[r] = __builtin_amdgcn_exp2f(p1[r]);
    float ps = 0;
#pragma unroll
    for (int r = 0; r < 16; ++r) ps += p0[r];
#pragma unroll
    for (int r = 0; r < 16; ++r) ps += p1[r];
    ps = half_swap_add(ps);
    l_reg = l_reg * alpha + ps;
    pack_p(p0, p1, pa0, pa1, pa2, pa3);
}
__device__ __forceinline__ void qkt4(f32x16& p0, f32x16& p1, const LAS char* Ks, const bf16x8* qr, bf16x8 kx0, bf16x8 kx1, bf16x8 qx, int r32, int hi, int cbase) {
    p0 = MFMA32(kx0, qx, f32x16{}); p1 = MFMA32(kx1, qx, f32x16{});
#pragma unroll
    for (int d0 = 0; d0 < 4; ++d0) { const int cb = cbase + (d0 * 16 + hi * 8) * 2;
        const bf16x8 b0 = *(const LAS bf16x8*)(Ks + KSWZ(r32, cb)); const bf16x8 b1 = *(const LAS bf16x8*)(Ks + KSWZ(32 + r32, cb));
        p0 = MFMA32(b0, qr[d0], p0); p1 = MFMA32(b1, qr[d0], p1); }
}

__device__ __forceinline__ void store_rows(const f32x16 (&o)[4], const float (&rs)[16], const float* colscale, LAS float* stg, bf16* dst, int ldd, const bf16* gate, int ldg, int lane) {
    const int r32 = lane & 31, hi = lane >> 5;
#pragma unroll
    for (int d = 0; d < 4; ++d) { const float cs = colscale[d * 32 + r32];
#pragma unroll
        for (int r = 0; r < 16; ++r) stg[crow(r, hi) * 128 + d * 32 + r32] = o[d][r] * rs[r] * cs; }
    asm volatile("s_waitcnt lgkmcnt(0)" ::: "memory");
#pragma unroll 2
    for (int i = 0; i < 8; ++i) { const int p = i * 64 + lane, row = p >> 4, ch = p & 15;
        f32x4 a = *(const LAS f32x4*)(stg + row * 128 + ch * 8), b = *(const LAS f32x4*)(stg + row * 128 + ch * 8 + 4);
        if (gate) { const bf16x8 gv = *(const bf16x8*)(gate + (size_t)row * ldg + ch * 8);
#pragma unroll
            for (int k = 0; k < 4; ++k) { a[k] = a[k] / (1.0f + __expf(-bf2f((unsigned short)gv[k]))); b[k] = b[k] / (1.0f + __expf(-bf2f((unsigned short)gv[4 + k]))); } }
        u32x4 w = {cvtpk(a[0], a[1]), cvtpk(a[2], a[3]), cvtpk(b[0], b[1]), cvtpk(b[2], b[3])};
        *(u32x4*)(dst + (size_t)row * ldd + ch * 8) = w; }
}

__device__ __forceinline__ void dattn_unit(Frame& F, int b, int h, int qb, float lam) {
    const int tid = F.tid, wid = F.wave, lane = F.lane, r32 = lane & 31, hi = lane >> 5, c = wid & 1, g = wid >> 1;
    LAS char* lds = (LAS char*)F.lds;
    LAS char* V_lds = lds; LAS char* K_lds = lds + 2 * SHM_T;
    LAS float* ws = (LAS float*)(lds + WSCR_OFF) + wid * 128; LAS float* li_l = ws; LAS float* al_l = ws + 32;
    const bf16* DAQ = WSP(bf16, WS_PROJ); const bf16* DAK = DAQ + PROJ_STRIDE; const bf16* DAV = DAQ + 2 * PROJ_STRIDE;
    const int q0 = qb * 128, rw = q0 + 32 * g + r32;
    const bf16* Qw = DAQ + ((size_t)b * SEQ + rw) * PW + h * 128 + c * 64 + hi * 8;
    bf16x8 qr[4];
#pragma unroll
    for (int d0 = 0; d0 < 4; ++d0) qr[d0] = *(const bf16x8*)(Qw + d0 * 16);
    const bf16* Kh = DAK + (size_t)b * SEQ * PW + h * 128; const bf16* Vh = DAV + (size_t)b * SEQ * PW + h * 128;
    const int NT = (q0 + 128) / 64;
    const float slope2 = __builtin_amdgcn_exp2f(-2.0f * (float)(h + 1)) * LOG2E;
    bf16x8 qx = {0, 0, 0, 0, 0, 0, 0, 0}, kx0 = qx, kx1 = qx;
    { const unsigned short shi = (unsigned short)f2bf(slope2); const unsigned short slo = (unsigned short)f2bf(slope2 - bf2f(shi));
      if (hi == 0) { qx[0] = (short)shi; qx[1] = (short)slo; const short k0 = (short)f2bf((float)r32), k1 = (short)f2bf((float)(32 + r32)); kx0[0] = k0; kx0[1] = k0; kx1[0] = k1; kx1[1] = k1; } }
    float m_reg = -1e30f, l_reg = 0; f32x16 o[4] = {};
    const int sr = tid >> 4, sc = (tid & 15) * 8, vst0 = v_st(sr, sc), vst1 = v_st(32 + sr, sc);
    const int vb0 = (int)(uintptr_t)V_lds + v_rd_base(lane);
    struct { bf16x8 vs0, vs1, ks0, ks1; } sr_[1];
#define SLOAD(i, k0) do { sr_[i].vs0 = *(const bf16x8*)(&Vh[(size_t)((k0) + sr) * PW + sc]); sr_[i].vs1 = *(const bf16x8*)(&Vh[(size_t)((k0) + 32 + sr) * PW + sc]); \
    sr_[i].ks0 = *(const bf16x8*)(&Kh[(size_t)((k0) + sr) * PW + sc]); sr_[i].ks1 = *(const bf16x8*)(&Kh[(size_t)((k0) + 32 + sr) * PW + sc]); } while (0)
#define SWRITE(bf, i) do { *(LAS bf16x8*)(V_lds + (bf) * SHM_T + vst0) = sr_[i].vs0; *(LAS bf16x8*)(V_lds + (bf) * SHM_T + vst1) = sr_[i].vs1; const int kc = sc * 2; \
    *(LAS bf16x8*)(K_lds + (bf) * SHM_T + KSWZ(sr, kc)) = sr_[i].ks0; *(LAS bf16x8*)(K_lds + (bf) * SHM_T + KSWZ(32 + sr, kc)) = sr_[i].ks1; } while (0)
#define SWAIT() asm volatile("s_waitcnt vmcnt(0)" ::: "memory")
#define RESC(a) do { if (__any((a) < 1.f)) { if (hi == 0) al_l[r32] = (a); asm volatile("s_waitcnt lgkmcnt(0)" ::: "memory"); \
    _Pragma("unroll") for (int d = 0; d < 4; ++d) _Pragma("unroll") for (int r = 0; r < 16; ++r) o[d][r] *= al_l[crow(r, hi)]; } } while (0)
#define TJ(j) (slope2 * 64.f * (float)((j) - NT))
    f32x16 pA0, pA1, pB0, pB1; float alA, alB; bf16x8 pa0, pa1, pa2, pa3; const int cbase = c * 128;
    constexpr int SE = 0, SO = 0;
    SLOAD(SE, 0); asm volatile("s_waitcnt vmcnt(0)" ::: "memory"); SWRITE(0, SE); __syncthreads();
    qkt4(pA0, pA1, K_lds, qr, kx0, kx1, qx, r32, hi, cbase); partialSM(pA0, pA1, m_reg, alA, TJ(0), 0 >= NT - 2, 0, rw, hi);
    SLOAD(SO, 64);
    SWAIT(); SWRITE(1, SO); __syncthreads();
    for (int j = 1; j + 1 < NT; j += 2) {
        SBAR(); qkt4(pB0, pB1, K_lds + SHM_T, qr, kx0, kx1, qx, r32, hi, cbase);
        finishSM(pA0, pA1, alA, l_reg, pa0, pa1, pa2, pa3); SBAR();
        SLOAD(SO, (j + 1) * 64); SBAR();
        pv_d0(o, vb0, pa0, pa1, pa2, pa3); partialSM(pB0, pB1, m_reg, alB, TJ(j), j >= NT - 2, 64 * j, rw, hi);
        __syncthreads(); SWAIT(); SWRITE(0, SE);
        RESC(alB); __syncthreads();
        SBAR(); qkt4(pA0, pA1, K_lds, qr, kx0, kx1, qx, r32, hi, cbase);
        finishSM(pB0, pB1, alB, l_reg, pa0, pa1, pa2, pa3); SBAR();
        SLOAD(SE, (j + 2) * 64); SBAR();
        pv_d0(o, vb0 + SHM_T, pa0, pa1, pa2, pa3); partialSM(pA0, pA1, m_reg, alA, TJ(j + 1), j + 1 >= NT - 2, 64 * (j + 1), rw, hi);
        __syncthreads(); SWAIT(); SWRITE(1, SO);
        RESC(alA); __syncthreads();
    }
    SBAR(); qkt4(pB0, pB1, K_lds + SHM_T, qr, kx0, kx1, qx, r32, hi, cbase);
    finishSM(pA0, pA1, alA, l_reg, pa0, pa1, pa2, pa3); SBAR();
    pv_d0(o, vb0, pa0, pa1, pa2, pa3); partialSM(pB0, pB1, m_reg, alB, TJ(NT - 1), true, 64 * (NT - 1), rw, hi);
    __syncthreads(); RESC(alB);
    finishSM(pB0, pB1, alB, l_reg, pa0, pa1, pa2, pa3); SBAR();
    pv_d0(o, vb0 + SHM_T, pa0, pa1, pa2, pa3);
    asm volatile("s_waitcnt vmcnt(0)" ::: "memory");
#undef SLOAD
#undef SWRITE
#undef SWAIT
#undef RESC
#undef TJ
#ifdef DATT_NO_EPI
    if (l_reg == 123.f) F.out[tid] = o[0][0] + o[1][1] + o[2][2] + o[3][3];
    return;
#endif
    if (hi == 0) li_l[r32] = l_reg; asm volatile("s_waitcnt lgkmcnt(0)" ::: "memory");
    float rli[16];
#pragma unroll
    for (int r = 0; r < 16; ++r) rli[r] = __builtin_amdgcn_rcpf(li_l[crow(r, hi)]);
    __syncthreads();
    LAS float* xb = (LAS float*)lds + g * 4096;
    if (c == 1) {
#pragma unroll
        for (int d = 0; d < 4; ++d)
#pragma unroll
            for (int r = 0; r < 16; ++r) xb[(d * 16 + r) * 64 + lane] = o[d][r] * rli[r];
    }
    __syncthreads();
    if (c == 0) {
        const float* gsub = F.in[11];
        float ssq[16];
#pragma unroll
        for (int r = 0; r < 16; ++r) ssq[r] = 0.f;
#pragma unroll
        for (int d = 0; d < 4; ++d)
#pragma unroll
            for (int r = 0; r < 16; ++r) { const float v = o[d][r] * rli[r] - lam * xb[(d * 16 + r) * 64 + lane]; o[d][r] = v; ssq[r] += v * v; }
#pragma unroll
        for (int r = 0; r < 16; ++r) ssq[r] = (1.0f - LAM_INIT) / sqrtf(half_sum32(ssq[r]) * (1.f / 128.f) + SUBLN_EPS);
        bf16* MIX = WSP(bf16, WS_H1) + ((size_t)b * SEQ + q0 + 32 * g) * DM + h * 128;
        store_rows(o, ssq, gsub, xb, MIX, DM, nullptr, 0, lane);
    }
    __syncthreads();
}

constexpr int MCH = 256, NCH = SEQ / MCH;

__device__ __forceinline__ void conv8(const bf16* raw, size_t rb, int t, int col0, const f32x4 (&w)[4][2], const f32x4 (&bias)[2], float scale, float (&y)[8]) {
#pragma unroll
    for (int i = 0; i < 8; ++i) y[i] = bias[i >> 2][i & 3];
#pragma unroll
    for (int j = 0; j < 4; ++j) { const int tt = t - 3 + j;
        if (tt >= 0) { const bf16x8 v = *(const bf16x8*)(raw + (rb + tt) * PW + col0);
#pragma unroll
            for (int i = 0; i < 8; ++i) y[i] += w[j][i >> 2][i & 3] * bf2f((unsigned short)v[i]); } }
#pragma unroll
    for (int i = 0; i < 8; ++i) y[i] = y[i] / (1.0f + __expf(-y[i])) * scale;
}
__device__ __forceinline__ bf16x8 pack8(const float (&y)[8]) { u32x4 w = {cvtpk(y[0], y[1]), cvtpk(y[2], y[3]), cvtpk(y[4], y[5]), cvtpk(y[6], y[7])}; return __builtin_bit_cast(bf16x8, w); }
__device__ __forceinline__ void load_convw(const float* conv_w, const float* conv_b, int ch0, f32x4 (&w)[4][2], f32x4 (&bias)[2]) {
#pragma unroll
    for (int j = 0; j < 4; ++j) { w[j][0] = *(const f32x4*)(conv_w + j * 1024 + ch0); w[j][1] = *(const f32x4*)(conv_w + j * 1024 + ch0 + 4); }
    bias[0] = *(const f32x4*)(conv_b + ch0); bias[1] = *(const f32x4*)(conv_b + ch0 + 4);
}
__device__ __forceinline__ void split3(float x, short& a, short& b, short& c) {
    const unsigned short h = (unsigned short)f2bf(x); const float r1 = x - bf2f(h); const unsigned short m = (unsigned short)f2bf(r1); const float r2 = r1 - bf2f(m); const unsigned short l = (unsigned short)f2bf(r2);
    a = (short)h; b = (short)m; c = (short)l;
}

__device__ __forceinline__ void mlstm_state_item(Frame& F, int bh, int c) {
    const int tid = F.tid, wid = F.wave, lane = F.lane, r32 = lane & 31, hi = lane >> 5;
    const int b = bh >> 2, hh = bh & 3, t0 = c * MCH;
    LAS char* lds = (LAS char*)F.lds; LAS char* Kimg = lds; LAS char* Vimg = lds + 4 * SHM_T;
    const bf16* MLK = WSP(bf16, WS_PROJ) + 4 * PROJ_STRIDE; const bf16* MLV = WSP(bf16, WS_PROJ) + 5 * PROJ_STRIDE;
    const float* A2 = WSP(float, WS_A2) + (size_t)bh * SEQ + t0;
    float am = (tid < MCH) ? A2[tid] : -3.0e38f; am = wave_max(am);
    LAS float* red = (LAS float*)(lds + XTRA_OFF);
    if (lane == 0) red[wid] = am;
    __syncthreads();
    float mloc = red[0];
#pragma unroll
    for (int w = 1; w < 8; ++w) mloc = fmaxf(mloc, red[w]);
    if (tid == 0) WSP(float, WS_MLOC)[bh * NCH + c] = mloc;
    const int cg = tid & 15; const size_t rb = (size_t)b * SEQ;
    f32x4 cw[4][2], cb[2]; load_convw(F.in[3], F.in[4], 512 + hh * 128 + cg * 8, cw, cb);
#pragma unroll 2
    for (int i = 0; i < 8; ++i) { const int row = (tid >> 4) + 32 * i, t = t0 + row; float y[8];
        conv8(MLK, rb, t, hh * 128 + cg * 8, cw, cb, MLK_SCALE, y);
        const float wgt = __builtin_amdgcn_exp2f(A2[row] - mloc);
#pragma unroll
        for (int e = 0; e < 8; ++e) y[e] *= wgt;
        *(LAS bf16x8*)(Kimg + (row >> 6) * SHM_T + v_st(row & 63, cg * 8)) = pack8(y);
        *(LAS bf16x8*)(Vimg + (row >> 6) * SHM_T + v_st(row & 63, cg * 8)) = *(const bf16x8*)(MLV + (rb + t) * PW + hh * 128 + cg * 8); }
    __syncthreads();
    const int id0 = wid * 2, dvb = id0 >> 2, dkb0 = id0 & 3;
    f32x16 acc0 = {}, acc1 = {}, accn = {};
    const bf16x8 ones = {0x3F80, 0x3F80, 0x3F80, 0x3F80, 0x3F80, 0x3F80, 0x3F80, 0x3F80};
    const int vbK = (int)(uintptr_t)Kimg + v_rd_base(lane), vbV = (int)(uintptr_t)Vimg + v_rd_base(lane);
#define ST_STEP(KS) do { \
        bf16x8 af, b0f, b1f, bnf; \
        af = (dvb == 0) ? tr_frag<0, KS>(vbV + tt * SHM_T) : (dvb == 1) ? tr_frag<1, KS>(vbV + tt * SHM_T) : (dvb == 2) ? tr_frag<2, KS>(vbV + tt * SHM_T) : tr_frag<3, KS>(vbV + tt * SHM_T); \
        if (dkb0 == 0) { b0f = tr_frag<0, KS>(vbK + tt * SHM_T); b1f = tr_frag<1, KS>(vbK + tt * SHM_T); } else { b0f = tr_frag<2, KS>(vbK + tt * SHM_T); b1f = tr_frag<3, KS>(vbK + tt * SHM_T); } \
        acc0 = MFMA32(af, b0f, acc0); acc1 = MFMA32(af, b1f, acc1); \
        if (wid < 4) { bnf = (wid == 0) ? tr_frag<0, KS>(vbK + tt * SHM_T) : (wid == 1) ? tr_frag<1, KS>(vbK + tt * SHM_T) : (wid == 2) ? tr_frag<2, KS>(vbK + tt * SHM_T) : tr_frag<3, KS>(vbK + tt * SHM_T); \
            accn = MFMA32(ones, bnf, accn); } } while (0)
    for (int tt = 0; tt < 4; ++tt) { ST_STEP(0); ST_STEP(1); ST_STEP(2); ST_STEP(3); }
#undef ST_STEP
    float* DCT = WSP(float, WS_DCT) + ((size_t)(bh * NCH + c) << 14);
#pragma unroll
    for (int r = 0; r < 16; ++r) { const int dv = 32 * dvb + crow(r, hi);
        DCT[dv * 128 + 32 * dkb0 + r32] = acc0[r]; DCT[dv * 128 + 32 * (dkb0 + 1) + r32] = acc1[r]; }
    if (wid < 4 && hi == 0) WSP(float, WS_DN)[(size_t)(bh * NCH + c) * 128 + 32 * wid + r32] = accn[0];
    __syncthreads();
}

__device__ __forceinline__ void mlstm_out_unit(Frame& F, int bh, int c) {
    const int tid = F.tid, wid = F.wave, lane = F.lane, r32 = lane & 31, hi = lane >> 5;
    const int b = bh >> 2, hh = bh & 3, t0 = c * MCH; const size_t rb = (size_t)b * SEQ;
    LAS char* lds = (LAS char*)F.lds; LAS char* Kimg = lds; LAS char* Vimg = lds + 4 * SHM_T; LAS char* Cimg = lds + 4 * SHM_T; LAS float* nref = (LAS float*)(lds + 6 * SHM_T);
    LAS float* ws = (LAS float*)(lds + WSCR_OFF) + wid * 128; LAS float* f_l = ws; LAS float* rn_l = ws + 32;
    const bf16* MLQ = WSP(bf16, WS_PROJ) + 3 * PROJ_STRIDE; const bf16* MLK = MLQ + PROJ_STRIDE; const bf16* MLV = MLQ + 2 * PROJ_STRIDE; const bf16* MLO = MLQ + 3 * PROJ_STRIDE;
    const float* A2 = WSP(float, WS_A2) + (size_t)bh * SEQ; const float* M2 = WSP(float, WS_M2) + (size_t)bh * SEQ; const float* NB2 = WSP(float, WS_NB2) + (size_t)bh * SEQ;
    const int trow = t0 + 32 * wid + r32;
    const float m2t = M2[trow], nb2t = NB2[trow];
    const float mref2 = (c > 0) ? M2[t0 - 1] : -1e30f;
    { const int cg = tid & 15; f32x4 cw[4][2], cb[2]; load_convw(F.in[3], F.in[4], hh * 128 + cg * 8, cw, cb);
#pragma unroll 2
      for (int i = 0; i < 8; ++i) { const int row = (tid >> 4) + 32 * i; float y[8];
          conv8(MLQ, rb, t0 + row, hh * 128 + cg * 8, cw, cb, 1.0f, y);
          *(LAS bf16x8*)(Kimg + (row >> 6) * SHM_T + KSWZ(row & 63, cg * 16)) = pack8(y); } }
    __syncthreads();
    bf16x8 qr[8];
    { const int row = 32 * wid + r32;
#pragma unroll
      for (int d0 = 0; d0 < 8; ++d0) qr[d0] = *(const LAS bf16x8*)(Kimg + (row >> 6) * SHM_T + KSWZ(row & 63, (d0 * 16 + hi * 8) * 2)); }
    f32x16 o[4] = {}; float den = 0.f;
    if (c > 0) {
        const float* ML = WSP(float, WS_MLOC) + bh * NCH; const float* DCT = WSP(float, WS_DCT) + ((size_t)(bh * NCH) << 14); const float* DN = WSP(float, WS_DN) + (size_t)(bh * NCH) * 128;
        { const int dv = tid >> 2, dk0 = (tid & 3) * 32; f32x4 a[8];
#pragma unroll
          for (int i = 0; i < 8; ++i) a[i] = (f32x4){0.f, 0.f, 0.f, 0.f};
          for (int cp = 0; cp < c; ++cp) { const float cf = __builtin_amdgcn_exp2f(ML[cp] - mref2); const f32x4* src = (const f32x4*)(DCT + ((size_t)cp << 14) + dv * 128 + dk0);
#pragma unroll
              for (int i = 0; i < 8; ++i) a[i] += src[i] * cf; }
#pragma unroll
          for (int i = 0; i < 4; ++i) { u32x4 w = {cvtpk(a[2 * i][0], a[2 * i][1]), cvtpk(a[2 * i][2], a[2 * i][3]), cvtpk(a[2 * i + 1][0], a[2 * i + 1][1]), cvtpk(a[2 * i + 1][2], a[2 * i + 1][3])};
              *(LAS u32x4*)(Cimg + KSWZ(dv, (dk0 + 8 * i) * 2)) = w; }
          if (tid < 128) { float s = 0.f; for (int cp = 0; cp < c; ++cp) s += DN[cp * 128 + tid] * __builtin_amdgcn_exp2f(ML[cp] - mref2); nref[tid] = s; } }
        __syncthreads();
#pragma unroll
        for (int d = 0; d < 4; ++d)
#pragma unroll
            for (int ks = 0; ks < 8; ++ks) { const bf16x8 cf = *(const LAS bf16x8*)(Cimg + KSWZ(32 * d + r32, (16 * ks + 8 * hi) * 2)); o[d] = MFMA32(qr[ks], cf, o[d]); }
        float dn = 0.f;
#pragma unroll
        for (int ks = 0; ks < 8; ++ks) { const f32x4 n0 = *(const LAS f32x4*)(nref + 16 * ks + 8 * hi), n1 = *(const LAS f32x4*)(nref + 16 * ks + 8 * hi + 4);
#pragma unroll
            for (int j = 0; j < 4; ++j) { dn += bf2f((unsigned short)qr[ks][j]) * n0[j]; dn += bf2f((unsigned short)qr[ks][4 + j]) * n1[j]; } }
        dn = half_swap_add(dn);
        const float ft = __builtin_amdgcn_exp2f(mref2 - m2t);
        den = ft * dn;
        if (hi == 0) f_l[r32] = ft; asm volatile("s_waitcnt lgkmcnt(0)" ::: "memory");
#pragma unroll
        for (int d = 0; d < 4; ++d)
#pragma unroll
            for (int r = 0; r < 16; ++r) o[d][r] *= f_l[crow(r, hi)];
        __syncthreads();
    }
    __syncthreads();
    { const int cg = tid & 15; f32x4 cw[4][2], cb[2]; load_convw(F.in[3], F.in[4], 512 + hh * 128 + cg * 8, cw, cb);
#pragma unroll 1
      for (int i = 0; i < 8; ++i) { const int row = (tid >> 4) + 32 * i, t = t0 + row; float y[8];
          conv8(MLK, rb, t, hh * 128 + cg * 8, cw, cb, MLK_SCALE, y);
          *(LAS bf16x8*)(Kimg + (row >> 6) * SHM_T + KSWZ(row & 63, cg * 16)) = pack8(y);
          *(LAS bf16x8*)(Vimg + (row >> 6) * SHM_T + v_st(row & 63, cg * 8)) = *(const bf16x8*)(MLV + (rb + t) * PW + hh * 128 + cg * 8); } }
    __syncthreads();
    bf16x8 qx = {0, 0, 0, 0, 0, 0, 0, 0};
    if (hi == 0) { short a, bq, cq; split3(-m2t, a, bq, cq); qx[0] = 0x3F80; qx[1] = 0x3F80; qx[2] = 0x3F80; qx[3] = a; qx[4] = bq; qx[5] = cq; }
    const int ntile = (wid >> 1) + 1;
    for (int jt = 0; jt < ntile; ++jt) {
        const LAS char* Ks = Kimg + jt * SHM_T;
        bf16x8 kx0 = {0, 0, 0, 0, 0, 0, 0, 0}, kx1 = kx0;
        if (hi == 0) { short a, bq, cq; split3(A2[t0 + 64 * jt + r32], a, bq, cq); kx0[0] = a; kx0[1] = bq; kx0[2] = cq; kx0[3] = 0x3F80; kx0[4] = 0x3F80; kx0[5] = 0x3F80;
                       split3(A2[t0 + 64 * jt + 32 + r32], a, bq, cq); kx1[0] = a; kx1[1] = bq; kx1[2] = cq; kx1[3] = 0x3F80; kx1[4] = 0x3F80; kx1[5] = 0x3F80; }
        f32x16 e0 = MFMA32(kx0, qx, f32x16{}), e1 = MFMA32(kx1, qx, f32x16{});
        f32x16 p0 = {}, p1 = {};
#pragma unroll
        for (int d0 = 0; d0 < 8; ++d0) { const int cbb = (d0 * 16 + hi * 8) * 2;
            const bf16x8 b0 = *(const LAS bf16x8*)(Ks + KSWZ(r32, cbb)); const bf16x8 b1 = *(const LAS bf16x8*)(Ks + KSWZ(32 + r32, cbb));
            p0 = MFMA32(b0, qr[d0], p0); p1 = MFMA32(b1, qr[d0], p1); }
        const bool diag = (jt == ntile - 1); const int qrel = 32 * wid + r32 - 64 * jt;
        float ps = 0.f;
#pragma unroll
        for (int r = 0; r < 16; ++r) { const int kv = crow(r, hi);
            float v0 = p0[r] * __builtin_amdgcn_exp2f(fminf(e0[r], 0.f)), v1 = p1[r] * __builtin_amdgcn_exp2f(fminf(e1[r], 0.f));
            if (diag) { if (kv > qrel) v0 = 0.f; if (kv + 32 > qrel) v1 = 0.f; }
            p0[r] = v0; p1[r] = v1; ps += v0 + v1; }
        den += half_swap_add(ps);
        bf16x8 pa0, pa1, pa2, pa3; pack_p(p0, p1, pa0, pa1, pa2, pa3);
        pv_d0(o, (int)(uintptr_t)(Vimg + jt * SHM_T) + v_rd_base(lane), pa0, pa1, pa2, pa3);
    }
    { const float nrm = fmaxf(fabsf(den), __builtin_amdgcn_exp2f(nb2t));
      if (hi == 0) rn_l[r32] = 1.0f / nrm; asm volatile("s_waitcnt lgkmcnt(0)" ::: "memory"); }
    const float* gml = F.in[12] + hh * 128;
    float ssq[16];
#pragma unroll
    for (int r = 0; r < 16; ++r) { const float rn = rn_l[crow(r, hi)]; float s = 0.f;
#pragma unroll
        for (int d = 0; d < 4; ++d) { o[d][r] *= rn; s += o[d][r] * o[d][r]; }
        ssq[r] = s; }
#pragma unroll
    for (int r = 0; r < 16; ++r) ssq[r] = 1.0f / sqrtf(half_sum32(ssq[r]) * (1.f / 128.f) + NORM_EPS);
    __syncthreads();
    bf16* MIX = WSP(bf16, WS_H1) + (rb + t0 + 32 * wid) * DM + 512 + hh * 128;
    const bf16* Og = MLO + (rb + t0 + 32 * wid) * PW + hh * 128;
    store_rows(o, ssq, gml, (LAS float*)lds + wid * 4096, MIX, DM, Og, PW, lane);
    __syncthreads();
}
}

namespace peer {
using att::f32x16; using att::crow;
__device__ __forceinline__ unsigned ordf(float f) { const unsigned u = __float_as_uint(f); return u ^ ((u >> 31) ? 0xFFFFFFFFu : 0x80000000u); }
__device__ __forceinline__ float unordf(unsigned k) { return __uint_as_float(k ^ ((k >> 31) ? 0x80000000u : 0xFFFFFFFFu)); }
#define CAS_D(a, b) do { const unsigned _x = (a) > (b) ? (a) : (b), _n = (a) > (b) ? (b) : (a); (a) = _x; (b) = _n; } while (0)
template <bool DESC> __device__ __forceinline__ void bsort16(unsigned (&v)[16]) {
#pragma unroll
    for (int k = 2; k <= 16; k <<= 1)
#pragma unroll
        for (int j = k >> 1; j > 0; j >>= 1)
#pragma unroll
            for (int i = 0; i < 16; ++i) { const int l = i ^ j; if (l > i) { const bool asc = (((i & k) == 0) != DESC); if (asc) CAS_D(v[l], v[i]); else CAS_D(v[i], v[l]); } }
}
__device__ __forceinline__ void bmerge16_desc(unsigned (&v)[16]) {
#pragma unroll
    for (int j = 8; j > 0; j >>= 1)
#pragma unroll
        for (int i = 0; i < 16; ++i) { const int l = i ^ j; if (l > i) CAS_D(v[i], v[l]); }
}
__device__ __forceinline__ void merge_in(unsigned (&T)[16], unsigned (&N)[16]) {
    bsort16<false>(N);
#pragma unroll
    for (int i = 0; i < 16; ++i) T[i] = T[i] > N[i] ? T[i] : N[i];
    bmerge16_desc(T);
}
__device__ __forceinline__ void top16_of_tile(const f32x16 (&acc)[4], int hi, unsigned (&T)[16]) {
    unsigned N[16];
#pragma unroll
    for (int r = 0; r < 16; ++r) T[r] = (ordf(acc[0][r]) & ~0x7Fu) | (unsigned)(crow(r, hi));
    bsort16<true>(T);
#pragma unroll
    for (int mt = 1; mt < 4; ++mt) {
#pragma unroll
        for (int r = 0; r < 16; ++r) N[r] = (ordf(acc[mt][r]) & ~0x7Fu) | (unsigned)(32 * mt + crow(r, hi));
        merge_in(T, N); }
#pragma unroll
    for (int i = 0; i < 16; ++i) N[i] = (unsigned)__shfl_xor((int)T[15 - i], 32);
#pragma unroll
    for (int i = 0; i < 16; ++i) T[i] = T[i] > N[i] ? T[i] : N[i];
    bmerge16_desc(T);
}
struct CandTab { unsigned char ij[64]; };
constexpr CandTab make_cands() { CandTab t{}; int n = 0; for (int i = 0; i < 16; ++i) for (int j = 0; j < 16; ++j) if ((i + 1) * (j + 1) <= 16) t.ij[n++] = (unsigned char)(i * 16 + j); for (; n < 64; ++n) t.ij[n] = 255; return t; }
constexpr CandTab CANDS = make_cands();

__device__ __forceinline__ void peer_topk_phase(Frame& F) {
    const int tid = F.tid, wid = F.wave, lane = F.lane, r32 = lane & 31, hi = lane >> 5;
    const int h = F.vcu & 7, bq = F.vcu >> 3, nbq = F.G >> 3;
    LAS char* lds = (LAS char*)F.lds;
    const bf16* SK = WSP(bf16, WS_SUBK) + (size_t)h * 2 * 128 * 128;
    for (int i = tid; i < 4096; i += NTHR) { const int cc = i >> 11, r = (i >> 4) & 127, ch = i & 15;
        *(LAS bf16x8*)(lds + cc * 32768 + KSWZ(r, ch * 16)) = *(const bf16x8*)(SK + (size_t)cc * 16384 + r * 128 + ch * 8); }
    __syncthreads();
    const bf16* QP = (h < 4) ? WSP(bf16, WS_H1) + h * 256 : WSP(bf16, WS_QPB) + (h - 4) * 256;
    LAS unsigned char* ixs = (LAS unsigned char*)(lds + XTRA_OFF) + tid * 32;
    unsigned long long* PE = WSP(unsigned long long, WS_PE);
    for (int tg = bq * NWAVES + wid; tg < M / 32; tg += nbq * NWAVES) {
        const int tok = tg * 32 + r32;
        unsigned T1[16], T2[16];
#pragma unroll
        for (int cc = 0; cc < 2; ++cc) {
            bf16x8 qf[8];
#pragma unroll
            for (int ks = 0; ks < 8; ++ks) qf[ks] = *(const bf16x8*)(QP + (size_t)tok * DM + cc * 128 + 16 * ks + 8 * hi);
            f32x16 acc[4];
#pragma unroll
            for (int mt = 0; mt < 4; ++mt) { acc[mt] = f32x16{};
#pragma unroll
                for (int ks = 0; ks < 8; ++ks) { const bf16x8 af = *(const LAS bf16x8*)(lds + cc * 32768 + KSWZ(32 * mt + r32, (16 * ks + 8 * hi) * 2)); acc[mt] = MFMA32(af, qf[ks], acc[mt]); } }
            if (cc == 0) top16_of_tile(acc, hi, T1); else top16_of_tile(acc, hi, T2);
        }
        { v4u w1, w2;
#pragma unroll
          for (int q = 0; q < 4; ++q) { w1[q] = (T1[4 * q] & 0x7F) | ((T1[4 * q + 1] & 0x7F) << 8) | ((T1[4 * q + 2] & 0x7F) << 16) | ((T1[4 * q + 3] & 0x7F) << 24);
                                        w2[q] = (T2[4 * q] & 0x7F) | ((T2[4 * q + 1] & 0x7F) << 8) | ((T2[4 * q + 2] & 0x7F) << 16) | ((T2[4 * q + 3] & 0x7F) << 24); }
          *(LAS v4u*)ixs = w1; *(LAS v4u*)(ixs + 16) = w2; }
        float s1[16], s2[16];
#pragma unroll
        for (int i = 0; i < 16; ++i) { s1[i] = unordf(T1[i] & ~0x7Fu); s2[i] = unordf(T2[i] & ~0x7Fu); }
        unsigned R[16], N[16];
#pragma unroll
        for (int ch = 0; ch < 4; ++ch) {
#pragma unroll
            for (int q = 0; q < 16; ++q) { const int ij = CANDS.ij[ch * 16 + q]; const unsigned kk = (ij == 255) ? 0u : ((ordf(s1[(ij >> 4) & 15] + s2[ij & 15]) & ~0xFFu) | (unsigned)ij);
                if (ch == 0) R[q] = kk; else N[q] = kk; }
            if (ch == 0) bsort16<true>(R); else merge_in(R, N); }
        asm volatile("s_waitcnt lgkmcnt(0)" ::: "memory");
        const float mx = unordf(R[0] & ~0xFFu); float ev[16], es = 0.f;
#pragma unroll
        for (int k = 0; k < 16; ++k) { ev[k] = __expf(unordf(R[k] & ~0xFFu) - mx); es += ev[k]; }
        const float inv = 1.0f / es;
        if (hi == 0) {
#pragma unroll
            for (int k = 0; k < 16; k += 2) { v4u w;
                w[0] = (unsigned)ixs[(R[k] >> 4) & 15] * 128u + (unsigned)ixs[16 + (R[k] & 15)]; w[1] = __float_as_uint(ev[k] * inv);
                w[2] = (unsigned)ixs[(R[k + 1] >> 4) & 15] * 128u + (unsigned)ixs[16 + (R[k + 1] & 15)]; w[3] = __float_as_uint(ev[k + 1] * inv);
                *(v4u*)(PE + (size_t)tok * 128 + h * 16 + k) = w; }
        }
    }
    __syncthreads();
}

__device__ __forceinline__ float gelu_erf(float a) { return 0.5f * a * (1.0f + erff(a * 0.70710678118654752f)); }
__device__ __forceinline__ void peer_gather_phase(Frame& F) {
    const int lane = F.lane; const int gw = F.vcu * NWAVES + F.wave, NGW = F.G * NWAVES;
    const float* X1 = WSP(float, WS_X1); const float* SSP = WSP(float, WS_SSP); const bf16* UB = WSP(bf16, WS_UB); const bf16* VB = WSP(bf16, WS_VB);
    const unsigned long long* PE = WSP(unsigned long long, WS_PE); const float* fg = F.in[19];
    for (int t = gw; t < M; t += NGW) {
        float xv[16];
        { const f32x4* xp = (const f32x4*)(X1 + (size_t)t * DM + 8 * lane);
#pragma unroll
          for (int j = 0; j < 2; ++j) { const f32x4 a = xp[128 * j], b = xp[128 * j + 1];
#pragma unroll
              for (int i = 0; i < 4; ++i) { xv[8 * j + i] = a[i]; xv[8 * j + 4 + i] = b[i]; } } }
        float rstd;
        { const f32x4* sp = (const f32x4*)(SSP + (size_t)t * 16); const f32x4 a = sp[0], b = sp[1], c = sp[2], d = sp[3];
          const float s = ((a[0] + a[1]) + (a[2] + a[3])) + ((b[0] + b[1]) + (b[2] + b[3])) + ((c[0] + c[1]) + (c[2] + c[3])) + ((d[0] + d[1]) + (d[2] + d[3]));
          rstd = 1.0f / sqrtf(s * (1.0f / 1024.0f) + NORM_EPS); }
        float acc[16];
#pragma unroll
        for (int i = 0; i < 16; ++i) acc[i] = 0.f;
        const unsigned long long* pe = PE + (size_t)t * 128;
        for (int p0 = 0; p0 < 128; p0 += 4) {
            unsigned long long ent[4]; bf16x8 ur[4][2], vr[4][2];
#pragma unroll
            for (int k = 0; k < 4; ++k) ent[k] = pe[p0 + k];
#pragma unroll
            for (int k = 0; k < 4; ++k) { const size_t eo = (size_t)(unsigned)(ent[k] & 0xFFFFFFFFull) * DM + 8 * lane;
                ur[k][0] = *(const bf16x8*)(UB + eo); ur[k][1] = *(const bf16x8*)(UB + eo + 512); vr[k][0] = *(const bf16x8*)(VB + eo); vr[k][1] = *(const bf16x8*)(VB + eo + 512); }
#pragma unroll
            for (int k = 0; k < 4; ++k) { float d = 0.f;
#pragma unroll
                for (int j = 0; j < 2; ++j)
#pragma unroll
                    for (int i = 0; i < 8; ++i) d += bf2f((unsigned short)ur[k][j][i]) * xv[8 * j + i];
                d = wave_sum(d);
                const float w = __uint_as_float((unsigned)(ent[k] >> 32)) * gelu_erf(d * rstd);
#pragma unroll
                for (int j = 0; j < 2; ++j)
#pragma unroll
                    for (int i = 0; i < 8; ++i) acc[8 * j + i] += w * bf2f((unsigned short)vr[k][j][i]); }
        }
        float s = 0.f;
#pragma unroll
        for (int i = 0; i < 16; ++i) { acc[i] += xv[i]; s += acc[i] * acc[i]; }
        const float rs = 1.0f / sqrtf(wave_sum(s) * (1.0f / 1024.0f) + NORM_EPS);
        f32x4* op = (f32x4*)(F.out + (size_t)t * DM + 8 * lane); const f32x4* gp = (const f32x4*)(fg + 8 * lane);
#pragma unroll
        for (int j = 0; j < 2; ++j) { const f32x4 ga = gp[128 * j], gb = gp[128 * j + 1];
            op[128 * j] = (f32x4){acc[8 * j] * rs * ga[0], acc[8 * j + 1] * rs * ga[1], acc[8 * j + 2] * rs * ga[2], acc[8 * j + 3] * rs * ga[3]};
            op[128 * j + 1] = (f32x4){acc[8 * j + 4] * rs * gb[0], acc[8 * j + 5] * rs * gb[1], acc[8 * j + 6] * rs * gb[2], acc[8 * j + 7] * rs * gb[3]}; }
    }
}
}

#ifndef MK_N_LAUNCHES
#define MK_N_LAUNCHES 1
#endif
constexpr int N_PHASES = 8;
struct Args { const float* in[20]; float* out; unsigned char* ws; int ph_lo, ph_hi; };

__global__ void __launch_bounds__(NTHR, 2) mega_fwd(Args args) {
    extern __shared__ __attribute__((aligned(16))) unsigned char lds_raw[];
    Frame F;
    F.lds = (LAS unsigned char*)lds_raw; F.ldsg = lds_raw;
    F.MISC = (volatile LAS unsigned*)(F.lds + MISC_OFF);
    F.tid = threadIdx.x; F.lane = F.tid & 63; F.wave = __builtin_amdgcn_readfirstlane(F.tid >> 6);
    F.G = gridDim.x; { const int bx = blockIdx.x; F.vcu = (F.G % 8 == 0) ? (bx % 8) * (F.G / 8) + bx / 8 : bx; }
#pragma unroll
    for (int i = 0; i < 20; ++i) F.in[i] = args.in[i];
    F.out = args.out; F.ws = args.ws; F.ctl = (gu32*)(args.ws + WS_CTL);
    for (int u = F.tid; u < 512 / 4; u += NTHR) ((LAS unsigned*)(F.lds + MISC_OFF))[u] = 0u;
    __syncthreads();
    const int lo = args.ph_lo, hi = args.ph_hi;
    const bool one = (hi - lo) > 1;
    XcdBarrier bar; bar.bar = (unsigned*)(F.ctl + CW_BAR); bar.x = 0; bar.st = nullptr;
    if (one) bar = xcd_barrier_post((unsigned*)(F.ctl + CW_BAR), F.MISC + 8);
#ifndef PH_MASK
#define PH_MASK 0xFF
#endif
#define IN(k) ((((PH_MASK) >> (k)) & 1) && lo <= (k) && (k) < hi)
#define SEAM(k) do { if (IN(k) && IN((k) + 1)) xcd_barrier(bar); } while (0)

    if (IN(0)) { p0_prologue(F); } SEAM(0);

    if (IN(1)) {
        pg8::Gemm g{WSP(bf16, WS_H1), WSP(bf16, WS_WIN), M, NPROJ, DM}; pg8::StaticOrder S; S.init(M, NPROJ, F.G, (int)blockIdx.x);
        pg8::EpiBf16S E{WSP(bf16, WS_PROJ), PW, PW, PROJ_STRIDE, QSCALE, nullptr, 0.f};
        pg8::gemm_phase<pg8::EpiBf16S, pg8::StaticOrder, true, true>(F.lds, g, S, E);
        const int sb = (int)blockIdx.x - (F.G - 16);
        if (sb >= 0 && sb < 16 && F.wave == 0) gate_scan(F, sb);
    } SEAM(1);

    if (IN(2)) {
        const float lam = __expf(wave_sum(F.in[7][F.lane] * F.in[8][F.lane])) - __expf(wave_sum(F.in[9][F.lane] * F.in[10][F.lane])) + LAM_INIT;
#ifndef PH2_NO_ATT
        { const int v = F.vcu; if (v < 256) { const int bh = v >> 4, s = v & 15;
            att::dattn_unit(F, bh >> 2, bh & 3, 31 - s, lam); att::dattn_unit(F, bh >> 2, bh & 3, s, lam); } }
#endif
#ifndef PH2_NO_ST
        { const int v = F.vcu; if (v < 16 * 15) att::mlstm_state_item(F, v / 15, v % 15); }
#endif
    } SEAM(2);

    if (IN(3)) {
        { const int v = F.vcu; if (v < 256) att::mlstm_out_unit(F, v >> 4, v & 15); }
    } SEAM(3);

    if (IN(4)) {
        pg8::Gemm g{WSP(bf16, WS_H1), WSP(bf16, WS_WOUT), M, DM, DM}; pg8::StaticOrder S; S.init(M, DM, F.G, (int)blockIdx.x);
        pg8::EpiResid E{F.in[0], WSP(float, WS_X1), WSP(bf16, WS_X1B), WSP(float, WS_SSP), DM};
        pg8::gemm_phase<pg8::EpiResid, pg8::StaticOrder, true, true>(F.lds, g, S, E);
    } SEAM(4);

    if (IN(5)) {
        pg8::Gemm g{WSP(bf16, WS_X1B), WSP(bf16, WS_WPQ), M, 2048, DM}; pg8::StaticOrder S; S.init(M, 2048, F.G, (int)blockIdx.x);
        pg8::EpiBf16S E{WSP(bf16, WS_H1), DM, DM, (size_t)(WS_QPB - WS_H1) / 2, 1.0f, WSP(float, WS_SSP), NORM_EPS};
        pg8::gemm_phase<pg8::EpiBf16S, pg8::StaticOrder, true, true>(F.lds, g, S, E);
    } SEAM(5);

    if (IN(6)) { peer::peer_topk_phase(F); } SEAM(6);

    if (IN(7)) { peer::peer_gather_phase(F); }
#undef IN
#undef SEAM
}

#if defined(MK_CHECK)
__device__ __forceinline__ unsigned hsh(unsigned x) { x ^= x >> 16; x *= 0x7feb352dU; x ^= x >> 15; x *= 0x846ca68bU; x ^= x >> 16; return x; }
__device__ __forceinline__ void chk(unsigned* err, unsigned bit, float a, float ref, float rel, float ab) { if (!(fabsf(a - ref) <= ab + rel * fabsf(ref))) atomicOr(err, bit); }
#define CWS(T, off) ((T*)(a.ws + (off)))
#define CERR ((unsigned*)(a.ws) + CW_ERR)
__device__ __forceinline__ float blk_sum(float v, float* red, int n) { __syncthreads(); red[threadIdx.x] = v; __syncthreads(); for (int s = n / 2; s > 0; s >>= 1) { if ((int)threadIdx.x < s) red[threadIdx.x] += red[threadIdx.x + s]; __syncthreads(); } return red[0]; }
__device__ __forceinline__ float blk_max(float v, float* red, int n) { __syncthreads(); red[threadIdx.x] = v; __syncthreads(); for (int s = n / 2; s > 0; s >>= 1) { if ((int)threadIdx.x < s) red[threadIdx.x] = fmaxf(red[threadIdx.x], red[threadIdx.x + s]); __syncthreads(); } return red[0]; }

__global__ void chk_p0(Args a) {
    __shared__ float hs[1024]; __shared__ float red[256];
    const int m = hsh(blockIdx.x * 7919u + 1u) % M; const float* x = a.in[0] + (size_t)m * DM; const float* g1 = a.in[1];
    float s = 0.f; for (int e = threadIdx.x; e < 1024; e += 256) s += x[e] * x[e];
    const float rstd = 1.0f / sqrtf(blk_sum(s, red, 256) / 1024.f + NORM_EPS);
    for (int e = threadIdx.x; e < 1024; e += 256) { hs[e] = x[e] * rstd * g1[e]; chk(CERR, 0x200u, bf2f(CWS(bf16, WS_H1)[(size_t)m * DM + e]), hs[e], 0.01f, 0.01f); }
    __syncthreads();
    if (threadIdx.x < 8) { const int g = threadIdx.x; float d = 0.f; for (int k = 0; k < 1024; ++k) d += hs[k] * a.in[2][(size_t)k * INCOLS + NPROJ + g];
        const int b = m / SEQ, t = m % SEQ, hh = g & 3; const size_t o = (size_t)(b * 4 + hh) * SEQ + t;
        if (g < 4) chk(CERR, 0x200u, CWS(float, WS_GI)[o], d + a.in[5][hh], 1e-3f, 2e-3f);
        else { const float f = d + a.in[6][hh]; chk(CERR, 0x200u, CWS(float, WS_GLF)[o], -log1pf(expf(-f)), 1e-3f, 2e-3f); } }
    const unsigned sm = hsh(blockIdx.x * 256u + threadIdx.x + 77u);
    { const int n = sm % NPROJ, k = (sm >> 12) % 1024; chk(CERR, 0x100u, bf2f(CWS(bf16, WS_WIN)[(size_t)n * 1024 + k]), a.in[2][(size_t)k * INCOLS + n], 0.01f, 1e-4f); }
    { const int n = sm % 1024, k = (sm >> 12) % 1024; chk(CERR, 0x100u, bf2f(CWS(bf16, WS_WOUT)[(size_t)n * 1024 + k]), a.in[13][(size_t)k * 1024 + n], 0.01f, 1e-4f); }
    { const int n = sm % 2048, k = (sm >> 12) % 1024; chk(CERR, 0x100u, bf2f(CWS(bf16, WS_WPQ)[(size_t)n * 1024 + k]), a.in[15][(size_t)k * 2048 + n] * a.in[14][k], 0.01f, 1e-4f); }
    { const int i = sm % 262144; chk(CERR, 0x100u, bf2f(CWS(bf16, WS_SUBK)[i]), a.in[16][i], 0.01f, 1e-4f); }
    { const size_t i = (size_t)(sm % 16777216u); chk(CERR, 0x100u, bf2f(CWS(bf16, WS_UB)[i]), a.in[17][i] * a.in[14][i & 1023], 0.01f, 1e-4f); chk(CERR, 0x100u, bf2f(CWS(bf16, WS_VB)[i]), a.in[18][i], 0.01f, 1e-4f); }
}
__global__ void chk_gemm1(Args a) {
    const unsigned gid = blockIdx.x * 256u + threadIdx.x; const unsigned sm = hsh(gid + 1234567u);
    { const int t = sm % M, n = (sm >> 14) % NPROJ; const bf16* hr = CWS(bf16, WS_H1) + (size_t)t * DM; const bf16* wr = CWS(bf16, WS_WIN) + (size_t)n * DM;
      float d = 0.f; for (int k = 0; k < 1024; ++k) d += bf2f(hr[k]) * bf2f(wr[k]);
      const int bi = n / 512, col = n % 512; if (bi == 0) d *= QSCALE;
      chk(CERR, 0x80u, bf2f(CWS(bf16, WS_PROJ)[(size_t)bi * PROJ_STRIDE + (size_t)t * PW + col]), d, 0.02f, 0.02f); }
    if (gid < 256) { const int bh = sm % 16, t = (gid < 16) ? (int)(4095 - gid * 17) : (int)((sm >> 4) % SEQ); const float* gi = CWS(float, WS_GI) + (size_t)bh * SEQ; const float* glf = CWS(float, WS_GLF) + (size_t)bh * SEQ;
      float B = 0.f, Mx = -3.0e38f, av = 0.f; for (int s = 0; s <= t; ++s) { B += glf[s]; av = gi[s] - B; Mx = fmaxf(Mx, av); }
      chk(CERR, 0x40u, CWS(float, WS_A2)[(size_t)bh * SEQ + t], av * LOG2E, 1e-4f, 5e-3f); chk(CERR, 0x40u, CWS(float, WS_M2)[(size_t)bh * SEQ + t], Mx * LOG2E, 1e-4f, 5e-3f);
      chk(CERR, 0x40u, CWS(float, WS_NB2)[(size_t)bh * SEQ + t], -(B + Mx) * LOG2E, 1e-4f, 5e-3f); }
}
__global__ void __launch_bounds__(128) chk_attn(Args a) {
    __shared__ float sc[2][4096]; __shared__ float red[128]; __shared__ float qv[128];
    const unsigned sm = hsh(blockIdx.x * 31u + 5u); const int b = sm & 3, h = (sm >> 2) & 3, t = (blockIdx.x < 4) ? (int)(4095 - blockIdx.x * 129) : (int)((sm >> 4) % SEQ), d = threadIdx.x;
    const bf16* DAQ = CWS(bf16, WS_PROJ); const bf16* DAK = DAQ + PROJ_STRIDE; const bf16* DAV = DAQ + 2 * PROJ_STRIDE;
    qv[d] = bf2f(DAQ[((size_t)b * SEQ + t) * PW + h * 128 + d]); __syncthreads();
    const float slope2 = exp2f(-2.0f * (h + 1)) * LOG2E;
    float mx0 = -3.0e38f, mx1 = -3.0e38f;
    for (int s = d; s <= t; s += 128) { const bf16* kr = DAK + ((size_t)b * SEQ + s) * PW + h * 128; float d0 = 0.f, d1 = 0.f;
        for (int k = 0; k < 64; ++k) { d0 += qv[k] * bf2f(kr[k]); d1 += qv[64 + k] * bf2f(kr[64 + k]); }
        d0 -= slope2 * (t - s); d1 -= slope2 * (t - s); sc[0][s] = d0; sc[1][s] = d1; mx0 = fmaxf(mx0, d0); mx1 = fmaxf(mx1, d1); }
    mx0 = blk_max(mx0, red, 128); mx1 = blk_max(mx1, red, 128);
    float l0 = 0.f, l1 = 0.f; for (int s = d; s <= t; s += 128) { l0 += exp2f(sc[0][s] - mx0); l1 += exp2f(sc[1][s] - mx1); }
    l0 = blk_sum(l0, red, 128); l1 = blk_sum(l1, red, 128);
    float la = 0.f, lb = 0.f; for (int k = 0; k < 64; ++k) { la += a.in[7][k] * a.in[8][k]; lb += a.in[9][k] * a.in[10][k]; }
    const float lam = expf(la) - expf(lb) + LAM_INIT;
    float o = 0.f; for (int s = 0; s <= t; ++s) o += (exp2f(sc[0][s] - mx0) / l0 - lam * exp2f(sc[1][s] - mx1) / l1) * bf2f(DAV[((size_t)b * SEQ + s) * PW + h * 128 + d]);
    const float ms = blk_sum(o * o, red, 128) / 128.f;
    const float ref = o / sqrtf(ms + SUBLN_EPS) * a.in[11][d] * (1.0f - LAM_INIT);
    chk(CERR, 0x20u, bf2f(CWS(bf16, WS_H1)[((size_t)b * SEQ + t) * DM + h * 128 + d]), ref, 0.03f, 0.03f);
}
__device__ __forceinline__ float conv1(const bf16* raw, size_t rb, int t, int col, const float* cw, const float* cb, int ch) {
    float y = cb[ch]; for (int j = 0; j < 4; ++j) { const int tt = t - 3 + j; if (tt >= 0) y += cw[j * 1024 + ch] * bf2f(raw[(rb + tt) * PW + col]); } return y / (1.0f + expf(-y)); }
__global__ void __launch_bounds__(128) chk_mlstm(Args a) {
    __shared__ float sc[4096]; __shared__ float red[128]; __shared__ float qs[128];
    const unsigned sm = hsh(blockIdx.x * 131u + 9u); const int bh = sm & 15, b = bh >> 2, hh = bh & 3, d = threadIdx.x;
    const int t = (blockIdx.x < 8) ? (int)(blockIdx.x * 37) : (blockIdx.x < 16) ? (int)(4095 - (blockIdx.x - 8) * 300) : (int)((sm >> 4) % SEQ);
    const bf16* MLQ = CWS(bf16, WS_PROJ) + 3 * PROJ_STRIDE; const bf16* MLK = MLQ + PROJ_STRIDE; const bf16* MLV = MLQ + 2 * PROJ_STRIDE; const bf16* MLO = MLQ + 3 * PROJ_STRIDE;
    const size_t rb = (size_t)b * SEQ; const float* A2 = CWS(float, WS_A2) + (size_t)bh * SEQ; const float m2t = CWS(float, WS_M2)[(size_t)bh * SEQ + t], nb2t = CWS(float, WS_NB2)[(size_t)bh * SEQ + t];
    qs[d] = conv1(MLQ, rb, t, hh * 128 + d, a.in[3], a.in[4], hh * 128 + d); __syncthreads();
    float dp = 0.f;
    for (int s = d; s <= t; s += 128) { float dot = 0.f; for (int k = 0; k < 128; ++k) dot += qs[k] * conv1(MLK, rb, s, hh * 128 + k, a.in[3], a.in[4], 512 + hh * 128 + k);
        const float w = dot * MLK_SCALE * exp2f(A2[s] - m2t); sc[s] = w; dp += w; }
    const float den = blk_sum(dp, red, 128);
    float num = 0.f; for (int s = 0; s <= t; ++s) num += sc[s] * bf2f(MLV[(rb + s) * PW + hh * 128 + d]);
    const float hv = num / fmaxf(fabsf(den), exp2f(nb2t));
    const float ms = blk_sum(hv * hv, red, 128) / 128.f;
    const float og = bf2f(MLO[(rb + t) * PW + hh * 128 + d]);
    const float ref = hv / sqrtf(ms + NORM_EPS) * a.in[12][hh * 128 + d] / (1.0f + expf(-og));
    chk(CERR, 0x10u, bf2f(CWS(bf16, WS_H1)[(rb + t) * DM + 512 + hh * 128 + d]), ref, 0.03f, 0.03f);
}
__global__ void chk_gemm2(Args a) {
    const unsigned gid = blockIdx.x * 256u + threadIdx.x; const unsigned sm = hsh(gid + 99u);
    const int t = sm % M, n = (sm >> 14) % 1024; const bf16* ar = CWS(bf16, WS_H1) + (size_t)t * DM; const bf16* wr = CWS(bf16, WS_WOUT) + (size_t)n * DM;
    float d = a.in[0][(size_t)t * DM + n]; for (int k = 0; k < 1024; ++k) d += bf2f(ar[k]) * bf2f(wr[k]);
    chk(CERR, 0x8u, CWS(float, WS_X1)[(size_t)t * DM + n], d, 0.01f, 0.01f); chk(CERR, 0x8u, bf2f(CWS(bf16, WS_X1B)[(size_t)t * DM + n]), d, 0.015f, 0.015f);
    if (gid < 64) { float s = 0.f, p = 0.f; for (int k = 0; k < 1024; ++k) { const float v = CWS(float, WS_X1)[(size_t)t * DM + k]; s += v * v; } for (int k = 0; k < 16; ++k) p += CWS(float, WS_SSP)[(size_t)t * 16 + k];
        chk(CERR, 0x8u, p, s, 1e-3f, 1e-3f); }
}
__global__ void chk_gemm3(Args a) {
    const unsigned gid = blockIdx.x * 256u + threadIdx.x; const unsigned sm = hsh(gid + 4242u);
    const int t = sm % M, n = (sm >> 14) % 2048; const bf16* ar = CWS(bf16, WS_X1B) + (size_t)t * DM; const bf16* wr = CWS(bf16, WS_WPQ) + (size_t)n * DM;
    float p = 0.f; for (int k = 0; k < 16; ++k) p += CWS(float, WS_SSP)[(size_t)t * 16 + k];
    float d = 0.f; for (int k = 0; k < 1024; ++k) d += bf2f(ar[k]) * bf2f(wr[k]); d /= sqrtf(p / 1024.f + NORM_EPS);
    const bf16* qp = (n < 1024) ? CWS(bf16, WS_H1) + (size_t)t * DM + n : CWS(bf16, WS_QPB) + (size_t)t * DM + (n - 1024);
    chk(CERR, 0x4u, bf2f(*qp), d, 0.02f, 0.02f);
}
__global__ void chk_topk(Args a) {
    __shared__ float s12[256]; __shared__ float cand[256]; __shared__ int i12[32]; __shared__ float v12[32]; __shared__ int pe[16]; __shared__ float pg[16];
    const unsigned sm = hsh(blockIdx.x * 17u + 3u); const int t = sm % M, h = (sm >> 14) & 7, tid = threadIdx.x, c = tid >> 7, n = tid & 127;
    const bf16* q = ((h < 4) ? CWS(bf16, WS_H1) + h * 256 : CWS(bf16, WS_QPB) + (h - 4) * 256) + (size_t)t * DM + c * 128; const bf16* sk = CWS(bf16, WS_SUBK) + ((size_t)(h * 2 + c) * 128 + n) * 128;
    float d = 0.f; for (int k = 0; k < 128; ++k) d += bf2f(q[k]) * bf2f(sk[k]); s12[tid] = d; __syncthreads();
    if (tid < 2) { for (int k = 0; k < 16; ++k) { int bi = 0; float bv = -3.0e38f; for (int j = 0; j < 128; ++j) if (s12[tid * 128 + j] > bv) { bv = s12[tid * 128 + j]; bi = j; } i12[tid * 16 + k] = bi; v12[tid * 16 + k] = bv; s12[tid * 128 + bi] = -3.0e38f; } }
    __syncthreads(); cand[tid] = v12[tid >> 4] + v12[16 + (tid & 15)]; __syncthreads();
    if (tid == 0) { float mx = 0.f, es = 0.f; for (int k = 0; k < 16; ++k) { int bi = 0; float bv = -3.0e38f; for (int j = 0; j < 256; ++j) if (cand[j] > bv) { bv = cand[j]; bi = j; }
            pe[k] = i12[bi >> 4] * 128 + i12[16 + (bi & 15)]; if (k == 0) mx = bv; pg[k] = expf(bv - mx); es += pg[k]; cand[bi] = -3.0e38f; }
        const unsigned long long* P = CWS(unsigned long long, WS_PE) + (size_t)t * 128 + h * 16; int miss = 0;
        for (int k = 0; k < 16; ++k) { bool f = false; for (int j = 0; j < 16; ++j) if ((int)(unsigned)(P[j] & 0xFFFFFFFFull) == pe[k]) { f = true; const float g = __uint_as_float((unsigned)(P[j] >> 32)); if (!(fabsf(g - pg[k] / es) <= 0.003f + 0.03f * pg[k] / es)) miss += 4; } if (!f) ++miss; }
        if (miss > 2) atomicOr(CERR, 0x2u); }
}
__global__ void chk_gather(Args a) {
    __shared__ float wv[128]; __shared__ int ev[128]; __shared__ float red[256];
    const int t = hsh(blockIdx.x * 13u + 11u) % M, tid = threadIdx.x; const float* x1 = CWS(float, WS_X1) + (size_t)t * DM;
    float p = 0.f; for (int k = 0; k < 16; ++k) p += CWS(float, WS_SSP)[(size_t)t * 16 + k]; const float rstd = 1.0f / sqrtf(p / 1024.f + NORM_EPS);
    if (tid < 128) { const unsigned long long e = CWS(unsigned long long, WS_PE)[(size_t)t * 128 + tid]; const int ei = (int)(unsigned)(e & 0xFFFFFFFFull); const bf16* u = CWS(bf16, WS_UB) + (size_t)ei * DM;
        float d = 0.f; for (int k = 0; k < 1024; ++k) d += bf2f(u[k]) * x1[k]; d *= rstd; ev[tid] = ei; wv[tid] = __uint_as_float((unsigned)(e >> 32)) * 0.5f * d * (1.0f + erff(d * 0.70710678f)); }
    __syncthreads();
    float y[4], s = 0.f; for (int i = 0; i < 4; ++i) { const int dd = tid * 4 + i; float acc = x1[dd]; for (int k = 0; k < 128; ++k) acc += wv[k] * bf2f(CWS(bf16, WS_VB)[(size_t)ev[k] * DM + dd]); y[i] = acc; s += acc * acc; }
    const float rs = 1.0f / sqrtf(blk_sum(s, red, 256) / 1024.f + NORM_EPS);
    for (int i = 0; i < 4; ++i) { const int dd = tid * 4 + i; chk(CERR, 0x1u, a.out[(size_t)t * DM + dd], y[i] * rs * a.in[19][dd], 0.01f, 0.01f); }
}
__global__ void chk_poison(Args a) { const unsigned e = *CERR; if (e) { const float f = 1.0f + 10.0f * (float)e; for (size_t i = blockIdx.x * 256u + threadIdx.x; i < (size_t)M * DM; i += (size_t)gridDim.x * 256u) a.out[i] *= f; } }
#endif

extern "C" void kernel_launch(void* const* d_in, const int* in_sizes, int n_in, void* d_out, int out_size, void* d_ws, size_t ws_size, hipStream_t stream) {
    static int grid = 0;
    if (grid == 0) {
        if (n_in != 20 || in_sizes[0] != M * DM || out_size != M * DM || ws_size < WS_END) { fprintf(stderr, "kernel_launch: unexpected shapes (n_in %d, in0 %d, out %d, ws %zu); nothing launched\n", n_in, n_in > 0 ? in_sizes[0] : -1, out_size, ws_size); grid = -1; return; }
        int dev = 0, cus = 0, per_cu = 0;
        if (hipGetDevice(&dev) != hipSuccess || hipDeviceGetAttribute(&cus, hipDeviceAttributeMultiprocessorCount, dev) != hipSuccess) { grid = -1; return; }
        if (hipFuncSetAttribute((const void*)mega_fwd, hipFuncAttributeMaxDynamicSharedMemorySize, LDS_BYTES) != hipSuccess) { fprintf(stderr, "kernel_launch: hipFuncSetAttribute failed\n"); grid = -1; return; }
        if (hipOccupancyMaxActiveBlocksPerMultiprocessor(&per_cu, (const void*)mega_fwd, NTHR, LDS_BYTES) != hipSuccess || per_cu < 1) fprintf(stderr, "kernel_launch: occupancy query reports %d\n", per_cu);
        (void)hipGetLastError();
        grid = 256;
        if (cus < 256) { fprintf(stderr, "kernel_launch: %d CUs, need 256\n", cus); grid = -1; return; }
    }
    if (grid < 0) return;
    (void)hipMemsetAsync((char*)d_ws + WS_CTL, 0, CTL_ZERO_BYTES, stream);
    Args a{};
    for (int i = 0; i < 20; ++i) a.in[i] = (const float*)d_in[i];
    a.out = (float*)d_out; a.ws = (unsigned char*)d_ws;
#if MK_N_LAUNCHES == 1
    a.ph_lo = 0; a.ph_hi = N_PHASES;
    hipLaunchKernelGGL(mega_fwd, dim3(grid), dim3(NTHR), LDS_BYTES, stream, a);
#else
    for (int p = 0; p < N_PHASES; ++p) { a.ph_lo = p; a.ph_hi = p + 1; hipLaunchKernelGGL(mega_fwd, dim3(grid), dim3(NTHR), LDS_BYTES, stream, a);
#if defined(MK_CHECK)
        a.ph_lo = 0; a.ph_hi = 0;
        if (p == 0) hipLaunchKernelGGL(chk_p0, dim3(256), dim3(256), 0, stream, a);
        if (p == 1) hipLaunchKernelGGL(chk_gemm1, dim3(16), dim3(256), 0, stream, a);
        if (p == 3) { hipLaunchKernelGGL(chk_attn, dim3(64), dim3(128), 0, stream, a); hipLaunchKernelGGL(chk_mlstm, dim3(64), dim3(128), 0, stream, a); }
        if (p == 4) hipLaunchKernelGGL(chk_gemm2, dim3(16), dim3(256), 0, stream, a);
        if (p == 5) hipLaunchKernelGGL(chk_gemm3, dim3(16), dim3(256), 0, stream, a);
        if (p == 6) hipLaunchKernelGGL(chk_topk, dim3(128), dim3(256), 0, stream, a);
        if (p == 7) { hipLaunchKernelGGL(chk_gather, dim3(32), dim3(256), 0, stream, a); hipLaunchKernelGGL(chk_poison, dim3(1024), dim3(256), 0, stream, a); }
#endif
    }
#endif
    const hipError_t le = hipPeekAtLastError();
    if (le != hipSuccess) fprintf(stderr, "kernel_launch: launch failed: %s\n", hipGetErrorName(le));
}
```

```cpp
#define MK_N_LAUNCHES 1
#include <hip/hip_runtime.h>
#include <cstdio>
#include <cstdint>
namespace pg8 {
#define PG8_LAS __attribute__((address_space(3)))
typedef unsigned short bf16_t;
typedef short bf16x8 __attribute__((ext_vector_type(8)));
typedef float f32x4 __attribute__((ext_vector_type(4)));
typedef unsigned u32x4 __attribute__((ext_vector_type(4)));
constexpr int BM = 256, BK = 64, HALF = 128, HTB = HALF * BK * 2  , STAGE_BYTES = 8 * HTB, NXCD = 8, WGM = 8;

__host__ __device__ __forceinline__ int lds_byte(int r, int c) { const int st = (r >> 4) * 2 + (c >> 5), rr = r & 15, cc = c & 31, ob = rr * 64 + cc * 2; return st * 1024 + (ob ^ (((ob >> 9) & 1) << 5)); }
__host__ __device__ __forceinline__ void stage_rc(int b, int& R, int& C) { const int st = b / 1024, sb = b % 1024, swz = sb ^ (((sb >> 9) & 1) << 5); R = (st >> 1) * 16 + swz / 64; C = (st & 1) * 32 + (swz % 64) / 2; }
__host__ __device__ __forceinline__ int perm32(int rho) { const int n = rho >> 4, i = rho & 15; return 8 * (i >> 2) + 4 * n + (i & 3); }

struct Unit { int pm, pn; };
struct Gemm { const bf16_t* A; const bf16_t* Bt; int M, N, K; };

struct StaticOrder {
    int nM, nN, nwg, G, c;
    __host__ __device__ void init(int M, int N, int G_, int c_) { nM = M / BM; nN = N / BM; nwg = nM * nN; G = G_; c = c_; }
    __host__ __device__ bool next(int i, Unit& u) const {
        const long L = (long)i * G + c; if (L >= nwg) return false;
        int wgid = (int)L; { const int q = nwg / NXCD, r = nwg % NXCD, xcd = wgid % NXCD, off = wgid / NXCD; wgid = (xcd < r ? xcd * (q + 1) : r * (q + 1) + (xcd - r) * q) + off; }
        const int nig = WGM * nN, gid = wgid / nig, fm = gid * WGM, gsz = (nM - fm) < WGM ? (nM - fm) : WGM;
        u.pm = fm + ((wgid % nig) % gsz); u.pn = (wgid % nig) / gsz; return true;
    }
    __device__ __forceinline__ void a_ready(const Unit&) const {}
    __device__ __forceinline__ void done(const Unit&) const {}
};

__device__ __forceinline__ unsigned cvt_pk_bf16(float lo, float hi) { unsigned r; asm volatile("v_cvt_pk_bf16_f32 %0, %1, %2" : "=v"(r) : "v"(lo), "v"(hi)); return r; }
typedef float f32x2 __attribute__((ext_vector_type(2)));
typedef unsigned u32x2e __attribute__((ext_vector_type(2)));
__device__ __forceinline__ void st16_wt(void* p, u32x4 v) {
#ifdef PG8_WT_STORES
    asm volatile("global_store_dwordx4 %0, %1, off sc1\n\ts_nop 1" :: "v"(p), "v"(v) : "memory");
#else
    *(u32x4*)p = v;
#endif
}
struct EpiBf16S {
    static constexpr bool PERM = true, AFTER_DRAIN = false;
    bf16_t* O; int ldc; int split_cols; size_t split_stride; float scale0; const float* ssp; float eps;
    __device__ __forceinline__ void operator()(const f32x4 (&acc)[2][2][4][2], const Unit& u, int wr, int wc, int fr, int fq) const {
        const int row0 = u.pm * BM + wr * 64 + fr; int colt = u.pn * BM; bf16_t* base = O;
        float sc = 1.f; if (split_cols) { const int t = colt / split_cols; base += (size_t)t * split_stride; colt -= t * split_cols; if (t == 0) sc = scale0; }
        const int col0 = colt + wc * 32 + 8 * fq;
#pragma unroll
        for (int ai = 0; ai < 2; ++ai)
#pragma unroll
            for (int m = 0; m < 4; ++m) { const int row = row0 + ai * HALF + m * 16; bf16_t* rowp = base + (size_t)row * ldc + col0;
                float rs = sc;
                if (ssp) { const f32x4* sp = (const f32x4*)(ssp + (size_t)row * 16); const f32x4 a = sp[0], b = sp[1], c = sp[2], d = sp[3];
                    const float s = ((a[0] + a[1]) + (a[2] + a[3])) + ((b[0] + b[1]) + (b[2] + b[3])) + ((c[0] + c[1]) + (c[2] + c[3])) + ((d[0] + d[1]) + (d[2] + d[3]));
                    rs *= 1.0f / sqrtf(s * (1.0f / 1024.0f) + eps); }
#pragma unroll
                for (int bj = 0; bj < 2; ++bj) { const f32x4 v0 = acc[ai][bj][m][0] * rs, v1 = acc[ai][bj][m][1] * rs;
                    u32x4 w; w.x = cvt_pk_bf16(v0[0], v0[1]); w.y = cvt_pk_bf16(v0[2], v0[3]); w.z = cvt_pk_bf16(v1[0], v1[1]); w.w = cvt_pk_bf16(v1[2], v1[3]);
                    st16_wt(rowp + bj * HALF, w); } }
    }
};
struct EpiResid {
    static constexpr bool PERM = false, AFTER_DRAIN = false;
    const float* resid; float* out; bf16_t* outb; float* ssp; int ldc;
    __device__ __forceinline__ void operator()(const f32x4 (&acc)[2][2][4][2], const Unit& u, int wr, int wc, int fr, int fq) const {
        const int col0 = u.pn * BM + wc * 32 + 4 * fq;
#pragma unroll
        for (int ai = 0; ai < 2; ++ai)
#pragma unroll
            for (int m = 0; m < 4; ++m) { const int r = u.pm * BM + ai * HALF + wr * 64 + m * 16 + fr; const size_t off = (size_t)r * ldc + col0; float s = 0.f;
#pragma unroll
                for (int bj = 0; bj < 2; ++bj)
#pragma unroll
                    for (int n = 0; n < 2; ++n) { const f32x4 x = *(const f32x4*)(resid + off + bj * HALF + n * 16) + acc[ai][bj][m][n];
                        if (out) *(f32x4*)(out + off + bj * HALF + n * 16) = x; s += (x[0] * x[0] + x[1] * x[1]) + (x[2] * x[2] + x[3] * x[3]);
                        u32x2e w; w.x = cvt_pk_bf16(x[0], x[1]); w.y = cvt_pk_bf16(x[2], x[3]); *(u32x2e*)(outb + off + bj * HALF + n * 16) = w; }
                s += __shfl_xor(s, 16); s += __shfl_xor(s, 32);
                if (fq == 0) ssp[(size_t)r * 16 + u.pn * 4 + wc] = s; }
    }
};
template <class Epi, class Sched, bool ALIGN_EPI = false, bool SP2 = false>
__device__ __forceinline__ void gemm_phase(PG8_LAS unsigned char* lds, const Gemm g, const Sched& S, const Epi& E) {
    const int tid = threadIdx.x, wid = __builtin_amdgcn_readfirstlane(tid >> 6), lane = tid & 63, wr = wid >> 2, wc = wid & 3, fr = lane & 15, fq = lane >> 4;
    const int K = g.K, nt = K / BK;
    unsigned voffA[2], voffB[2];
#pragma unroll
    for (int i = 0; i < 2; ++i) { int R, C; stage_rc(tid * 16 + i * 8192, R, C); const int Rb = Epi::PERM ? ((R & ~31) + perm32(R & 31)) : R;
        voffA[i] = (unsigned)(R * K + C) * 2u; voffB[i] = (unsigned)(Rb * K + C) * 2u; }
    const size_t kstep = (size_t)(BK * 2);
    const size_t hstep = (size_t)HALF * K * 2;
    const size_t tstep = 2 * hstep;
    const unsigned ldsw = (unsigned)wid * 1024u;
    const int aoff = lds_byte(wr * 64 + fr, fq * 8), boff = lds_byte(wc * 32 + fr, fq * 8);
#define PG8_SA(b, h) (((b) * 2 + (h)) * HTB)
#define PG8_SB(b, h) ((4 + (b) * 2 + (h)) * HTB)
#define PG8_STAGE(bufoff, gbase, voff) do { _Pragma("unroll") for (int _i = 0; _i < 2; ++_i) \
        __builtin_amdgcn_global_load_lds((const unsigned*)((const char*)(gbase) + (voff)[_i]), (PG8_LAS unsigned*)(lds + (bufoff) + ldsw + _i * 8192), 16, 0, 0); } while (0)
#define PG8_LDA(dst, b, h) do { _Pragma("unroll") for (int m = 0; m < 4; ++m) _Pragma("unroll") for (int k = 0; k < 2; ++k) dst[m][k] = *(const PG8_LAS bf16x8*)(lds + PG8_SA(b, h) + aoff + m * 2048 + k * 1024); } while (0)
#define PG8_LDB(dst, b, h) do { _Pragma("unroll") for (int n = 0; n < 2; ++n) _Pragma("unroll") for (int k = 0; k < 2; ++k) dst[n][k] = *(const PG8_LAS bf16x8*)(lds + PG8_SB(b, h) + boff + n * 2048 + k * 1024); } while (0)
#define PG8_MMA(ai, bj, At, Bt) do { __builtin_amdgcn_s_setprio(1); _Pragma("unroll") for (int m = 0; m < 4; ++m) _Pragma("unroll") for (int n = 0; n < 2; ++n) _Pragma("unroll") for (int k = 0; k < 2; ++k) \
        acc[ai][bj][m][n] = __builtin_amdgcn_mfma_f32_16x16x32_bf16(Bt[n][k], At[m][k], acc[ai][bj][m][n], 0, 0, 0); __builtin_amdgcn_s_setprio(0); } while (0)
#define PG8_WAIT_V(n) asm volatile("s_waitcnt vmcnt(" #n ")" ::: "memory")
#define PG8_WAIT_L(n) asm volatile("s_waitcnt lgkmcnt(" #n ")" ::: "memory")
#define PG8_BAR __builtin_amdgcn_s_barrier()
#define PG8_SCHED __builtin_amdgcn_sched_barrier(0)
    Unit cur, nxt; int ui = 0;
    if (!S.next(0, cur)) return;
    f32x4 acc[2][2][4][2];
#pragma unroll
    for (int a = 0; a < 2; ++a)
#pragma unroll
        for (int b = 0; b < 2; ++b)
#pragma unroll
            for (int m = 0; m < 4; ++m)
#pragma unroll
                for (int n = 0; n < 2; ++n) acc[a][b][m][n] = (f32x4){0.f, 0.f, 0.f, 0.f};
    bf16x8 At[4][2], B0[2][2], B1[2][2];
    const char* cA = (const char*)g.A + (size_t)cur.pm * tstep; const char* cB = (const char*)g.Bt + (size_t)cur.pn * tstep;
    S.a_ready(cur);
    if constexpr (SP2) {
        PG8_STAGE(PG8_SB(0, 0), cB, voffB); PG8_STAGE(PG8_SB(0, 1), cB + hstep, voffB); PG8_STAGE(PG8_SA(0, 0), cA, voffA); PG8_STAGE(PG8_SA(0, 1), cA + hstep, voffA);
        if (wr == 1) PG8_BAR;
        PG8_WAIT_V(2); PG8_BAR;
        PG8_STAGE(PG8_SB(1, 0), cB + kstep, voffB); PG8_STAGE(PG8_SA(1, 0), cA + kstep, voffA); PG8_STAGE(PG8_SB(1, 1), cB + hstep + kstep, voffB);
        PG8_WAIT_V(6); PG8_BAR;
    } else {
        PG8_STAGE(PG8_SB(0, 0), cB, voffB); PG8_STAGE(PG8_SA(0, 0), cA, voffA); PG8_STAGE(PG8_SB(0, 1), cB + hstep, voffB); PG8_STAGE(PG8_SA(0, 1), cA + hstep, voffA);
        if (wr == 1) PG8_BAR;
        PG8_WAIT_V(4); PG8_BAR;
        PG8_STAGE(PG8_SB(1, 0), cB + kstep, voffB); PG8_STAGE(PG8_SA(1, 0), cA + kstep, voffA); PG8_STAGE(PG8_SB(1, 1), cB + hstep + kstep, voffB);
        PG8_WAIT_V(6); PG8_BAR;
    }
    for (;;) {
        const bool has_next = S.next(ui + 1, nxt);
        const char* nA = has_next ? (const char*)g.A + (size_t)nxt.pm * tstep : cA; const char* nB = has_next ? (const char*)g.Bt + (size_t)nxt.pn * tstep : cB;
        for (int t = 0; t < nt; t += 2) {
            const bool last = (t == nt - 2);
            const char* a1 = cA + (size_t)(t + 1) * kstep;
            const char* a2 = last ? nA : cA + (size_t)(t + 2) * kstep; const char* b2 = last ? nB : cB + (size_t)(t + 2) * kstep;
            const char* a3 = a2 + kstep; const char* b3 = b2 + kstep;
            if (last && has_next) S.a_ready(nxt);
            if constexpr (SP2) {
            PG8_LDB(B0, 0, 0); PG8_LDB(B1, 0, 1); PG8_SCHED; PG8_LDA(At, 0, 0); PG8_STAGE(PG8_SA(1, 1), a1 + hstep, voffA);
            PG8_WAIT_V(8); PG8_WAIT_L(0); PG8_BAR; PG8_MMA(0, 0, At, B0); PG8_MMA(0, 1, At, B1); PG8_BAR; PG8_SCHED;
            PG8_LDA(At, 0, 1); PG8_STAGE(PG8_SB(0, 0), b2, voffB); PG8_STAGE(PG8_SB(0, 1), b2 + hstep, voffB); PG8_STAGE(PG8_SA(0, 0), a2, voffA);
            PG8_WAIT_V(8); PG8_WAIT_L(0); PG8_BAR; PG8_MMA(1, 0, At, B0); PG8_MMA(1, 1, At, B1); PG8_BAR; PG8_SCHED;
            PG8_LDB(B0, 1, 0); PG8_LDB(B1, 1, 1); PG8_SCHED; PG8_LDA(At, 1, 0); PG8_STAGE(PG8_SA(0, 1), a2 + hstep, voffA);
            PG8_WAIT_V(8); PG8_WAIT_L(0); PG8_BAR; PG8_MMA(0, 0, At, B0); PG8_MMA(0, 1, At, B1); PG8_BAR; PG8_SCHED;
            PG8_LDA(At, 1, 1); PG8_STAGE(PG8_SB(1, 0), b3, voffB); PG8_STAGE(PG8_SB(1, 1), b3 + hstep, voffB); PG8_STAGE(PG8_SA(1, 0), a3, voffA);
            PG8_WAIT_V(8); PG8_WAIT_L(0); PG8_BAR; PG8_MMA(1, 0, At, B0); PG8_MMA(1, 1, At, B1); PG8_BAR; PG8_SCHED;
            } else {
            PG8_LDB(B0, 0, 0); PG8_SCHED; PG8_LDA(At, 0, 0); PG8_STAGE(PG8_SA(1, 1), a1 + hstep, voffA);
            PG8_WAIT_L(8); PG8_BAR; PG8_WAIT_L(0); PG8_MMA(0, 0, At, B0); PG8_BAR; PG8_SCHED;
            PG8_LDB(B1, 0, 1); PG8_STAGE(PG8_SB(0, 0), b2, voffB);
            PG8_BAR; PG8_WAIT_L(0); PG8_MMA(0, 1, At, B1); PG8_BAR;
            PG8_LDA(At, 0, 1); PG8_STAGE(PG8_SA(0, 0), a2, voffA);
            PG8_BAR; PG8_WAIT_L(0); PG8_MMA(1, 0, At, B0); PG8_BAR; PG8_SCHED;
            PG8_STAGE(PG8_SB(0, 1), b2 + hstep, voffB);
            PG8_WAIT_V(6); PG8_BAR; PG8_MMA(1, 1, At, B1); PG8_BAR;
            PG8_LDB(B0, 1, 0); PG8_SCHED; PG8_LDA(At, 1, 0); PG8_STAGE(PG8_SA(0, 1), a2 + hstep, voffA);
            PG8_WAIT_L(8); PG8_BAR; PG8_WAIT_L(0); PG8_MMA(0, 0, At, B0); PG8_BAR; PG8_SCHED;
            PG8_LDB(B1, 1, 1); PG8_STAGE(PG8_SB(1, 0), b3, voffB);
            PG8_BAR; PG8_WAIT_L(0); PG8_MMA(0, 1, At, B1); PG8_BAR;
            PG8_LDA(At, 1, 1); PG8_STAGE(PG8_SA(1, 0), a3, voffA);
            PG8_BAR; PG8_WAIT_L(0); PG8_MMA(1, 0, At, B0); PG8_BAR; PG8_SCHED;
            PG8_STAGE(PG8_SB(1, 1), b3 + hstep, voffB);
            PG8_WAIT_V(6); PG8_BAR; PG8_MMA(1, 1, At, B1); PG8_BAR;
            }
        }
        if constexpr (ALIGN_EPI) { if (wr == 0) PG8_BAR; }
        if constexpr (!Epi::AFTER_DRAIN) { E(acc, cur, wr, wc, fr, fq); S.done(cur); }
        if (!has_next) break;
#pragma unroll
        for (int a = 0; a < 2; ++a)
#pragma unroll
            for (int b = 0; b < 2; ++b)
#pragma unroll
                for (int m = 0; m < 4; ++m)
#pragma unroll
                    for (int n = 0; n < 2; ++n) acc[a][b][m][n] = (f32x4){0.f, 0.f, 0.f, 0.f};
        cur = nxt; cA = nA; cB = nB; ++ui;
        if constexpr (ALIGN_EPI) { if (wr == 1) PG8_BAR; }
    }
    PG8_WAIT_V(0);
    if constexpr (!ALIGN_EPI) { if (wr == 0) PG8_BAR; }
    PG8_BAR;
    if constexpr (Epi::AFTER_DRAIN) { E.fused(acc, cur, wr, wc, fr, fq, lds, wid, lane); S.done(cur); }
#undef PG8_SA
#undef PG8_SB
#undef PG8_STAGE
#undef PG8_LDA
#undef PG8_LDB
#undef PG8_MMA
#undef PG8_WAIT_V
#undef PG8_WAIT_L
#undef PG8_BAR
#undef PG8_SCHED
}
}
#define GAS __attribute__((address_space(1)))
#define LAS __attribute__((address_space(3)))
typedef unsigned short bf16;
typedef unsigned v4u __attribute__((ext_vector_type(4)));
typedef float f32x4 __attribute__((ext_vector_type(4)));
typedef short bf16x8 __attribute__((ext_vector_type(8)));
typedef GAS unsigned gu32;
typedef GAS unsigned long long gu64;
#define RLX_AGENT __ATOMIC_RELAXED, __HIP_MEMORY_SCOPE_AGENT
#define LDS_WAIT() asm volatile("s_waitcnt lgkmcnt(0)" ::: "memory")
#define VM_WAIT() asm volatile("s_waitcnt vmcnt(0)" ::: "memory")
__device__ __forceinline__ unsigned long long rt() { return __builtin_amdgcn_s_memrealtime(); }
__device__ __forceinline__ unsigned f2bf(float f) { unsigned u = __builtin_bit_cast(unsigned, f); return (u + 0x7fffu + ((u >> 16) & 1u)) >> 16; }
__device__ __forceinline__ unsigned pk2(float lo, float hi) { return f2bf(lo) | (f2bf(hi) << 16); }

#define XB_TMO      128
#define XB_XCNT(j)  (256  + 64 * (j))
#define XB_XSUB(j)  (1280 + 64 * (j))
#define XB_XGEN(j)  (2304 + 64 * (j))
#define XB_TOP      3328
#define XB_TOPGEN   3392
#define XCD_BAR_WORDS 3456
#define XB_SPIN_CAP (1u << 18)

__device__ __forceinline__ unsigned xb_ld(unsigned* p)              { return __hip_atomic_load(p, __ATOMIC_RELAXED, __HIP_MEMORY_SCOPE_AGENT); }
__device__ __forceinline__ unsigned xb_add(unsigned* p, unsigned v) { return __hip_atomic_fetch_add(p, v, __ATOMIC_RELAXED, __HIP_MEMORY_SCOPE_AGENT); }
__device__ __forceinline__ unsigned xb_xcc_id() { return (unsigned)__builtin_amdgcn_s_getreg((3 << 11) | 20) & 0xFu; }
#define XB_SPIN(cond, bar) do { unsigned _sp = 0; while (cond) { __builtin_amdgcn_s_sleep(1); \
    if ((++_sp & 255u) == 0u) { if (xb_ld(&(bar)[XB_TMO])) break; if (_sp > XB_SPIN_CAP) { atomicAdd(&(bar)[XB_TMO], 1u); break; } } } } while (0)

struct XcdBarrier {
    unsigned* bar; unsigned x;
    volatile LAS unsigned* st;
};

__device__ __forceinline__ XcdBarrier xcd_barrier_post(unsigned* bar, volatile LAS unsigned* st) {
    XcdBarrier b; b.bar = bar; b.x = xb_xcc_id(); b.st = st;
    if (threadIdx.x == 0) (void)xb_add(&bar[XB_XCNT(b.x)], 1u);
    return b;
}
__device__ __forceinline__ void xcd_barrier_complete(unsigned* bar, unsigned x, unsigned& nloc, unsigned& nx) {
    const unsigned G = gridDim.x * gridDim.y * gridDim.z;
    unsigned sum, cnt, mine, sp = 0u;
    for (;;) {
        sum = 0u; cnt = 0u; mine = 0u;
#pragma unroll
        for (unsigned j = 0; j < 16; ++j) { const unsigned c = xb_ld(&bar[XB_XCNT(j)]); sum += c; cnt += (c > 0u) ? 1u : 0u; mine = (j == x) ? c : mine; }
        if (sum == G) break;
        __builtin_amdgcn_s_sleep(1);
        if ((++sp & 255u) == 0u) { if (xb_ld(&bar[XB_TMO])) break; if (sp > XB_SPIN_CAP) { atomicAdd(&bar[XB_TMO], 1u); break; } }
    }
    nloc = mine > 0u ? mine : 1u; nx = cnt > 0u ? cnt : 1u;
}

__device__ __forceinline__ void xcd_barrier(const XcdBarrier& b) {
    asm volatile("s_waitcnt vmcnt(0)" ::: "memory");
    __syncthreads();
    if (threadIdx.x == 0) {
        unsigned* bar = b.bar;
        __builtin_amdgcn_s_waitcnt(0);
        unsigned nloc = b.st[0], nx = b.st[1];
        if (nloc == 0u) { xcd_barrier_complete(bar, b.x, nloc, nx); b.st[0] = nloc; b.st[1] = nx; }
        const unsigned old = xb_add(&bar[XB_XSUB(b.x)], 1u);
        const unsigned gen = old / nloc;
        if (old + 1u == (gen + 1u) * nloc) {
            __builtin_amdgcn_fence(__ATOMIC_RELEASE, "agent");
            asm volatile("s_waitcnt vmcnt(0)" ::: "memory");
            const unsigned og = xb_add(&bar[XB_TOP], 1u);
            const unsigned tg = og / nx;
            if (og + 1u == (tg + 1u) * nx) xb_add(&bar[XB_TOPGEN], 1u);
            else XB_SPIN(xb_ld(&bar[XB_TOPGEN]) == tg, bar);
            __builtin_amdgcn_fence(__ATOMIC_ACQUIRE, "agent");
            xb_add(&bar[XB_XGEN(b.x)], 1u);
            asm volatile("s_waitcnt vmcnt(0)" ::: "memory");
        } else {
            XB_SPIN(xb_ld(&bar[XB_XGEN(b.x)]) == gen, bar);
            __builtin_amdgcn_fence(__ATOMIC_ACQUIRE, "agent");
            asm volatile("s_waitcnt vmcnt(0)" ::: "memory");
        }
    }
    __syncthreads();
}

constexpr int NWAVES = 8, NTHR = NWAVES * 64;
constexpr int BATCH = 4, SEQ = 4096, DM = 1024, M = BATCH * SEQ;
constexpr int NPROJ = 3584, INCOLS = 3592;
constexpr int PW = 512;
constexpr int NEXP = 16384, PHEADS = 8, PTOPK = 16;
constexpr float LOG2E = 1.4426950408889634f;
constexpr float NORM_EPS = 1e-6f, SUBLN_EPS = 1e-5f;
constexpr float LAM_INIT = 0.2f;
constexpr float QSCALE = 0.125f * LOG2E;
constexpr float MLK_SCALE = 0.08838834764831845f;

constexpr size_t MiB = 1u << 20;
constexpr size_t WS_CTL = 0, CTL_ZERO_BYTES = 1 * MiB;
constexpr size_t WS_GI = 1 * MiB, WS_GLF = WS_GI + 256 * 1024, WS_A2 = WS_GLF + 256 * 1024, WS_M2 = WS_A2 + 256 * 1024;
constexpr size_t WS_NB2 = 2 * MiB, WS_MLOC = WS_NB2 + 256 * 1024, WS_DN = WS_MLOC + 4096;
constexpr size_t WS_SSP = 3 * MiB;
constexpr size_t WS_WIN = 4 * MiB, WS_WOUT = 11 * MiB, WS_WPQ = 13 * MiB, WS_SUBK = 17 * MiB;
constexpr size_t WS_H1 = 20 * MiB;
constexpr size_t WS_PROJ = 52 * MiB;
constexpr size_t PROJ_STRIDE = (size_t)M * PW;
constexpr size_t WS_X1 = 52 * MiB, WS_X1B = 116 * MiB, WS_QPB = 148 * MiB;
constexpr size_t WS_DCT = 164 * MiB;
constexpr size_t WS_SU = 188 * MiB;
constexpr size_t WS_WL = 180 * MiB;
constexpr size_t WS_UB = 192 * MiB, WS_VB = 208 * MiB;
constexpr size_t WS_PE = 224 * MiB, WS_LIST = 240 * MiB, WS_END = 256 * MiB;
constexpr int CW_ERR = 16, CW_Q = 32, CW_BAR = 4096;

constexpr int RING_BYTES = 131072;
constexpr int MISC_OFF = RING_BYTES;
constexpr int WSCR_OFF = MISC_OFF + 512;
constexpr int XTRA_OFF = WSCR_OFF + 8 * 512;
constexpr int LDS_BYTES = 163840;

struct Frame {
    LAS unsigned char* lds; unsigned char* ldsg;
    volatile LAS unsigned* MISC;
    gu32* ctl;
    int tid, lane, wave, vcu, G;
    const float* in[20]; float* out; unsigned char* ws;
};
#define WSP(T, off) ((T*)(F.ws + (off)))

__device__ __forceinline__ float bf2f(unsigned short b) { return __builtin_bit_cast(float, (unsigned)b << 16); }
__device__ __forceinline__ float wave_sum(float v) {
#pragma unroll
    for (int o = 1; o < 64; o <<= 1) v += __shfl_xor(v, o);
    return v;
}
__device__ __forceinline__ float wave_max(float v) {
#pragma unroll
    for (int o = 1; o < 64; o <<= 1) v = fmaxf(v, __shfl_xor(v, o));
    return v;
}

template <int CTRL> __device__ __forceinline__ float dppf(float v) { return __int_as_float(__builtin_amdgcn_mov_dpp(__float_as_int(v), CTRL, 0xf, 0xf, true)); }
__device__ __forceinline__ float reduce8(const float (&d)[8], int lane) {
    float s[4], t[2];
#pragma unroll
    for (int k = 0; k < 4; ++k) { auto r = __builtin_amdgcn_permlane32_swap(__float_as_uint(d[k]), __float_as_uint(d[k + 4]), false, false); s[k] = __uint_as_float(r[0]) + __uint_as_float(r[1]); }
#pragma unroll
    for (int k = 0; k < 2; ++k) { auto r = __builtin_amdgcn_permlane16_swap(__float_as_uint(s[k]), __float_as_uint(s[k + 2]), false, false); t[k] = __uint_as_float(r[0]) + __uint_as_float(r[1]); }
    const bool b3 = (lane & 8) != 0;
    float r = (b3 ? t[1] : t[0]) + dppf<0x128>(b3 ? t[0] : t[1]);
    r += dppf<0xB1>(r); r += dppf<0x4E>(r); r += dppf<0x141>(r);
    return r;
}

__device__ __forceinline__ void p0_transpose_item(const float* W, int ldw, int K, int nblk, bf16* WT, const float* kscale, LAS float* scr, int item, int lane) {
    const int kb = item / nblk, nb = item % nblk, k0 = 64 * kb, n0 = 32 * nb;
    float v[32];
#pragma unroll
    for (int i = 0; i < 32; ++i) v[i] = W[(size_t)(k0 + 2 * i + (lane >> 5)) * ldw + n0 + (lane & 31)];
#pragma unroll
    for (int i = 0; i < 32; ++i) { const int kk = 2 * i + (lane >> 5); scr[kk * 33 + (lane & 31)] = kscale ? v[i] * kscale[k0 + kk] : v[i]; }
    LDS_WAIT(); asm volatile("" ::: "memory");
    const int c = lane & 7;
#pragma unroll
    for (int j = 0; j < 4; ++j) { const int n = (lane >> 3) + 8 * j; const LAS float* s = scr + (8 * c) * 33 + n;
        v4u o; o.x = pk2(s[0 * 33], s[1 * 33]); o.y = pk2(s[2 * 33], s[3 * 33]); o.z = pk2(s[4 * 33], s[5 * 33]); o.w = pk2(s[6 * 33], s[7 * 33]);
        *(GAS v4u*)(WT + (size_t)(n0 + n) * K + k0 + 8 * c) = o; }
    LDS_WAIT(); asm volatile("" ::: "memory");
}
__device__ __forceinline__ float log_sigmoid(float f) { return fminf(f, 0.f) - log1pf(expf(-fabsf(f))); }

__device__ __forceinline__ void cvt_small_weights(Frame& F, int bi, int nblk) {
    const float* w_out = F.in[13]; const float* g2 = F.in[14]; const float* w_pq = F.in[15]; const float* sk = F.in[16];
    LAS float* scr = (LAS float*)(F.lds + F.wave * 8448);
    const int gw = bi * NWAVES + F.wave, NGW = nblk * NWAVES;
    constexpr int I_OUT = 16 * 32, I_PQ = 16 * 64;
    for (int it = gw; it < I_OUT + I_PQ; it += NGW) {
        if (it < I_OUT) p0_transpose_item(w_out, DM, DM, 32, WSP(bf16, WS_WOUT), nullptr, scr, it, F.lane);
        else p0_transpose_item(w_pq, 2048, DM, 64, WSP(bf16, WS_WPQ), g2, scr, it - I_OUT, F.lane); }
    bf16* SK = WSP(bf16, WS_SUBK);
    for (int i = bi * NTHR + F.tid; i < 262144 / 8; i += nblk * NTHR) { const f32x4 a = ((const f32x4*)sk)[2 * i], b = ((const f32x4*)sk)[2 * i + 1];
        v4u o; o.x = pk2(a[0], a[1]); o.y = pk2(a[2], a[3]); o.z = pk2(b[0], b[1]); o.w = pk2(b[2], b[3]); ((v4u*)SK)[i] = o; }
}
__device__ __forceinline__ void p0_prologue(Frame& F) {
    const float* x = F.in[0]; const float* g1 = F.in[1]; const float* w_in = F.in[2];
    LAS float* wg = (LAS float*)(F.lds + 98304);
    { float t[16];
#pragma unroll
      for (int i = 0; i < 16; ++i) { const int e = F.tid + i * NTHR; t[i] = w_in[(size_t)(e >> 3) * INCOLS + NPROJ + (e & 7)]; }
#pragma unroll
      for (int i = 0; i < 16; ++i) wg[F.tid + i * NTHR] = t[i]; }
    LAS float* scr = (LAS float*)(F.lds + F.wave * 8448);
    const int gw = F.vcu * NWAVES + F.wave, NGW = F.G * NWAVES;
    constexpr int I_IN = 16 * (NPROJ / 32);
    for (int it = gw; it < I_IN; it += NGW) p0_transpose_item(w_in, INCOLS, DM, NPROJ / 32, WSP(bf16, WS_WIN), nullptr, scr, it, F.lane);
    __syncthreads();
    const float* b_i = F.in[5]; const float* b_f = F.in[6];
    float* GI = WSP(float, WS_GI); float* GLF = WSP(float, WS_GLF); bf16* H1 = WSP(bf16, WS_H1);
    f32x4 gv[4];
#pragma unroll
    for (int j = 0; j < 4; ++j) gv[j] = ((const f32x4*)g1)[F.lane + 64 * j];
    const int gsel = F.lane >> 3; const float gbias = (gsel < 4) ? b_i[gsel] : b_f[gsel - 4];
    f32x4 nv[4];
    if (gw < M) { const f32x4* xr = (const f32x4*)(x + (size_t)gw * DM) + F.lane;
#pragma unroll
        for (int j = 0; j < 4; ++j) nv[j] = __builtin_nontemporal_load(xr + 64 * j); }
    for (int m = gw; m < M; m += NGW) {
        f32x4 v[4]; float s = 0.f;
#pragma unroll
        for (int j = 0; j < 4; ++j) { v[j] = nv[j]; s += (v[j][0] * v[j][0] + v[j][1] * v[j][1]) + (v[j][2] * v[j][2] + v[j][3] * v[j][3]); }
        if (m + NGW < M) { const f32x4* xr = (const f32x4*)(x + (size_t)(m + NGW) * DM) + F.lane;
#pragma unroll
            for (int j = 0; j < 4; ++j) nv[j] = __builtin_nontemporal_load(xr + 64 * j); }
        const float rstd = 1.0f / sqrtf(wave_sum(s) * (1.f / DM) + NORM_EPS);
        float ga[8];
#pragma unroll
        for (int g = 0; g < 8; ++g) ga[g] = 0.f;
        unsigned long long* o8 = (unsigned long long*)(H1 + (size_t)m * DM) + F.lane;
#pragma unroll
        for (int j = 0; j < 4; ++j) { v[j] = v[j] * rstd * gv[j];
            o8[64 * j] = (unsigned long long)pk2(v[j][0], v[j][1]) | ((unsigned long long)pk2(v[j][2], v[j][3]) << 32);
#pragma unroll
            for (int i = 0; i < 4; ++i) { const int e = 4 * F.lane + 256 * j + i; const f32x4 w0 = *(const LAS f32x4*)(wg + e * 8), w1 = *(const LAS f32x4*)(wg + e * 8 + 4);
                ga[0] += v[j][i] * w0[0]; ga[1] += v[j][i] * w0[1]; ga[2] += v[j][i] * w0[2]; ga[3] += v[j][i] * w0[3];
                ga[4] += v[j][i] * w1[0]; ga[5] += v[j][i] * w1[1]; ga[6] += v[j][i] * w1[2]; ga[7] += v[j][i] * w1[3]; } }
        const float gt = reduce8(ga, F.lane) + gbias;
        if ((F.lane & 7) == 0) { const int b = m / SEQ, t = m % SEQ; const size_t o = (size_t)(b * 4 + (gsel & 3)) * SEQ + t;
            if (gsel < 4) GI[o] = gt; else GLF[o] = log_sigmoid(gt); }
    }
}
__device__ __forceinline__ void cvt_peer_tables(Frame& F, int quota) {
    const float* g2 = F.in[14]; const float* ue = F.in[17]; const float* ve = F.in[18];
    unsigned* U8 = WSP(unsigned, WS_UB); unsigned* V8 = WSP(unsigned, WS_VB);
    constexpr int NROW = NEXP, CH = 64, NCHUNK = 2 * NROW / CH;
    f32x4 sc[4];
#pragma unroll
    for (int q = 0; q < 4; ++q) sc[q] = ((const f32x4*)g2)[F.lane + 64 * q];
    for (int nq = 0; nq < quota; ++nq) {
        if (F.tid == 0) F.MISC[17] = __hip_atomic_fetch_add(F.ctl + CW_Q + 1, 1u, __ATOMIC_RELAXED, __HIP_MEMORY_SCOPE_AGENT);
        __syncthreads();
        const int ck = (int)F.MISC[17];
        __syncthreads();
        if (ck >= NCHUNK) break;
#pragma unroll 1
        for (int r0 = ck * CH + F.wave; r0 < (ck + 1) * CH; r0 += 2 * NWAVES) {
            f32x4 v[2][4];
#pragma unroll
            for (int u = 0; u < 2; ++u) { const int r = r0 + u * NWAVES; const f32x4* src = (const f32x4*)((r < NROW ? ue : ve) + (size_t)(r < NROW ? r : r - NROW) * DM) + F.lane;
#pragma unroll
                for (int q = 0; q < 4; ++q) v[u][q] = __builtin_nontemporal_load(src + 64 * q); }
#pragma unroll
            for (int u = 0; u < 2; ++u) { const int r = r0 + u * NWAVES; const bool isu = r < NROW; unsigned* dst = (isu ? U8 : V8) + (size_t)(isu ? r : r - NROW) * (DM / 4) + F.lane;
                {
                    f32x4 w[4]; float mx = 0.f;
#pragma unroll
                    for (int q = 0; q < 4; ++q) { w[q] = isu ? v[u][q] * sc[q] : v[u][q]; mx = fmaxf(fmaxf(mx, fmaxf(fabsf(w[q][0]), fabsf(w[q][1]))), fmaxf(fabsf(w[q][2]), fabsf(w[q][3]))); }
                    mx = wave_max(mx); const float su = mx > 0.f ? mx * (1.0f / 127.0f) : 1.0f, inv = 1.0f / su;
                    if (F.lane == 0) WSP(float, WS_SU)[r] = su;
#pragma unroll
                    for (int q = 0; q < 4; ++q) { const int q0 = (int)rintf(w[q][0] * inv), q1 = (int)rintf(w[q][1] * inv), q2 = (int)rintf(w[q][2] * inv), q3 = (int)rintf(w[q][3] * inv);
                        dst[64 * q] = (unsigned)(q0 & 255) | ((unsigned)(q1 & 255) << 8) | ((unsigned)(q2 & 255) << 16) | ((unsigned)q3 << 24); }
                } }
        }
    }
}

__device__ __forceinline__ void gate_scan(Frame& F, int bh) {
    const float* gi = WSP(float, WS_GI) + (size_t)bh * SEQ + 64 * F.lane; const float* glf = WSP(float, WS_GLF) + (size_t)bh * SEQ + 64 * F.lane;
    float* A2 = WSP(float, WS_A2) + (size_t)bh * SEQ + 64 * F.lane; float* M2 = WSP(float, WS_M2) + (size_t)bh * SEQ + 64 * F.lane; float* NB2 = WSP(float, WS_NB2) + (size_t)bh * SEQ + 64 * F.lane;
    float tot = 0.f;
    for (int j = 0; j < 16; ++j) { const f32x4 v = ((const f32x4*)glf)[j]; tot += v[0]; tot += v[1]; tot += v[2]; tot += v[3]; }
    float inc = tot;
#pragma unroll
    for (int o = 1; o < 64; o <<= 1) { const float u = __shfl_up(inc, o); if (F.lane >= o) inc += u; }
    const float boff = inc - tot;
    float B = boff, lm = -3.0e38f;
    for (int j = 0; j < 16; ++j) { const f32x4 v = ((const f32x4*)glf)[j], iv = ((const f32x4*)gi)[j];
#pragma unroll
        for (int i = 0; i < 4; ++i) { B += v[i]; lm = fmaxf(lm, iv[i] - B); } }
    float incm = lm;
#pragma unroll
    for (int o = 1; o < 64; o <<= 1) { const float u = __shfl_up(incm, o); if (F.lane >= o) incm = fmaxf(incm, u); }
    float pm = __shfl_up(incm, 1); if (F.lane == 0) pm = -3.0e38f;
    B = boff; float Mx = pm;
    for (int j = 0; j < 16; ++j) { const f32x4 v = ((const f32x4*)glf)[j], iv = ((const f32x4*)gi)[j]; f32x4 oa, om, ob;
#pragma unroll
        for (int i = 0; i < 4; ++i) { B += v[i]; const float a = iv[i] - B; Mx = fmaxf(Mx, a); oa[i] = a * LOG2E; om[i] = Mx * LOG2E; ob[i] = -(B + Mx) * LOG2E; }
        ((f32x4*)A2)[j] = oa; ((f32x4*)M2)[j] = om; ((f32x4*)NB2)[j] = ob; }
}

namespace att {
using s16x4 = __attribute__((ext_vector_type(4))) short;
using f32x16 = __attribute__((ext_vector_type(16))) float;
using u32x4 = __attribute__((ext_vector_type(4))) unsigned;
constexpr int SHM_T = 64 * 128 * 2;
#define KSWZ(row, colB) ((row) * 256 + ((colB) ^ (((row) & 7) << 4)))
#define SBAR() __builtin_amdgcn_sched_barrier(0)
#define MFMA32(a, b, c) __builtin_amdgcn_mfma_f32_32x32x16_bf16((a), (b), (c), 0, 0, 0)
__device__ __forceinline__ int crow(int r, int hi) { return (r & 3) + 8 * (r >> 2) + 4 * hi; }
__device__ __forceinline__ unsigned cvtpk(float lo, float hi) { unsigned r; asm volatile("v_cvt_pk_bf16_f32 %0, %1, %2" : "=v"(r) : "v"(lo), "v"(hi)); return r; }
__device__ __forceinline__ int v_st(int k, int c) { const int kk = (k & ~0xC) | ((k & 4) << 1) | ((k & 8) >> 1); return ((kk >> 3) * 4 + (c >> 5)) * 512 + ((kk & 7) * 32 + (c & 31)) * 2; }
__device__ __forceinline__ int v_rd_base(int lane) { return ((lane & 3) << 3) | (((lane >> 2) & 3) << 6) | (((lane >> 4) & 1) << 5) | (((lane >> 5) & 1) << 8); }
constexpr int v_rd_off(int d0, int ks, int half) { return d0 * 512 + ks * 4096 + half * 2048; }
template <int OFF> __device__ __forceinline__ s16x4 tr_read(int vb) { s16x4 r; asm volatile("ds_read_b64_tr_b16 %0, %1 offset:%2" : "=&v"(r) : "v"(vb), "i"(OFF) : "memory"); return r; }
#define PKF(L, H) (bf16x8){L[0], L[1], L[2], L[3], H[0], H[1], H[2], H[3]}
template <int D0, int KS> __device__ __forceinline__ bf16x8 tr_frag(int vb) {
    const s16x4 l = tr_read<v_rd_off(D0, KS, 0)>(vb), h = tr_read<v_rd_off(D0, KS, 1)>(vb); asm volatile("s_waitcnt lgkmcnt(0)" ::: "memory"); return PKF(l, h); }
template <int D0> __device__ __forceinline__ void pv_one(f32x16& od, int vb, bf16x8 pa0, bf16x8 pa1, bf16x8 pa2, bf16x8 pa3) {
    const s16x4 l0 = tr_read<v_rd_off(D0, 0, 0)>(vb), h0 = tr_read<v_rd_off(D0, 0, 1)>(vb), l1 = tr_read<v_rd_off(D0, 1, 0)>(vb), h1 = tr_read<v_rd_off(D0, 1, 1)>(vb);
    const s16x4 l2 = tr_read<v_rd_off(D0, 2, 0)>(vb), h2 = tr_read<v_rd_off(D0, 2, 1)>(vb), l3 = tr_read<v_rd_off(D0, 3, 0)>(vb), h3 = tr_read<v_rd_off(D0, 3, 1)>(vb);
    asm volatile("s_waitcnt lgkmcnt(0)" ::: "memory"); SBAR();
    od = MFMA32(pa0, PKF(l0, h0), od); od = MFMA32(pa1, PKF(l1, h1), od); od = MFMA32(pa2, PKF(l2, h2), od); od = MFMA32(pa3, PKF(l3, h3), od);
}
__device__ __forceinline__ void pv_d0(f32x16* o, int vb, bf16x8 pa0, bf16x8 pa1, bf16x8 pa2, bf16x8 pa3) {
    pv_one<0>(o[0], vb, pa0, pa1, pa2, pa3); pv_one<1>(o[1], vb, pa0, pa1, pa2, pa3); pv_one<2>(o[2], vb, pa0, pa1, pa2, pa3); pv_one<3>(o[3], vb, pa0, pa1, pa2, pa3);
}
__device__ __forceinline__ void pack_p(const f32x16& p0, const f32x16& p1, bf16x8& pa0, bf16x8& pa1, bf16x8& pa2, bf16x8& pa3) {
#define PK4(P, BASE, OUT) do { unsigned a0 = cvtpk(P[BASE + 0], P[BASE + 1]), a1 = cvtpk(P[BASE + 2], P[BASE + 3]);   \
    unsigned b0 = cvtpk(P[BASE + 4], P[BASE + 5]), b1 = cvtpk(P[BASE + 6], P[BASE + 7]);                              \
    auto r0 = __builtin_amdgcn_permlane32_swap(a0, b0, false, false); auto r1 = __builtin_amdgcn_permlane32_swap(a1, b1, false, false); \
    u32x4 w = {r0[0], r1[0], r0[1], r1[1]}; OUT = __builtin_bit_cast(bf16x8, w); } while (0)
    PK4(p0, 0, pa0); PK4(p0, 8, pa1); PK4(p1, 0, pa2); PK4(p1, 8, pa3);
#undef PK4
}
__device__ __forceinline__ float half_swap_max(float v) { auto rr = __builtin_amdgcn_permlane32_swap(__float_as_uint(v), __float_as_uint(v), false, false); return fmaxf(__uint_as_float(rr[0]), __uint_as_float(rr[1])); }
__device__ __forceinline__ float half_swap_add(float v) { auto rr = __builtin_amdgcn_permlane32_swap(__float_as_uint(v), __float_as_uint(v), false, false); return __uint_as_float(rr[0]) + __uint_as_float(rr[1]); }
__device__ __forceinline__ float half_sum32(float v) {
#pragma unroll
    for (int o = 1; o < 32; o <<= 1) v += __shfl_xor(v, o);
    return v;
}

constexpr float THR2 = 10.f;
__device__ __forceinline__ void partialSM(f32x16& p0, f32x16& p1, float& m_reg, float& alpha, float Tj, bool domask, int key0, int qrow, int hi) {
    if (domask) {
#pragma unroll
        for (int r = 0; r < 16; ++r) { const int kv = key0 + crow(r, hi); if (kv > qrow) p0[r] = -INFINITY; if (kv + 32 > qrow) p1[r] = -INFINITY; }
    }
    float pmax = p0[0];
#pragma unroll
    for (int r = 1; r < 16; ++r) pmax = fmaxf(pmax, p0[r]);
#pragma unroll
    for (int r = 0; r < 16; ++r) pmax = fmaxf(pmax, p1[r]);
    pmax = half_swap_max(pmax) + Tj;
    float mn;
    if (__builtin_expect(__all(pmax - m_reg <= THR2), 1)) { mn = m_reg; alpha = 1.f; }
    else { mn = fmaxf(m_reg, pmax); alpha = __builtin_amdgcn_exp2f(m_reg - mn); m_reg = mn; }
    const float off = Tj - mn;
#pragma unroll
    for (int r = 0; r < 16; ++r) p0[r] += off;
#pragma unroll
    for (int r = 0; r < 16; ++r) p1[r] += off;
#pragma unroll
    for (int r = 0; r < 16; ++r) p0[r] = __builtin_amdgcn_exp2f(p0[r]);
}
__device__ __forceinline__ void finishSM(f32x16& p0, f32x16& p1, float alpha, float& l_reg, bf16x8& pa0, bf16x8& pa1, bf16x8& pa2, bf16x8& pa3) {
#pragma unroll
    for (int r = 0; r < 16; ++r) p1[r] = __builtin_amdgcn_exp2f(p1[r]);
    float ps = 0;
#pragma unroll
    for (int r = 0; r < 16; ++r) ps += p0[r];
#pragma unroll
    for (int r = 0; r < 16; ++r) ps += p1[r];
    ps = half_swap_add(ps);
    l_reg = l_reg * alpha + ps;
    pack_p(p0, p1, pa0, pa1, pa2, pa3);
}
__device__ __forceinline__ void qkt4(f32x16& p0, f32x16& p1, const LAS char* Ks, const LAS char* fs, int r32, int hi, int cbase) {
    const bf16x8 kx0 = *(const LAS bf16x8*)(fs + 4096), kx1 = *(const LAS bf16x8*)(fs + 5120), qx = *(const LAS bf16x8*)(fs + 6144);
    p0 = MFMA32(kx0, qx, f32x16{}); p1 = MFMA32(kx1, qx, f32x16{});
#pragma unroll
    for (int d0 = 0; d0 < 4; ++d0) { const int cb = cbase + (d0 * 16 + hi * 8) * 2; const bf16x8 qf = *(const LAS bf16x8*)(fs + d0 * 1024);
        const bf16x8 b0 = *(const LAS bf16x8*)(Ks + KSWZ(r32, cb)); const bf16x8 b1 = *(const LAS bf16x8*)(Ks + KSWZ(32 + r32, cb));
        p0 = MFMA32(b0, qf, p0); p1 = MFMA32(b1, qf, p1); }
}

__device__ __forceinline__ void store_rows(const f32x16 (&o)[4], const float (&rs)[16], const float* colscale, LAS float* stg, bf16* dst, int ldd, const bf16* gate, int ldg, int lane) {
    const int r32 = lane & 31, hi = lane >> 5;
#pragma unroll
    for (int d = 0; d < 4; ++d) { const float cs = colscale[d * 32 + r32];
#pragma unroll
        for (int r = 0; r < 16; ++r) stg[crow(r, hi) * 128 + d * 32 + r32] = o[d][r] * rs[r] * cs; }
    asm volatile("s_waitcnt lgkmcnt(0)" ::: "memory");
#pragma unroll 2
    for (int i = 0; i < 8; ++i) { const int p = i * 64 + lane, row = p >> 4, ch = p & 15;
        f32x4 a = *(const LAS f32x4*)(stg + row * 128 + ch * 8), b = *(const LAS f32x4*)(stg + row * 128 + ch * 8 + 4);
        if (gate) { const bf16x8 gv = *(const bf16x8*)(gate + (size_t)row * ldg + ch * 8);
#pragma unroll
            for (int k = 0; k < 4; ++k) { a[k] = a[k] / (1.0f + __expf(-bf2f((unsigned short)gv[k]))); b[k] = b[k] / (1.0f + __expf(-bf2f((unsigned short)gv[4 + k]))); } }
        u32x4 w = {cvtpk(a[0], a[1]), cvtpk(a[2], a[3]), cvtpk(b[0], b[1]), cvtpk(b[2], b[3])};
        *(u32x4*)(dst + (size_t)row * ldd + ch * 8) = w; }
}

__device__ __forceinline__ void dattn_unit(Frame& F, int b, int h, int qb, float lam) {
    const int tid = F.tid, wid = F.wave, lane = F.lane, r32 = lane & 31, hi = lane >> 5, c = wid & 1, g = wid >> 1;
    LAS char* lds = (LAS char*)F.lds;
    LAS char* V_lds = lds; LAS char* K_lds = lds + 2 * SHM_T;
    LAS float* ws = (LAS float*)(lds + WSCR_OFF) + wid * 128; LAS float* li_l = ws; LAS float* al_l = ws + 32;
    const bf16* DAQ = WSP(bf16, WS_PROJ); const bf16* DAK = DAQ + PROJ_STRIDE; const bf16* DAV = DAQ + 2 * PROJ_STRIDE;
    const int q0 = qb * 128, rw = q0 + 32 * g + r32;
    const bf16* Qw = DAQ + ((size_t)b * SEQ + rw) * PW + h * 128 + c * 64 + hi * 8;
    bf16x8 qr[4];
#pragma unroll
    for (int d0 = 0; d0 < 4; ++d0) qr[d0] = *(const bf16x8*)(Qw + d0 * 16);
    const bf16* Kh = DAK + (size_t)b * SEQ * PW + h * 128; const bf16* Vh = DAV + (size_t)b * SEQ * PW + h * 128;
    const int NT = (q0 + 128) / 64;
    const float slope2 = __builtin_amdgcn_exp2f(-2.0f * (float)(h + 1)) * LOG2E;
    bf16x8 qx = {0, 0, 0, 0, 0, 0, 0, 0}, kx0 = qx, kx1 = qx;
    { const unsigned short shi = (unsigned short)f2bf(slope2); const unsigned short slo = (unsigned short)f2bf(slope2 - bf2f(shi));
      if (hi == 0) { qx[0] = (short)shi; qx[1] = (short)slo; const short k0 = (short)f2bf((float)r32), k1 = (short)f2bf((float)(32 + r32)); kx0[0] = k0; kx0[1] = k0; kx1[0] = k1; kx1[1] = k1; } }
    LAS char* fs = lds + 65536 + wid * 8192 + lane * 16;
    float m_reg = -1e30f, l_reg = 0; f32x16 o[4] = {};
    const int sr = tid >> 4, sc = (tid & 15) * 8, vst0 = v_st(sr, sc), vst1 = v_st(32 + sr, sc);
    const int vb0 = (int)(uintptr_t)V_lds + v_rd_base(lane);
    struct { bf16x8 vs0, vs1, ks0, ks1; } sr_[1];
#define SLOAD(i, k0) do { sr_[i].vs0 = *(const bf16x8*)(&Vh[(size_t)((k0) + sr) * PW + sc]); sr_[i].vs1 = *(const bf16x8*)(&Vh[(size_t)((k0) + 32 + sr) * PW + sc]); \
    sr_[i].ks0 = *(const bf16x8*)(&Kh[(size_t)((k0) + sr) * PW + sc]); sr_[i].ks1 = *(const bf16x8*)(&Kh[(size_t)((k0) + 32 + sr) * PW + sc]); } while (0)
#define SWRITE(bf, i) do { *(LAS bf16x8*)(V_lds + (bf) * SHM_T + vst0) = sr_[i].vs0; *(LAS bf16x8*)(V_lds + (bf) * SHM_T + vst1) = sr_[i].vs1; const int kc = sc * 2; \
    *(LAS bf16x8*)(K_lds + (bf) * SHM_T + KSWZ(sr, kc)) = sr_[i].ks0; *(LAS bf16x8*)(K_lds + (bf) * SHM_T + KSWZ(32 + sr, kc)) = sr_[i].ks1; } while (0)
#define SWAIT() asm volatile("s_waitcnt vmcnt(0)" ::: "memory")
#define RESC(a) do { if (__any((a) < 1.f)) { if (hi == 0) al_l[r32] = (a); asm volatile("s_waitcnt lgkmcnt(0)" ::: "memory"); \
    _Pragma("unroll") for (int d = 0; d < 4; ++d) _Pragma("unroll") for (int r = 0; r < 16; ++r) o[d][r] *= al_l[crow(r, hi)]; } } while (0)
#define TJ(j) (slope2 * 64.f * (float)((j) - NT))
    f32x16 pA0, pA1, pB0, pB1; float alA = 1.f, alB = 1.f; bf16x8 pa0, pa1, pa2, pa3; const int cbase = c * 128;
    LAS float* kmx = (LAS float*)(lds + XTRA_OFF);
    float qn_w;
    { float s = 0.f;
#pragma unroll
      for (int d0 = 0; d0 < 4; ++d0)
#pragma unroll
          for (int e = 0; e < 8; ++e) { const float v = bf2f((unsigned short)qr[d0][e]); s += v * v; }
      s = half_swap_add(s);
#pragma unroll
      for (int o = 1; o < 32; o <<= 1) s = fmaxf(s, __shfl_xor(s, o));
      qn_w = __int_as_float(__builtin_amdgcn_readfirstlane(__float_as_int(sqrtf(s)))); }
#pragma unroll
    for (int d0 = 0; d0 < 4; ++d0) *(LAS bf16x8*)(fs + d0 * 1024) = qr[d0];
    *(LAS bf16x8*)(fs + 4096) = kx0; *(LAS bf16x8*)(fs + 5120) = kx1; *(LAS bf16x8*)(fs + 6144) = qx;
    asm volatile("s_waitcnt lgkmcnt(0)" ::: "memory");
#define KNORM(bf, i) do { float n0 = 0.f, n1 = 0.f; \
    _Pragma("unroll") for (int e = 0; e < 8; ++e) { const float a = bf2f((unsigned short)sr_[i].ks0[e]), b2 = bf2f((unsigned short)sr_[i].ks1[e]); n0 += a * a; n1 += b2 * b2; } \
    n0 += __shfl_xor(n0, 1); n1 += __shfl_xor(n1, 1); n0 += __shfl_xor(n0, 2); n1 += __shfl_xor(n1, 2); n0 += __shfl_xor(n0, 4); n1 += __shfl_xor(n1, 4);     \
    n0 = fmaxf(n0, n1); n0 = fmaxf(n0, __shfl_xor(n0, 16)); n0 = fmaxf(n0, __shfl_xor(n0, 32));                                                                 \
    if ((lane & 7) == 0 && lane < 16) kmx[(bf) * 16 + (lane >> 3) * 8 + wid] = sqrtf(n0); } while (0)
#ifndef DATT_SKIP
#undef KNORM
#define KNORM(bf, i) do { } while (0)
#endif
#define DECIDE(j, bf) ({ const LAS f32x4* kp_ = (const LAS f32x4*)(kmx + (bf) * 16 + c * 8); const f32x4 ka_ = kp_[0], kb_ = kp_[1]; \
    const float km_ = fmaxf(fmaxf(fmaxf(ka_[0], ka_[1]), fmaxf(ka_[2], ka_[3])), fmaxf(fmaxf(kb_[0], kb_[1]), fmaxf(kb_[2], kb_[3]))); \
    float mm_ = m_reg; _Pragma("unroll") for (int o_ = 1; o_ < 32; o_ <<= 1) mm_ = fminf(mm_, __shfl_xor(mm_, o_)); \
    const float ub_ = qn_w * km_ + slope2 * 63.f + TJ(j); __builtin_amdgcn_readfirstlane((int)(ub_ < mm_ - 60.f)) != 0; })
#ifndef DATT_SKIP
#undef DECIDE
#define DECIDE(j, bf) false
#endif
#define TL(i) (NT - 1 - (i))
    constexpr int SE = 0, SO = 0;
    bool skA = false, skB = false;
    SLOAD(SE, TL(0) * 64); asm volatile("s_waitcnt vmcnt(0)" ::: "memory"); SWRITE(0, SE); KNORM(0, SE); __syncthreads();
    qkt4(pA0, pA1, K_lds, fs, r32, hi, cbase); partialSM(pA0, pA1, m_reg, alA, TJ(TL(0)), true, 64 * TL(0), rw, hi);
    SLOAD(SO, TL(1) * 64);
    SWAIT(); SWRITE(1, SO); KNORM(1, SO); __syncthreads();
    for (int i = 1; i + 1 < NT; i += 2) {
        skB = DECIDE(TL(i), 1);
        SBAR(); if (!skB) qkt4(pB0, pB1, K_lds + SHM_T, fs, r32, hi, cbase);
        if (!skA) finishSM(pA0, pA1, alA, l_reg, pa0, pa1, pa2, pa3); SBAR();
        SLOAD(SO, TL(i + 1) * 64); SBAR();
        if (!skA) pv_d0(o, vb0, pa0, pa1, pa2, pa3);
        alB = 1.f; if (!skB) partialSM(pB0, pB1, m_reg, alB, TJ(TL(i)), i < 2, 64 * TL(i), rw, hi);
        __syncthreads(); SWAIT(); SWRITE(0, SE); KNORM(0, SE);
        RESC(alB); __syncthreads();
        skA = DECIDE(TL(i + 1), 0);
        SBAR(); if (!skA) qkt4(pA0, pA1, K_lds, fs, r32, hi, cbase);
        if (!skB) finishSM(pB0, pB1, alB, l_reg, pa0, pa1, pa2, pa3); SBAR();
        SLOAD(SE, TL(i + 2) * 64); SBAR();
        if (!skB) pv_d0(o, vb0 + SHM_T, pa0, pa1, pa2, pa3);
        alA = 1.f; if (!skA) partialSM(pA0, pA1, m_reg, alA, TJ(TL(i + 1)), false, 64 * TL(i + 1), rw, hi);
        __syncthreads(); SWAIT(); SWRITE(1, SO); KNORM(1, SO);
        RESC(alA); __syncthreads();
    }
    skB = DECIDE(TL(NT - 1), 1);
    SBAR(); if (!skB) qkt4(pB0, pB1, K_lds + SHM_T, fs, r32, hi, cbase);
    if (!skA) finishSM(pA0, pA1, alA, l_reg, pa0, pa1, pa2, pa3); SBAR();
    if (!skA) pv_d0(o, vb0, pa0, pa1, pa2, pa3);
    alB = 1.f; if (!skB) partialSM(pB0, pB1, m_reg, alB, TJ(TL(NT - 1)), NT - 1 < 2, 64 * TL(NT - 1), rw, hi);
    __syncthreads(); RESC(alB);
    if (!skB) { finishSM(pB0, pB1, alB, l_reg, pa0, pa1, pa2, pa3); SBAR();
        pv_d0(o, vb0 + SHM_T, pa0, pa1, pa2, pa3); }
    asm volatile("s_waitcnt vmcnt(0)" ::: "memory");
#undef KNORM
#undef DECIDE
#undef TL
#undef SLOAD
#undef SWRITE
#undef SWAIT
#undef RESC
#undef TJ
#ifdef DATT_NO_EPI
    if (l_reg == 123.f) F.out[tid] = o[0][0] + o[1][1] + o[2][2] + o[3][3];
    return;
#endif
    if (hi == 0) li_l[r32] = l_reg; asm volatile("s_waitcnt lgkmcnt(0)" ::: "memory");
    float rli[16];
#pragma unroll
    for (int r = 0; r < 16; ++r) rli[r] = __builtin_amdgcn_rcpf(li_l[crow(r, hi)]);
    __syncthreads();
    LAS float* xb = (LAS float*)lds + g * 4096;
    if (c == 1) {
#pragma unroll
        for (int d = 0; d < 4; ++d)
#pragma unroll
            for (int r = 0; r < 16; ++r) xb[(d * 16 + r) * 64 + lane] = o[d][r] * rli[r];
    }
    __syncthreads();
    if (c == 0) {
        const float* gsub = F.in[11];
        float ssq[16];
#pragma unroll
        for (int r = 0; r < 16; ++r) ssq[r] = 0.f;
#pragma unroll
        for (int d = 0; d < 4; ++d)
#pragma unroll
            for (int r = 0; r < 16; ++r) { const float v = o[d][r] * rli[r] - lam * xb[(d * 16 + r) * 64 + lane]; o[d][r] = v; ssq[r] += v * v; }
#pragma unroll
        for (int r = 0; r < 16; ++r) ssq[r] = (1.0f - LAM_INIT) / sqrtf(half_sum32(ssq[r]) * (1.f / 128.f) + SUBLN_EPS);
        bf16* MIX = WSP(bf16, WS_H1) + ((size_t)b * SEQ + q0 + 32 * g) * DM + h * 128;
        store_rows(o, ssq, gsub, xb, MIX, DM, nullptr, 0, lane);
    }
    __syncthreads();
}

constexpr int MCH = 256, NCH = SEQ / MCH;

__device__ __forceinline__ void conv8(const bf16* raw, size_t rb, int t, int col0, const f32x4 (&w)[4][2], const f32x4 (&bias)[2], float scale, float (&y)[8]) {
    bf16x8 v[4];
#pragma unroll
    for (int j = 0; j < 4; ++j) { const int tt = t - 3 + j; v[j] = *(const bf16x8*)(raw + (rb + (tt < 0 ? 0 : tt)) * PW + col0); }
#pragma unroll
    for (int i = 0; i < 8; ++i) y[i] = bias[i >> 2][i & 3];
#pragma unroll
    for (int j = 0; j < 4; ++j) { const float mk = (t - 3 + j >= 0) ? 1.f : 0.f;
#pragma unroll
        for (int i = 0; i < 8; ++i) y[i] += (w[j][i >> 2][i & 3] * mk) * bf2f((unsigned short)v[j][i]); }
#pragma unroll
    for (int i = 0; i < 8; ++i) y[i] = y[i] / (1.0f + __expf(-y[i])) * scale;
}
__device__ __forceinline__ bf16x8 pack8(const float (&y)[8]) { u32x4 w = {cvtpk(y[0], y[1]), cvtpk(y[2], y[3]), cvtpk(y[4], y[5]), cvtpk(y[6], y[7])}; return __builtin_bit_cast(bf16x8, w); }
__device__ __forceinline__ void load_convw(const float* conv_w, const float* conv_b, int ch0, f32x4 (&w)[4][2], f32x4 (&bias)[2]) {
#pragma unroll
    for (int j = 0; j < 4; ++j) { w[j][0] = *(const f32x4*)(conv_w + j * 1024 + ch0); w[j][1] = *(const f32x4*)(conv_w + j * 1024 + ch0 + 4); }
    bias[0] = *(const f32x4*)(conv_b + ch0); bias[1] = *(const f32x4*)(conv_b + ch0 + 4);
}
__device__ __forceinline__ void split3(float x, short& a, short& b, short& c) {
    const unsigned short h = (unsigned short)f2bf(x); const float r1 = x - bf2f(h); const unsigned short m = (unsigned short)f2bf(r1); const float r2 = r1 - bf2f(m); const unsigned short l = (unsigned short)f2bf(r2);
    a = (short)h; b = (short)m; c = (short)l;
}

__device__ __forceinline__ void mlstm_state_item(Frame& F, int bh, int c) {
    const int tid = F.tid, wid = F.wave, lane = F.lane, r32 = lane & 31, hi = lane >> 5;
    const int b = bh >> 2, hh = bh & 3, t0 = c * MCH;
    LAS char* lds = (LAS char*)F.lds; LAS char* Kimg = lds; LAS char* Vimg = lds + 4 * SHM_T;
    const bf16* MLK = WSP(bf16, WS_PROJ) + 4 * PROJ_STRIDE; const bf16* MLV = WSP(bf16, WS_PROJ) + 5 * PROJ_STRIDE;
    const float* A2 = WSP(float, WS_A2) + (size_t)bh * SEQ + t0;
    float am = (tid < MCH) ? A2[tid] : -3.0e38f; am = wave_max(am);
    LAS float* red = (LAS float*)(lds + XTRA_OFF);
    if (lane == 0) red[wid] = am;
    __syncthreads();
    float mloc = red[0];
#pragma unroll
    for (int w = 1; w < 8; ++w) mloc = fmaxf(mloc, red[w]);
    if (tid == 0) WSP(float, WS_MLOC)[bh * NCH + c] = mloc;
    const int cg = tid & 15; const size_t rb = (size_t)b * SEQ;
    f32x4 cw[4][2], cb[2]; load_convw(F.in[3], F.in[4], 512 + hh * 128 + cg * 8, cw, cb);
#pragma unroll 2
    for (int i = 0; i < 8; ++i) { const int row = (tid >> 4) + 32 * i, t = t0 + row; float y[8];
        conv8(MLK, rb, t, hh * 128 + cg * 8, cw, cb, MLK_SCALE, y);
        const float wgt = __builtin_amdgcn_exp2f(A2[row] - mloc);
#pragma unroll
        for (int e = 0; e < 8; ++e) y[e] *= wgt;
        *(LAS bf16x8*)(Kimg + (row >> 6) * SHM_T + v_st(row & 63, cg * 8)) = pack8(y);
        *(LAS bf16x8*)(Vimg + (row >> 6) * SHM_T + v_st(row & 63, cg * 8)) = *(const bf16x8*)(MLV + (rb + t) * PW + hh * 128 + cg * 8); }
    __syncthreads();
    const int id0 = wid * 2, dvb = id0 >> 2, dkb0 = id0 & 3;
    f32x16 acc0 = {}, acc1 = {}, accn = {};
    const bf16x8 ones = {0x3F80, 0x3F80, 0x3F80, 0x3F80, 0x3F80, 0x3F80, 0x3F80, 0x3F80};
    const int vbK = (int)(uintptr_t)Kimg + v_rd_base(lane), vbV = (int)(uintptr_t)Vimg + v_rd_base(lane);
#define ST_STEP(KS) do { \
        bf16x8 af, b0f, b1f, bnf; \
        af = (dvb == 0) ? tr_frag<0, KS>(vbV + tt * SHM_T) : (dvb == 1) ? tr_frag<1, KS>(vbV + tt * SHM_T) : (dvb == 2) ? tr_frag<2, KS>(vbV + tt * SHM_T) : tr_frag<3, KS>(vbV + tt * SHM_T); \
        if (dkb0 == 0) { b0f = tr_frag<0, KS>(vbK + tt * SHM_T); b1f = tr_frag<1, KS>(vbK + tt * SHM_T); } else { b0f = tr_frag<2, KS>(vbK + tt * SHM_T); b1f = tr_frag<3, KS>(vbK + tt * SHM_T); } \
        acc0 = MFMA32(af, b0f, acc0); acc1 = MFMA32(af, b1f, acc1); \
        if (wid < 4) { bnf = (wid == 0) ? tr_frag<0, KS>(vbK + tt * SHM_T) : (wid == 1) ? tr_frag<1, KS>(vbK + tt * SHM_T) : (wid == 2) ? tr_frag<2, KS>(vbK + tt * SHM_T) : tr_frag<3, KS>(vbK + tt * SHM_T); \
            accn = MFMA32(ones, bnf, accn); } } while (0)
    for (int tt = 0; tt < 4; ++tt) { ST_STEP(0); ST_STEP(1); ST_STEP(2); ST_STEP(3); }
#undef ST_STEP
    bf16* DCT = WSP(bf16, WS_DCT) + ((size_t)(bh * NCH + c) << 14);
#pragma unroll
    for (int r = 0; r < 16; ++r) { const int dv = 32 * dvb + crow(r, hi);
        DCT[dv * 128 + 32 * dkb0 + r32] = (bf16)f2bf(acc0[r]); DCT[dv * 128 + 32 * (dkb0 + 1) + r32] = (bf16)f2bf(acc1[r]); }
    if (wid < 4 && hi == 0) WSP(float, WS_DN)[(size_t)(bh * NCH + c) * 128 + 32 * wid + r32] = accn[0];
    __syncthreads();
}

__device__ __forceinline__ void mlstm_out_unit(Frame& F, int bh, int c) {
    const int tid = F.tid, wid = F.wave, lane = F.lane, r32 = lane & 31, hi = lane >> 5;
    const int rg = wid < 4 ? wid : 11 - wid;
    const int b = bh >> 2, hh = bh & 3, t0 = c * MCH; const size_t rb = (size_t)b * SEQ;
    LAS char* lds = (LAS char*)F.lds; LAS char* Kimg = lds; LAS char* Vimg = lds + 4 * SHM_T; LAS char* Cimg = lds + 4 * SHM_T; LAS float* nref = (LAS float*)(lds + 6 * SHM_T);
    LAS float* ws = (LAS float*)(lds + WSCR_OFF) + wid * 128; LAS float* f_l = ws; LAS float* rn_l = ws + 32;
    const bf16* MLQ = WSP(bf16, WS_PROJ) + 3 * PROJ_STRIDE; const bf16* MLK = MLQ + PROJ_STRIDE; const bf16* MLV = MLQ + 2 * PROJ_STRIDE; const bf16* MLO = MLQ + 3 * PROJ_STRIDE;
    const float* A2 = WSP(float, WS_A2) + (size_t)bh * SEQ; const float* M2 = WSP(float, WS_M2) + (size_t)bh * SEQ; const float* NB2 = WSP(float, WS_NB2) + (size_t)bh * SEQ;
    const int trow = t0 + 32 * rg + r32;
    const float m2t = M2[trow], nb2t = NB2[trow];
    const float mref2 = (c > 0) ? M2[t0 - 1] : -1e30f;
    { const int cg = tid & 15; f32x4 cw[4][2], cb[2]; load_convw(F.in[3], F.in[4], hh * 128 + cg * 8, cw, cb);
#pragma unroll 4
      for (int i = 0; i < 8; ++i) { const int row = (tid >> 4) + 32 * i; float y[8];
          conv8(MLQ, rb, t0 + row, hh * 128 + cg * 8, cw, cb, 1.0f, y);
          *(LAS bf16x8*)(Kimg + (row >> 6) * SHM_T + KSWZ(row & 63, cg * 16)) = pack8(y); } }
    __syncthreads();
    bf16x8 qr[8];
    { const int row = 32 * rg + r32;
#pragma unroll
      for (int d0 = 0; d0 < 8; ++d0) qr[d0] = *(const LAS bf16x8*)(Kimg + (row >> 6) * SHM_T + KSWZ(row & 63, (d0 * 16 + hi * 8) * 2)); }
    f32x16 o[4] = {}; float den = 0.f;
    if (c > 0) {
        const float* ML = WSP(float, WS_MLOC) + bh * NCH; const bf16* DCT = WSP(bf16, WS_DCT) + ((size_t)(bh * NCH) << 14); const float* DN = WSP(float, WS_DN) + (size_t)(bh * NCH) * 128;
        { const int dv = tid >> 2, dk0 = (tid & 3) * 32; f32x4 a[8];
#pragma unroll
          for (int i = 0; i < 8; ++i) a[i] = (f32x4){0.f, 0.f, 0.f, 0.f};
          for (int cp = 0; cp < c; cp += 4) {
              float cf[4]; const bf16x8* sp[4];
#pragma unroll
              for (int u = 0; u < 4; ++u) { const int cq = cp + u < c ? cp + u : cp; cf[u] = cp + u < c ? __builtin_amdgcn_exp2f(ML[cq] - mref2) : 0.f; sp[u] = (const bf16x8*)(DCT + ((size_t)cq << 14) + dv * 128 + dk0); }
              bf16x8 u0[4], u1[4], u2[4], u3[4];
#pragma unroll
              for (int i = 0; i < 4; ++i) { u0[i] = sp[0][i]; u1[i] = sp[1][i]; u2[i] = sp[2][i]; u3[i] = sp[3][i]; }
#pragma unroll
              for (int i = 0; i < 4; ++i)
#pragma unroll
                  for (int e = 0; e < 8; ++e) a[2 * i + (e >> 2)][e & 3] += (bf2f((unsigned short)u0[i][e]) * cf[0] + bf2f((unsigned short)u1[i][e]) * cf[1]) + (bf2f((unsigned short)u2[i][e]) * cf[2] + bf2f((unsigned short)u3[i][e]) * cf[3]); }
#pragma unroll
          for (int i = 0; i < 4; ++i) { u32x4 w = {cvtpk(a[2 * i][0], a[2 * i][1]), cvtpk(a[2 * i][2], a[2 * i][3]), cvtpk(a[2 * i + 1][0], a[2 * i + 1][1]), cvtpk(a[2 * i + 1][2], a[2 * i + 1][3])};
              *(LAS u32x4*)(Cimg + KSWZ(dv, (dk0 + 8 * i) * 2)) = w; }
          if (tid < 128) { float s = 0.f; for (int cp = 0; cp < c; ++cp) s += DN[cp * 128 + tid] * __builtin_amdgcn_exp2f(ML[cp] - mref2); nref[tid] = s; } }
        __syncthreads();
#pragma unroll
        for (int d = 0; d < 4; ++d)
#pragma unroll
            for (int ks = 0; ks < 8; ++ks) { const bf16x8 cf = *(const LAS bf16x8*)(Cimg + KSWZ(32 * d + r32, (16 * ks + 8 * hi) * 2)); o[d] = MFMA32(qr[ks], cf, o[d]); }
        float dn = 0.f;
#pragma unroll
        for (int ks = 0; ks < 8; ++ks) { const f32x4 n0 = *(const LAS f32x4*)(nref + 16 * ks + 8 * hi), n1 = *(const LAS f32x4*)(nref + 16 * ks + 8 * hi + 4);
#pragma unroll
            for (int j = 0; j < 4; ++j) { dn += bf2f((unsigned short)qr[ks][j]) * n0[j]; dn += bf2f((unsigned short)qr[ks][4 + j]) * n1[j]; } }
        dn = half_swap_add(dn);
        const float ft = __builtin_amdgcn_exp2f(mref2 - m2t);
        den = ft * dn;
        if (hi == 0) f_l[r32] = ft; asm volatile("s_waitcnt lgkmcnt(0)" ::: "memory");
#pragma unroll
        for (int d = 0; d < 4; ++d)
#pragma unroll
            for (int r = 0; r < 16; ++r) o[d][r] *= f_l[crow(r, hi)];
        __syncthreads();
    }
    __syncthreads();
    { const int cg = tid & 15; f32x4 cw[4][2], cb[2]; load_convw(F.in[3], F.in[4], 512 + hh * 128 + cg * 8, cw, cb);
#pragma unroll 2
      for (int i = 0; i < 8; ++i) { const int row = (tid >> 4) + 32 * i, t = t0 + row; float y[8];
          conv8(MLK, rb, t, hh * 128 + cg * 8, cw, cb, MLK_SCALE, y);
          *(LAS bf16x8*)(Kimg + (row >> 6) * SHM_T + KSWZ(row & 63, cg * 16)) = pack8(y);
          *(LAS bf16x8*)(Vimg + (row >> 6) * SHM_T + v_st(row & 63, cg * 8)) = *(const bf16x8*)(MLV + (rb + t) * PW + hh * 128 + cg * 8); } }
    __syncthreads();
    bf16x8 qx = {0, 0, 0, 0, 0, 0, 0, 0};
    if (hi == 0) { short a, bq, cq; split3(-m2t, a, bq, cq); qx[0] = 0x3F80; qx[1] = 0x3F80; qx[2] = 0x3F80; qx[3] = a; qx[4] = bq; qx[5] = cq; }
    const int ntile = (rg >> 1) + 1;
    for (int jt = 0; jt < ntile; ++jt) {
        const LAS char* Ks = Kimg + jt * SHM_T;
        bf16x8 kx0 = {0, 0, 0, 0, 0, 0, 0, 0}, kx1 = kx0;
        if (hi == 0) { short a, bq, cq; split3(A2[t0 + 64 * jt + r32], a, bq, cq); kx0[0] = a; kx0[1] = bq; kx0[2] = cq; kx0[3] = 0x3F80; kx0[4] = 0x3F80; kx0[5] = 0x3F80;
                       split3(A2[t0 + 64 * jt + 32 + r32], a, bq, cq); kx1[0] = a; kx1[1] = bq; kx1[2] = cq; kx1[3] = 0x3F80; kx1[4] = 0x3F80; kx1[5] = 0x3F80; }
        f32x16 e0 = MFMA32(kx0, qx, f32x16{}), e1 = MFMA32(kx1, qx, f32x16{});
        f32x16 p0 = {}, p1 = {};
#pragma unroll
        for (int d0 = 0; d0 < 8; ++d0) { const int cbb = (d0 * 16 + hi * 8) * 2;
            const bf16x8 b0 = *(const LAS bf16x8*)(Ks + KSWZ(r32, cbb)); const bf16x8 b1 = *(const LAS bf16x8*)(Ks + KSWZ(32 + r32, cbb));
            p0 = MFMA32(b0, qr[d0], p0); p1 = MFMA32(b1, qr[d0], p1); }
        const bool diag = (jt == ntile - 1); const int qrel = 32 * rg + r32 - 64 * jt;
        float ps = 0.f;
#pragma unroll
        for (int r = 0; r < 16; ++r) { const int kv = crow(r, hi);
            float v0 = p0[r] * __builtin_amdgcn_exp2f(fminf(e0[r], 0.f)), v1 = p1[r] * __builtin_amdgcn_exp2f(fminf(e1[r], 0.f));
            if (diag) { if (kv > qrel) v0 = 0.f; if (kv + 32 > qrel) v1 = 0.f; }
            p0[r] = v0; p1[r] = v1; ps += v0 + v1; }
        den += half_swap_add(ps);
        bf16x8 pa0, pa1, pa2, pa3; pack_p(p0, p1, pa0, pa1, pa2, pa3);
        pv_d0(o, (int)(uintptr_t)(Vimg + jt * SHM_T) + v_rd_base(lane), pa0, pa1, pa2, pa3);
    }
    { const float nrm = fmaxf(fabsf(den), __builtin_amdgcn_exp2f(nb2t));
      if (hi == 0) rn_l[r32] = 1.0f / nrm; asm volatile("s_waitcnt lgkmcnt(0)" ::: "memory"); }
    const float* gml = F.in[12] + hh * 128;
    float ssq[16];
#pragma unroll
    for (int r = 0; r < 16; ++r) { const float rn = rn_l[crow(r, hi)]; float s = 0.f;
#pragma unroll
        for (int d = 0; d < 4; ++d) { o[d][r] *= rn; s += o[d][r] * o[d][r]; }
        ssq[r] = s; }
#pragma unroll
    for (int r = 0; r < 16; ++r) ssq[r] = 1.0f / sqrtf(half_sum32(ssq[r]) * (1.f / 128.f) + NORM_EPS);
    __syncthreads();
    bf16* MIX = WSP(bf16, WS_H1) + (rb + t0 + 32 * rg) * DM + 512 + hh * 128;
    const bf16* Og = MLO + (rb + t0 + 32 * rg) * PW + hh * 128;
    store_rows(o, ssq, gml, (LAS float*)lds + wid * 4096, MIX, DM, Og, PW, lane);
    __syncthreads();
}
}

namespace peer {
using att::f32x16; using att::crow;
__device__ __forceinline__ unsigned ordf(float f) { const unsigned u = __float_as_uint(f); return u ^ ((u >> 31) ? 0xFFFFFFFFu : 0x80000000u); }
__device__ __forceinline__ float unordf(unsigned k) { return __uint_as_float(k ^ ((k >> 31) ? 0x80000000u : 0xFFFFFFFFu)); }
#define CAS_D(a, b) do { const unsigned _x = (a) > (b) ? (a) : (b), _n = (a) > (b) ? (b) : (a); (a) = _x; (b) = _n; } while (0)
struct SortNet { unsigned char a[63], b[63]; };
constexpr SortNet make_sortnet() { SortNet s{}; const int p[63][2] = {{0,1},{2,3},{0,2},{1,3},{1,2},{4,5},{6,7},{4,6},{5,7},{5,6},{0,4},{2,6},{2,4},{1,5},{3,7},{3,5},{1,2},{3,4},{5,6},{8,9},{10,11},{8,10},{9,11},{9,10},{12,13},{14,15},{12,14},{13,15},{13,14},{8,12},{10,14},{10,12},{9,13},{11,15},{11,13},{9,10},{11,12},{13,14},{0,8},{4,12},{4,8},{2,10},{6,14},{6,10},{2,4},{6,8},{10,12},{1,9},{5,13},{5,9},{3,11},{7,15},{7,11},{3,5},{7,9},{11,13},{1,2},{3,4},{5,6},{7,8},{9,10},{11,12},{13,14}}; for (int i = 0; i < 63; ++i) { s.a[i] = (unsigned char)p[i][0]; s.b[i] = (unsigned char)p[i][1]; } return s; }
constexpr SortNet SORTNET = make_sortnet();
template <bool DESC> __device__ __forceinline__ void bsort16(unsigned (&v)[16]) {
#pragma unroll
    for (int c = 0; c < 63; ++c) { const int i = SORTNET.a[c], j = SORTNET.b[c]; if (DESC) CAS_D(v[i], v[j]); else CAS_D(v[j], v[i]); }
}
__device__ __forceinline__ void bmerge16_desc(unsigned (&v)[16]) {
#pragma unroll
    for (int j = 8; j > 0; j >>= 1)
#pragma unroll
        for (int i = 0; i < 16; ++i) { const int l = i ^ j; if (l > i) CAS_D(v[i], v[l]); }
}
__device__ __forceinline__ void merge_in(unsigned (&T)[16], unsigned (&N)[16]) {
    bsort16<false>(N);
#pragma unroll
    for (int i = 0; i < 16; ++i) T[i] = T[i] > N[i] ? T[i] : N[i];
    bmerge16_desc(T);
}
__device__ __forceinline__ void top16_of_tile(const f32x16 (&acc)[4], int hi, unsigned (&T)[16]) {
    unsigned N[16];
#pragma unroll
    for (int r = 0; r < 16; ++r) T[r] = (ordf(acc[0][r]) & ~0x7Fu) | (unsigned)(crow(r, hi));
    bsort16<true>(T);
#pragma unroll
    for (int mt = 1; mt < 4; ++mt) {
#pragma unroll
        for (int r = 0; r < 16; ++r) N[r] = (ordf(acc[mt][r]) & ~0x7Fu) | (unsigned)(32 * mt + crow(r, hi));
        merge_in(T, N); }
#pragma unroll
    for (int i = 0; i < 16; ++i) N[i] = (unsigned)__shfl_xor((int)T[15 - i], 32);
#pragma unroll
    for (int i = 0; i < 16; ++i) T[i] = T[i] > N[i] ? T[i] : N[i];
    bmerge16_desc(T);
}
struct CandTab { unsigned char ij[64]; };
constexpr CandTab make_cands() { CandTab t{}; int n = 0; for (int i = 0; i < 16; ++i) for (int j = i; j < 16; ++j) if ((i + 1) * (j + 1) <= 16) t.ij[n++] = (unsigned char)(i * 16 + j); for (; n < 64; ++n) t.ij[n] = 255; return t; }
constexpr CandTab CANDS = make_cands();

__device__ __forceinline__ void peer_topk_phase(Frame& F) {
    const int tid = F.tid, wid = F.wave, lane = F.lane, r32 = lane & 31, hi = lane >> 5;
    const int h = F.vcu & 7, bq = F.vcu >> 3, nbq = F.G >> 3;
    LAS char* lds = (LAS char*)F.lds;
    const bf16* SK = WSP(bf16, WS_SUBK) + (size_t)h * 2 * 128 * 128;
    { bf16x8 t[8];
#pragma unroll
      for (int u = 0; u < 8; ++u) { const int i = tid + u * NTHR; const int cc = i >> 11, r = (i >> 4) & 127, ch = i & 15; t[u] = *(const bf16x8*)(SK + (size_t)cc * 16384 + r * 128 + ch * 8); }
#pragma unroll
      for (int u = 0; u < 8; ++u) { const int i = tid + u * NTHR; const int cc = i >> 11, r = (i >> 4) & 127, ch = i & 15; *(LAS bf16x8*)(lds + cc * 32768 + KSWZ(r, ch * 16)) = t[u]; } }
    __syncthreads();
    const bf16* QP = (h < 4) ? WSP(bf16, WS_H1) + h * 256 : WSP(bf16, WS_QPB) + (h - 4) * 256;
    LAS unsigned char* ixs = (LAS unsigned char*)(lds + XTRA_OFF) + tid * 32;
    unsigned long long* PE = WSP(unsigned long long, WS_PE);
    for (int tg = bq * NWAVES + wid; tg < M / 32; tg += nbq * NWAVES) {
        const int tok = tg * 32 + r32;
        unsigned T1[16], T2[16];
#pragma unroll
        for (int cc = 0; cc < 2; ++cc) {
            bf16x8 qf[8];
#pragma unroll
            for (int ks = 0; ks < 8; ++ks) qf[ks] = *(const bf16x8*)(QP + (size_t)tok * DM + cc * 128 + 16 * ks + 8 * hi);
            f32x16 acc[4];
#pragma unroll
            for (int mt = 0; mt < 4; ++mt) { acc[mt] = f32x16{};
#pragma unroll
                for (int ks = 0; ks < 8; ++ks) { const bf16x8 af = *(const LAS bf16x8*)(lds + cc * 32768 + KSWZ(32 * mt + r32, (16 * ks + 8 * hi) * 2)); acc[mt] = MFMA32(af, qf[ks], acc[mt]); } }
            if (cc == 0) top16_of_tile(acc, hi, T1); else top16_of_tile(acc, hi, T2);
        }
        { v4u w1, w2;
#pragma unroll
          for (int q = 0; q < 4; ++q) { w1[q] = (T1[4 * q] & 0x7F) | ((T1[4 * q + 1] & 0x7F) << 8) | ((T1[4 * q + 2] & 0x7F) << 16) | ((T1[4 * q + 3] & 0x7F) << 24);
                                        w2[q] = (T2[4 * q] & 0x7F) | ((T2[4 * q + 1] & 0x7F) << 8) | ((T2[4 * q + 2] & 0x7F) << 16) | ((T2[4 * q + 3] & 0x7F) << 24); }
          *(LAS v4u*)ixs = w1; *(LAS v4u*)(ixs + 16) = w2; }
        float s1[16], s2[16];
#pragma unroll
        for (int i = 0; i < 16; ++i) { s1[i] = unordf(T1[i] & ~0x7Fu); s2[i] = unordf(T2[i] & ~0x7Fu); }
        unsigned R[16], N[16];
        float sa[16], sb[16];
#pragma unroll
        for (int i = 0; i < 16; ++i) { sa[i] = hi ? s2[i] : s1[i]; sb[i] = hi ? s1[i] : s2[i]; }
#pragma unroll
        for (int ch = 0; ch < 2; ++ch) {
#pragma unroll
            for (int q = 0; q < 16; ++q) { const int ij = CANDS.ij[ch * 16 + q]; const int ii = (ij >> 4) & 15, jj = ij & 15;
                const unsigned code = hi ? (unsigned)(jj * 16 + ii) : (unsigned)ij;
                unsigned kk = (ij == 255 || (ii == jj && hi)) ? 0u : ((ordf(sa[ii] + sb[jj]) & ~0xFFu) | code);
                if (ch == 0) R[q] = kk; else N[q] = kk; }
            if (ch == 0) bsort16<true>(R); else merge_in(R, N); }
#pragma unroll
        for (int i = 0; i < 16; ++i) N[i] = (unsigned)__shfl_xor((int)R[15 - i], 32);
#pragma unroll
        for (int i = 0; i < 16; ++i) R[i] = R[i] > N[i] ? R[i] : N[i];
        bmerge16_desc(R);
        asm volatile("s_waitcnt lgkmcnt(0)" ::: "memory");
        const float mx = unordf(R[0] & ~0xFFu); float ev[16], es = 0.f;
#pragma unroll
        for (int k = 0; k < 16; ++k) { ev[k] = __expf(unordf(R[k] & ~0xFFu) - mx); es += ev[k]; }
        const float inv = 1.0f / es;
        if (hi == 0) {
#pragma unroll
            for (int k = 0; k < 16; k += 2) { v4u w;
                w[0] = (unsigned)ixs[(R[k] >> 4) & 15] * 128u + (unsigned)ixs[16 + (R[k] & 15)]; w[1] = __float_as_uint(ev[k] * inv);
                w[2] = (unsigned)ixs[(R[k + 1] >> 4) & 15] * 128u + (unsigned)ixs[16 + (R[k + 1] & 15)]; w[3] = __float_as_uint(ev[k + 1] * inv);
                *(v4u*)(PE + (size_t)tok * 128 + h * 16 + k) = w; }
        }
    }
    __syncthreads();
}

__device__ __forceinline__ float gelu_erf(float a) { return 0.5f * a * (1.0f + erff(a * 0.70710678118654752f)); }
typedef float f32x2g __attribute__((ext_vector_type(2)));
typedef __bf16 bf16x2_t __attribute__((ext_vector_type(2)));
__device__ __forceinline__ bf16x2_t asbf2(unsigned v) { return __builtin_bit_cast(bf16x2_t, v); }
__device__ __forceinline__ float reduce4(const float (&d)[4]) {
    float s[2];
#pragma unroll
    for (int k = 0; k < 2; ++k) { auto r = __builtin_amdgcn_permlane32_swap(__float_as_uint(d[k]), __float_as_uint(d[k + 2]), false, false); s[k] = __uint_as_float(r[0]) + __uint_as_float(r[1]); }
    auto r2 = __builtin_amdgcn_permlane16_swap(__float_as_uint(s[0]), __float_as_uint(s[1]), false, false);
    float r = __uint_as_float(r2[0]) + __uint_as_float(r2[1]);
    r += dppf<0xB1>(r); r += dppf<0x4E>(r); r += dppf<0x141>(r); r += dppf<0x128>(r);
    return r;
}
#define PG_GSH 11
#define PG_NGRP (16384 >> PG_GSH)
__device__ __forceinline__ void peer_gather_phase(Frame& F) {
    const int lane = F.lane, wid = F.wave; const int gw = F.vcu * NWAVES + wid;
    LAS char* lds = (LAS char*)F.lds;
    const float* X1 = WSP(float, WS_X1); const bf16* X1B = WSP(bf16, WS_X1B); const float* SSP = WSP(float, WS_SSP);
    const unsigned char* U8 = WSP(unsigned char, WS_UB); const unsigned char* V8 = WSP(unsigned char, WS_VB);
    const unsigned long long* PE = WSP(unsigned long long, WS_PE); const float* fg = F.in[19];
    unsigned long long* LIST = WSP(unsigned long long, WS_LIST) + (size_t)gw * 1024;
    float* WL = WSP(float, WS_WL) + (size_t)gw * 1024;
    const int tok0 = gw * 8;
    LAS float* rstd_l = (LAS float*)(lds + XTRA_OFF) + wid * 8;
    LAS unsigned* wmax_l = (LAS unsigned*)(lds + XTRA_OFF + 512) + wid * 8;
    if (lane < 8) wmax_l[lane] = 0u;
    LAS unsigned* bstart = (LAS unsigned*)(lds + XTRA_OFF + 1024) + wid * 256; LAS unsigned* bend = bstart + 128;
#pragma unroll
    for (int j = 0; j < 8; ++j) { const bf16x8* src = (const bf16x8*)(X1B + (size_t)(tok0 + j) * DM); const bf16x8 a = src[2 * lane], b = src[2 * lane + 1];
        float xf[16]; float mx = 0.f;
#pragma unroll
        for (int e = 0; e < 8; ++e) { xf[e] = bf2f((unsigned short)a[e]); xf[8 + e] = bf2f((unsigned short)b[e]); mx = fmaxf(mx, fmaxf(fabsf(xf[e]), fabsf(xf[8 + e]))); }
        mx = wave_max(mx); const float sx = mx > 0.f ? mx * (1.0f / 127.0f) : 1.0f, inv = 1.0f / sx;
        v4u o;
#pragma unroll
        for (int q = 0; q < 4; ++q) { const int q0 = (int)rintf(xf[4 * q] * inv), q1 = (int)rintf(xf[4 * q + 1] * inv), q2 = (int)rintf(xf[4 * q + 2] * inv), q3 = (int)rintf(xf[4 * q + 3] * inv);
            o[q] = (unsigned)(q0 & 255) | ((unsigned)(q1 & 255) << 8) | ((unsigned)(q2 & 255) << 16) | ((unsigned)q3 << 24); }
        *(LAS v4u*)(lds + (wid * 8 + j) * 1024 + lane * 16) = o;
        if (lane == 0) { const f32x4* sp = (const f32x4*)(SSP + (size_t)(tok0 + j) * 16); const f32x4 sa = sp[0], sb = sp[1], sc = sp[2], sd = sp[3];
            const float s = ((sa[0] + sa[1]) + (sa[2] + sa[3])) + ((sb[0] + sb[1]) + (sb[2] + sb[3])) + ((sc[0] + sc[1]) + (sc[2] + sc[3])) + ((sd[0] + sd[1]) + (sd[2] + sd[3]));
            rstd_l[j] = sx / sqrtf(s * (1.0f / 1024.0f) + NORM_EPS); } }
    bstart[lane] = 0u; bstart[64 + lane] = 0u;
    { v4u ent[8]; const unsigned ts = (unsigned)(lane >> 3);
      { const v4u* pe = (const v4u*)(PE + (size_t)(tok0 + (lane >> 3)) * 128 + (lane & 7) * 16);
#pragma unroll
        for (int i = 0; i < 8; ++i) ent[i] = pe[i]; }
#pragma unroll
      for (int i = 0; i < 8; ++i) { __hip_atomic_fetch_add(bstart + ((ent[i][0] >> PG_GSH) * 8 + ts), 1u, __ATOMIC_RELAXED, __HIP_MEMORY_SCOPE_WORKGROUP); __hip_atomic_fetch_add(bstart + ((ent[i][2] >> PG_GSH) * 8 + ts), 1u, __ATOMIC_RELAXED, __HIP_MEMORY_SCOPE_WORKGROUP); }
      { const unsigned c0 = bstart[2 * lane], c1 = bstart[2 * lane + 1]; unsigned inc = c0 + c1;
#pragma unroll
        for (int o = 1; o < 64; o <<= 1) { const unsigned u = (unsigned)__shfl_up((int)inc, o); if (lane >= o) inc += u; }
        const unsigned b0 = inc - (c0 + c1); bstart[2 * lane] = b0; bstart[2 * lane + 1] = b0 + c0; bend[2 * lane] = b0; bend[2 * lane + 1] = b0 + c0; }
#pragma unroll
      for (int i = 0; i < 8; ++i) {
          const unsigned p0 = __hip_atomic_fetch_add(bend + ((ent[i][0] >> PG_GSH) * 8 + ts), 1u, __ATOMIC_RELAXED, __HIP_MEMORY_SCOPE_WORKGROUP);
          LIST[p0] = (unsigned long long)(ent[i][0] | (ts << 16)) | ((unsigned long long)ent[i][1] << 32);
          const unsigned p1 = __hip_atomic_fetch_add(bend + ((ent[i][2] >> PG_GSH) * 8 + ts), 1u, __ATOMIC_RELAXED, __HIP_MEMORY_SCOPE_WORKGROUP);
          LIST[p1] = (unsigned long long)(ent[i][2] | (ts << 16)) | ((unsigned long long)ent[i][3] << 32); } }
    asm volatile("s_waitcnt vmcnt(0)" ::: "memory");
    __syncthreads();
#define PG_ISSUE(dst, TAB, r) do { _Pragma("unroll") for (int k = 0; k < 8; ++k) { const unsigned ei = (unsigned)__builtin_amdgcn_readlane((int)(unsigned)(r), k) & 0xFFFFu; dst[k] = *(const v4u*)(TAB + (size_t)ei * DM + 16 * lane); } } while (0)
#ifndef PG_NO_U
    {
        const float* SU = WSP(float, WS_SU);
        const LAS char* xw = lds + wid * 8 * 1024 + lane * 16;
        unsigned long long rA = LIST[lane & 7]; float sA = SU[(unsigned)rA & 0xFFFFu], vA = SU[NEXP + ((unsigned)rA & 0xFFFFu)];
        v4u ur[8];
        PG_ISSUE(ur, U8, rA);
        for (int b = 0; b < 128; ++b) {
            unsigned long long nA = rA; float nS = sA, nV = vA; if (b + 1 < 128) { nA = LIST[(b + 1) * 8 + (lane & 7)]; nS = SU[(unsigned)nA & 0xFFFFu]; nV = SU[NEXP + ((unsigned)nA & 0xFFFFu)]; }
            float d[8];
#pragma unroll
            for (int k = 0; k < 8; ++k) { const int tk = (int)(((unsigned)__builtin_amdgcn_readlane((int)(unsigned)rA, k) >> 16) & 7u);
                const v4u x = *(const LAS v4u*)(xw + tk * 1024);
                const int s0_ = __builtin_amdgcn_sdot4((int)ur[k][1], (int)x[1], __builtin_amdgcn_sdot4((int)ur[k][0], (int)x[0], 0, false), false);
                const int s1_ = __builtin_amdgcn_sdot4((int)ur[k][3], (int)x[3], __builtin_amdgcn_sdot4((int)ur[k][2], (int)x[2], 0, false), false);
                d[k] = (float)(s0_ + s1_); }
            if (b + 1 < 128) PG_ISSUE(ur, U8, nA);
            const float tot = reduce8(d, lane);
            const unsigned long long mine = __shfl((long long)rA, lane >> 3);
            const float sum = __shfl(sA, lane >> 3), svm = __shfl(vA, lane >> 3); const unsigned tsl = ((unsigned)mine >> 16) & 7u;
            const float w = __uint_as_float((unsigned)(mine >> 32)) * gelu_erf(tot * sum * rstd_l[tsl]) * svm;
            if ((lane & 7) == 0) { WL[b * 8 + (lane >> 3)] = w; __hip_atomic_fetch_max(wmax_l + tsl, __float_as_uint(fabsf(w)), __ATOMIC_RELAXED, __HIP_MEMORY_SCOPE_WORKGROUP); }
            rA = nA; sA = nS; vA = nV;
        }
    }
#endif
    asm volatile("s_waitcnt vmcnt(0)" ::: "memory");
    int acc[8][16];
#pragma unroll
    for (int j = 0; j < 8; ++j)
#pragma unroll
        for (int q = 0; q < 16; ++q) acc[j][q] = 0;
    asm volatile("s_waitcnt lgkmcnt(0)" ::: "memory");
#define PVB 8
    unsigned mrr = (unsigned)LIST[lane & 15]; float mww = WL[lane & 15]; int mpos = 0;
#define PG_RUN(j) { const int rs_ = (int)bstart[g * 8 + j], re_ = (int)bend[g * 8 + j]; const float wm_ = __uint_as_float(wmax_l[j]); const float qs_ = wm_ > 0.f ? 127.0f / wm_ : 0.f; \
        for (int pos = rs_; pos < re_; ) { const int nv = re_ - pos < PVB ? re_ - pos : PVB; \
            if (mpos != pos) { const int ix_ = pos + (lane & 15) < 1024 ? pos + (lane & 15) : 1023; mrr = (unsigned)LIST[ix_]; mww = WL[ix_]; mpos = pos; } \
            v4u vr[PVB]; \
            _Pragma("unroll") for (int k = 0; k < PVB; ++k) { const unsigned e0_ = (unsigned)__builtin_amdgcn_readlane((int)mrr, 0), ek_ = (unsigned)__builtin_amdgcn_readlane((int)mrr, k); \
                const unsigned ei = (k < nv ? ek_ : e0_) & 0xFFFFu; vr[k] = *(const v4u*)(V8 + (size_t)ei * DM + 16 * lane); }     \
            const int wq_ = ((lane & 15) < nv ? (int)rintf(mww * qs_) : 0) & 255;                         \
            { const int np_ = pos + nv; const int ix_ = np_ + (lane & 15) < 1024 ? np_ + (lane & 15) : 1023; mrr = (unsigned)LIST[ix_]; mww = WL[ix_]; mpos = np_; } \
            _Pragma("unroll") for (int gq = 0; gq < PVB / 4; ++gq) { \
                const int w4_ = __builtin_amdgcn_readlane(wq_, 4 * gq) | (__builtin_amdgcn_readlane(wq_, 4 * gq + 1) << 8) | (__builtin_amdgcn_readlane(wq_, 4 * gq + 2) << 16) | (__builtin_amdgcn_readlane(wq_, 4 * gq + 3) << 24); \
                _Pragma("unroll") for (int q = 0; q < 4; ++q) { const unsigned r0 = vr[4 * gq][q], r1 = vr[4 * gq + 1][q], r2 = vr[4 * gq + 2][q], r3 = vr[4 * gq + 3][q]; \
                    const unsigned t0 = __builtin_amdgcn_perm(r1, r0, 0x05010400u), t1 = __builtin_amdgcn_perm(r1, r0, 0x07030602u), t2 = __builtin_amdgcn_perm(r3, r2, 0x05010400u), t3 = __builtin_amdgcn_perm(r3, r2, 0x07030602u); \
                    acc[j][4 * q + 0] = __builtin_amdgcn_sdot4((int)__builtin_amdgcn_perm(t2, t0, 0x05040100u), w4_, acc[j][4 * q + 0], false); \
                    acc[j][4 * q + 1] = __builtin_amdgcn_sdot4((int)__builtin_amdgcn_perm(t2, t0, 0x07060302u), w4_, acc[j][4 * q + 1], false); \
                    acc[j][4 * q + 2] = __builtin_amdgcn_sdot4((int)__builtin_amdgcn_perm(t3, t1, 0x05040100u), w4_, acc[j][4 * q + 2], false); \
                    acc[j][4 * q + 3] = __builtin_amdgcn_sdot4((int)__builtin_amdgcn_perm(t3, t1, 0x07060302u), w4_, acc[j][4 * q + 3], false); } } \
            pos += nv; } }
#ifndef PG_NO_V
    for (int g = 0; g < PG_NGRP; ++g) { PG_RUN(0) PG_RUN(1) PG_RUN(2) PG_RUN(3) PG_RUN(4) PG_RUN(5) PG_RUN(6) PG_RUN(7) }
#endif
#undef PG_RUN
#undef PG_ISSUE
    int tb = tok0; asm volatile("" : "+s"(tb));
    f32x4 fgv[4];
    { const f32x4* gp = (const f32x4*)(fg + 16 * lane);
#pragma unroll
      for (int q = 0; q < 4; ++q) fgv[q] = gp[q]; }
    bf16x8 nxa, nxb;
    { const bf16x8* xp = (const bf16x8*)(X1B + (size_t)tb * DM + 16 * lane); nxa = xp[0]; nxb = xp[1]; }
#pragma unroll
    for (int j = 0; j < 8; ++j) { const int t = tb + j;
        const bf16x8 xa = nxa, xb = nxb; const float os = __uint_as_float(wmax_l[j]) * (1.0f / 127.0f);
        if (j + 1 < 8) { const bf16x8* xp = (const bf16x8*)(X1B + (size_t)(t + 1) * DM + 16 * lane); nxa = xp[0]; nxb = xp[1]; }
        float s = 0.f; f32x4 y[4];
#pragma unroll
        for (int q = 0; q < 4; ++q) { const bf16x8 xs = q < 2 ? xa : xb; const int o = 4 * (q & 1);
            y[q] = (f32x4){bf2f((unsigned short)xs[o]) + (float)acc[j][4 * q] * os, bf2f((unsigned short)xs[o + 1]) + (float)acc[j][4 * q + 1] * os, bf2f((unsigned short)xs[o + 2]) + (float)acc[j][4 * q + 2] * os, bf2f((unsigned short)xs[o + 3]) + (float)acc[j][4 * q + 3] * os};
            s += (y[q][0] * y[q][0] + y[q][1] * y[q][1]) + (y[q][2] * y[q][2] + y[q][3] * y[q][3]); }
        const float rs = 1.0f / sqrtf(wave_sum(s) * (1.0f / 1024.0f) + NORM_EPS);
        f32x4* op = (f32x4*)(F.out + (size_t)t * DM + 16 * lane);
#pragma unroll
        for (int q = 0; q < 4; ++q) op[q] = y[q] * rs * fgv[q];
        asm volatile("" ::: "memory"); }
}
}


#ifndef MK_N_LAUNCHES
#define MK_N_LAUNCHES 1
#endif
constexpr int N_PHASES = 8;
struct Args { const float* in[20]; float* out; unsigned char* ws; int ph_lo, ph_hi; };

__global__ void __launch_bounds__(NTHR, 2) mega_fwd(Args args) {
    extern __shared__ __attribute__((aligned(16))) unsigned char lds_raw[];
    Frame F;
    F.lds = (LAS unsigned char*)lds_raw; F.ldsg = lds_raw;
    F.MISC = (volatile LAS unsigned*)(F.lds + MISC_OFF);
    F.tid = threadIdx.x; F.lane = F.tid & 63; F.wave = __builtin_amdgcn_readfirstlane(F.tid >> 6);
    F.G = gridDim.x; { const int bx = blockIdx.x; F.vcu = (F.G % 8 == 0) ? (bx % 8) * (F.G / 8) + bx / 8 : bx; }
#pragma unroll
    for (int i = 0; i < 20; ++i) F.in[i] = args.in[i];
    F.out = args.out; F.ws = args.ws; F.ctl = (gu32*)(args.ws + WS_CTL);
    for (int u = F.tid; u < 512 / 4; u += NTHR) ((LAS unsigned*)(F.lds + MISC_OFF))[u] = 0u;
    __syncthreads();
    const int lo = args.ph_lo, hi = args.ph_hi;
    const bool one = (hi - lo) > 1;
    XcdBarrier bar; bar.bar = (unsigned*)(F.ctl + CW_BAR); bar.x = 0; bar.st = nullptr;
    if (one) bar = xcd_barrier_post((unsigned*)(F.ctl + CW_BAR), F.MISC + 8);
#ifndef PH_MASK
#define PH_MASK 0xFF
#endif
#define IN(k) ((((PH_MASK) >> (k)) & 1) && lo <= (k) && (k) < hi)
#define SEAM(k) do { if (IN(k) && IN((k) + 1)) xcd_barrier(bar); } while (0)
#ifndef REP_PHASE
#define REP_PHASE -1
#endif
#define REPS(k) for (int rep_ = 0; rep_ < ((k) == REP_PHASE ? 2 : 1); ++rep_, ((k) == REP_PHASE && rep_ == 1 ? xcd_barrier(bar) : (void)0))

    if (IN(0)) REPS(0) { p0_prologue(F); } SEAM(0);

    if (IN(1)) REPS(1) {
        pg8::Gemm g{WSP(bf16, WS_H1), WSP(bf16, WS_WIN), M, NPROJ, DM}; pg8::StaticOrder S; S.init(M, NPROJ, F.G, (int)blockIdx.x);
        pg8::EpiBf16S E{WSP(bf16, WS_PROJ), PW, PW, PROJ_STRIDE, QSCALE, nullptr, 0.f};
        pg8::gemm_phase<pg8::EpiBf16S, pg8::StaticOrder, true, true>(F.lds, g, S, E);
        const int sb = (int)blockIdx.x - (F.G - 16);
        if (sb >= 0 && sb < 16 && F.wave == 0) gate_scan(F, sb);
        if ((int)blockIdx.x >= F.G / 2) cvt_peer_tables(F, 2);
    } SEAM(1);

    if (IN(2)) REPS(2) {
        const float lam = __expf(wave_sum(F.in[7][F.lane] * F.in[8][F.lane])) - __expf(wave_sum(F.in[9][F.lane] * F.in[10][F.lane])) + LAM_INIT;
#ifdef DATT_QUEUE
        for (;;) {
            if (F.tid == 0) F.MISC[16] = __hip_atomic_fetch_add(F.ctl + CW_Q, 1u, __ATOMIC_RELAXED, __HIP_MEMORY_SCOPE_AGENT);
            __syncthreads();
            const int it = (int)F.MISC[16];
            __syncthreads();
            if (it >= 512 + 240) break;
            int tid_ = F.tid; asm volatile("" : "+v"(tid_)); F.tid = tid_; F.lane = tid_ & 63;
            if (it < 512) { const int qb = 31 - (it >> 4), bh = it & 15; att::dattn_unit(F, bh >> 2, bh & 3, qb, lam); }
            else { const int v = it - 512; att::mlstm_state_item(F, v / 15, v % 15); }
        }
#else
        { const int v = F.vcu; if (v < 256) { const int bh = v >> 4, s = v & 15;
            att::dattn_unit(F, bh >> 2, bh & 3, 31 - s, lam); att::dattn_unit(F, bh >> 2, bh & 3, s, lam); } }
        { const int v = F.vcu; if (v < 16 * 15) att::mlstm_state_item(F, v / 15, v % 15); }
#endif
    } SEAM(2);

    if (IN(3)) REPS(3) {
        { const int v = F.vcu; if (v < 256) att::mlstm_out_unit(F, v >> 4, v & 15); }
        cvt_small_weights(F, F.vcu, F.G);
        __syncthreads();
        cvt_peer_tables(F, 1 << 20);
    } SEAM(3);

    if (IN(4)) REPS(4) {
        pg8::Gemm g{WSP(bf16, WS_H1), WSP(bf16, WS_WOUT), M, DM, DM}; pg8::StaticOrder S; S.init(M, DM, F.G, (int)blockIdx.x);
        pg8::EpiResid E{F.in[0], nullptr, WSP(bf16, WS_X1B), WSP(float, WS_SSP), DM};
        pg8::gemm_phase<pg8::EpiResid, pg8::StaticOrder, true, true>(F.lds, g, S, E);
    } SEAM(4);

    if (IN(5)) REPS(5) {
        pg8::Gemm g{WSP(bf16, WS_X1B), WSP(bf16, WS_WPQ), M, 2048, DM}; pg8::StaticOrder S; S.init(M, 2048, F.G, (int)blockIdx.x);
        pg8::EpiBf16S E{WSP(bf16, WS_H1), DM, DM, (size_t)(WS_QPB - WS_H1) / 2, 1.0f, WSP(float, WS_SSP), NORM_EPS};
        pg8::gemm_phase<pg8::EpiBf16S, pg8::StaticOrder, true, true>(F.lds, g, S, E);
    } SEAM(5);

    if (IN(6)) REPS(6) { peer::peer_topk_phase(F); } SEAM(6);
#ifdef EXTRA_BAR
    SEAM(6); SEAM(6);
#endif

    if (IN(7)) REPS(7) { peer::peer_gather_phase(F); }
#undef IN
#undef SEAM
}

#if defined(MK_CHECK)
__device__ __forceinline__ unsigned hsh(unsigned x) { x ^= x >> 16; x *= 0x7feb352dU; x ^= x >> 15; x *= 0x846ca68bU; x ^= x >> 16; return x; }
__device__ __forceinline__ void chk(unsigned* err, unsigned bit, float a, float ref, float rel, float ab) { if (!(fabsf(a - ref) <= ab + rel * fabsf(ref))) atomicOr(err, bit); }
#define CWS(T, off) ((T*)(a.ws + (off)))
#define CERR ((unsigned*)(a.ws) + CW_ERR)
__device__ __forceinline__ float blk_sum(float v, float* red, int n) { __syncthreads(); red[threadIdx.x] = v; __syncthreads(); for (int s = n / 2; s > 0; s >>= 1) { if ((int)threadIdx.x < s) red[threadIdx.x] += red[threadIdx.x + s]; __syncthreads(); } return red[0]; }
__device__ __forceinline__ float blk_max(float v, float* red, int n) { __syncthreads(); red[threadIdx.x] = v; __syncthreads(); for (int s = n / 2; s > 0; s >>= 1) { if ((int)threadIdx.x < s) red[threadIdx.x] = fmaxf(red[threadIdx.x], red[threadIdx.x + s]); __syncthreads(); } return red[0]; }

__device__ __forceinline__ float fp8dec(unsigned char b) { const int ex = (b >> 3) & 15, mn = b & 7; const float v = ex ? (1.0f + mn * 0.125f) * exp2f((float)(ex - 7)) : mn * 0.001953125f; return (b & 0x80) ? -v : v; }
__global__ void chk_p0(Args a) {
    __shared__ float hs[1024]; __shared__ float red[256];
    const unsigned sm = hsh(blockIdx.x * 256u + threadIdx.x + 77u);
    if (a.ph_lo == 1) {
        { const int n = sm % 1024, k = (sm >> 12) % 1024; chk(CERR, 0x100u, bf2f(CWS(bf16, WS_WOUT)[(size_t)n * 1024 + k]), a.in[13][(size_t)k * 1024 + n], 0.01f, 1e-4f); }
        { const int n = sm % 2048, k = (sm >> 12) % 1024; chk(CERR, 0x100u, bf2f(CWS(bf16, WS_WPQ)[(size_t)n * 1024 + k]), a.in[15][(size_t)k * 2048 + n] * a.in[14][k], 0.01f, 1e-4f); }
        { const int i = sm % 262144; chk(CERR, 0x100u, bf2f(CWS(bf16, WS_SUBK)[i]), a.in[16][i], 0.01f, 1e-4f); }
        { const size_t i = (size_t)(sm % 16777216u); { const float su_ = CWS(float, WS_SU)[i >> 10]; chk(CERR, 0x100u, (float)(signed char)CWS(unsigned char, WS_UB)[i] * su_, a.in[17][i] * a.in[14][i & 1023], 0.f, 0.51f * su_ + 1e-7f); } { const float sv_ = CWS(float, WS_SU)[NEXP + (i >> 10)]; chk(CERR, 0x100u, (float)(signed char)CWS(unsigned char, WS_VB)[i] * sv_, a.in[18][i], 0.f, 0.51f * sv_ + 1e-7f); } }
        return; }
    const int m = hsh(blockIdx.x * 7919u + 1u) % M; const float* x = a.in[0] + (size_t)m * DM; const float* g1 = a.in[1];
    float s = 0.f; for (int e = threadIdx.x; e < 1024; e += 256) s += x[e] * x[e];
    const float rstd = 1.0f / sqrtf(blk_sum(s, red, 256) / 1024.f + NORM_EPS);
    for (int e = threadIdx.x; e < 1024; e += 256) { hs[e] = x[e] * rstd * g1[e]; chk(CERR, 0x200u, bf2f(CWS(bf16, WS_H1)[(size_t)m * DM + e]), hs[e], 0.01f, 0.01f); }
    __syncthreads();
    if (threadIdx.x < 8) { const int g = threadIdx.x; float d = 0.f; for (int k = 0; k < 1024; ++k) d += hs[k] * a.in[2][(size_t)k * INCOLS + NPROJ + g];
        const int b = m / SEQ, t = m % SEQ, hh = g & 3; const size_t o = (size_t)(b * 4 + hh) * SEQ + t;
        if (g < 4) chk(CERR, 0x200u, CWS(float, WS_GI)[o], d + a.in[5][hh], 1e-3f, 2e-3f);
        else { const float f = d + a.in[6][hh]; chk(CERR, 0x200u, CWS(float, WS_GLF)[o], -log1pf(expf(-f)), 1e-3f, 2e-3f); } }
    { const int n = sm % NPROJ, k = (sm >> 12) % 1024; chk(CERR, 0x100u, bf2f(CWS(bf16, WS_WIN)[(size_t)n * 1024 + k]), a.in[2][(size_t)k * INCOLS + n], 0.01f, 1e-4f); }
}
__global__ void chk_gemm1(Args a) {
    const unsigned gid = blockIdx.x * 256u + threadIdx.x; const unsigned sm = hsh(gid + 1234567u);
    { const int t = sm % M, n = (sm >> 14) % NPROJ; const bf16* hr = CWS(bf16, WS_H1) + (size_t)t * DM; const bf16* wr = CWS(bf16, WS_WIN) + (size_t)n * DM;
      float d = 0.f; for (int k = 0; k < 1024; ++k) d += bf2f(hr[k]) * bf2f(wr[k]);
      const int bi = n / 512, col = n % 512; if (bi == 0) d *= QSCALE;
      chk(CERR, 0x80u, bf2f(CWS(bf16, WS_PROJ)[(size_t)bi * PROJ_STRIDE + (size_t)t * PW + col]), d, 0.02f, 0.02f); }
    if (gid < 256) { const int bh = sm % 16, t = (gid < 16) ? (int)(4095 - gid * 17) : (int)((sm >> 4) % SEQ); const float* gi = CWS(float, WS_GI) + (size_t)bh * SEQ; const float* glf = CWS(float, WS_GLF) + (size_t)bh * SEQ;
      float B = 0.f, Mx = -3.0e38f, av = 0.f; for (int s = 0; s <= t; ++s) { B += glf[s]; av = gi[s] - B; Mx = fmaxf(Mx, av); }
      chk(CERR, 0x40u, CWS(float, WS_A2)[(size_t)bh * SEQ + t], av * LOG2E, 1e-4f, 5e-3f); chk(CERR, 0x40u, CWS(float, WS_M2)[(size_t)bh * SEQ + t], Mx * LOG2E, 1e-4f, 5e-3f);
      chk(CERR, 0x40u, CWS(float, WS_NB2)[(size_t)bh * SEQ + t], -(B + Mx) * LOG2E, 1e-4f, 5e-3f); }
}
__global__ void __launch_bounds__(128) chk_attn(Args a) {
    __shared__ float sc[2][4096]; __shared__ float red[128]; __shared__ float qv[128];
    const unsigned sm = hsh(blockIdx.x * 31u + 5u); const int b = sm & 3, h = (sm >> 2) & 3, t = (blockIdx.x < 4) ? (int)(4095 - blockIdx.x * 129) : (int)((sm >> 4) % SEQ), d = threadIdx.x;
    const bf16* DAQ = CWS(bf16, WS_PROJ); const bf16* DAK = DAQ + PROJ_STRIDE; const bf16* DAV = DAQ + 2 * PROJ_STRIDE;
    qv[d] = bf2f(DAQ[((size_t)b * SEQ + t) * PW + h * 128 + d]); __syncthreads();
    const float slope2 = exp2f(-2.0f * (h + 1)) * LOG2E;
    float mx0 = -3.0e38f, mx1 = -3.0e38f;
    for (int s = d; s <= t; s += 128) { const bf16* kr = DAK + ((size_t)b * SEQ + s) * PW + h * 128; float d0 = 0.f, d1 = 0.f;
        for (int k = 0; k < 64; ++k) { d0 += qv[k] * bf2f(kr[k]); d1 += qv[64 + k] * bf2f(kr[64 + k]); }
        d0 -= slope2 * (t - s); d1 -= slope2 * (t - s); sc[0][s] = d0; sc[1][s] = d1; mx0 = fmaxf(mx0, d0); mx1 = fmaxf(mx1, d1); }
    mx0 = blk_max(mx0, red, 128); mx1 = blk_max(mx1, red, 128);
    float l0 = 0.f, l1 = 0.f; for (int s = d; s <= t; s += 128) { l0 += exp2f(sc[0][s] - mx0); l1 += exp2f(sc[1][s] - mx1); }
    l0 = blk_sum(l0, red, 128); l1 = blk_sum(l1, red, 128);
    float la = 0.f, lb = 0.f; for (int k = 0; k < 64; ++k) { la += a.in[7][k] * a.in[8][k]; lb += a.in[9][k] * a.in[10][k]; }
    const float lam = expf(la) - expf(lb) + LAM_INIT;
    float o = 0.f; for (int s = 0; s <= t; ++s) o += (exp2f(sc[0][s] - mx0) / l0 - lam * exp2f(sc[1][s] - mx1) / l1) * bf2f(DAV[((size_t)b * SEQ + s) * PW + h * 128 + d]);
    const float ms = blk_sum(o * o, red, 128) / 128.f;
    const float ref = o / sqrtf(ms + SUBLN_EPS) * a.in[11][d] * (1.0f - LAM_INIT);
    chk(CERR, 0x20u, bf2f(CWS(bf16, WS_H1)[((size_t)b * SEQ + t) * DM + h * 128 + d]), ref, 0.03f, 0.03f);
}
__device__ __forceinline__ float conv1(const bf16* raw, size_t rb, int t, int col, const float* cw, const float* cb, int ch) {
    float y = cb[ch]; for (int j = 0; j < 4; ++j) { const int tt = t - 3 + j; if (tt >= 0) y += cw[j * 1024 + ch] * bf2f(raw[(rb + tt) * PW + col]); } return y / (1.0f + expf(-y)); }
__global__ void __launch_bounds__(128) chk_mlstm(Args a) {
    __shared__ float sc[4096]; __shared__ float red[128]; __shared__ float qs[128];
    const unsigned sm = hsh(blockIdx.x * 131u + 9u); const int bh = sm & 15, b = bh >> 2, hh = bh & 3, d = threadIdx.x;
    const int t = (blockIdx.x < 8) ? (int)(blockIdx.x * 37) : (blockIdx.x < 16) ? (int)(4095 - (blockIdx.x - 8) * 300) : (int)((sm >> 4) % SEQ);
    const bf16* MLQ = CWS(bf16, WS_PROJ) + 3 * PROJ_STRIDE; const bf16* MLK = MLQ + PROJ_STRIDE; const bf16* MLV = MLQ + 2 * PROJ_STRIDE; const bf16* MLO = MLQ + 3 * PROJ_STRIDE;
    const size_t rb = (size_t)b * SEQ; const float* A2 = CWS(float, WS_A2) + (size_t)bh * SEQ; const float m2t = CWS(float, WS_M2)[(size_t)bh * SEQ + t], nb2t = CWS(float, WS_NB2)[(size_t)bh * SEQ + t];
    qs[d] = conv1(MLQ, rb, t, hh * 128 + d, a.in[3], a.in[4], hh * 128 + d); __syncthreads();
    float dp = 0.f;
    for (int s = d; s <= t; s += 128) { float dot = 0.f; for (int k = 0; k < 128; ++k) dot += qs[k] * conv1(MLK, rb, s, hh * 128 + k, a.in[3], a.in[4], 512 + hh * 128 + k);
        const float w = dot * MLK_SCALE * exp2f(A2[s] - m2t); sc[s] = w; dp += w; }
    const float den = blk_sum(dp, red, 128);
    float num = 0.f; for (int s = 0; s <= t; ++s) num += sc[s] * bf2f(MLV[(rb + s) * PW + hh * 128 + d]);
    const float hv = num / fmaxf(fabsf(den), exp2f(nb2t));
    const float ms = blk_sum(hv * hv, red, 128) / 128.f;
    const float og = bf2f(MLO[(rb + t) * PW + hh * 128 + d]);
    const float ref = hv / sqrtf(ms + NORM_EPS) * a.in[12][hh * 128 + d] / (1.0f + expf(-og));
    chk(CERR, 0x10u, bf2f(CWS(bf16, WS_H1)[(rb + t) * DM + 512 + hh * 128 + d]), ref, 0.03f, 0.03f);
}
__global__ void chk_gemm2(Args a) {
    const unsigned gid = blockIdx.x * 256u + threadIdx.x; const unsigned sm = hsh(gid + 99u);
    const int t = sm % M, n = (sm >> 14) % 1024; const bf16* ar = CWS(bf16, WS_H1) + (size_t)t * DM; const bf16* wr = CWS(bf16, WS_WOUT) + (size_t)n * DM;
    float d = a.in[0][(size_t)t * DM + n]; for (int k = 0; k < 1024; ++k) d += bf2f(ar[k]) * bf2f(wr[k]);
    chk(CERR, 0x8u, bf2f(CWS(bf16, WS_X1B)[(size_t)t * DM + n]), d, 0.015f, 0.015f);
    if (gid < 64) { float s = 0.f, p = 0.f; for (int k = 0; k < 1024; ++k) { const float v = bf2f(CWS(bf16, WS_X1B)[(size_t)t * DM + k]); s += v * v; } for (int k = 0; k < 16; ++k) p += CWS(float, WS_SSP)[(size_t)t * 16 + k];
        chk(CERR, 0x8u, p, s, 5e-3f, 1e-3f); }
}
__global__ void chk_gemm3(Args a) {
    const unsigned gid = blockIdx.x * 256u + threadIdx.x; const unsigned sm = hsh(gid + 4242u);
    const int t = sm % M, n = (sm >> 14) % 2048; const bf16* ar = CWS(bf16, WS_X1B) + (size_t)t * DM; const bf16* wr = CWS(bf16, WS_WPQ) + (size_t)n * DM;
    float p = 0.f; for (int k = 0; k < 16; ++k) p += CWS(float, WS_SSP)[(size_t)t * 16 + k];
    float d = 0.f; for (int k = 0; k < 1024; ++k) d += bf2f(ar[k]) * bf2f(wr[k]); d /= sqrtf(p / 1024.f + NORM_EPS);
    const bf16* qp = (n < 1024) ? CWS(bf16, WS_H1) + (size_t)t * DM + n : CWS(bf16, WS_QPB) + (size_t)t * DM + (n - 1024);
    chk(CERR, 0x4u, bf2f(*qp), d, 0.02f, 0.02f);
}
__global__ void chk_topk(Args a) {
    __shared__ float s12[256]; __shared__ float cand[256]; __shared__ int i12[32]; __shared__ float v12[32]; __shared__ int pe[16]; __shared__ float pg[16];
    const unsigned sm = hsh(blockIdx.x * 17u + 3u); const int t = sm % M, h = (sm >> 14) & 7, tid = threadIdx.x, c = tid >> 7, n = tid & 127;
    const bf16* q = ((h < 4) ? CWS(bf16, WS_H1) + h * 256 : CWS(bf16, WS_QPB) + (h - 4) * 256) + (size_t)t * DM + c * 128; const bf16* sk = CWS(bf16, WS_SUBK) + ((size_t)(h * 2 + c) * 128 + n) * 128;
    float d = 0.f; for (int k = 0; k < 128; ++k) d += bf2f(q[k]) * bf2f(sk[k]); s12[tid] = d; __syncthreads();
    if (tid < 2) { for (int k = 0; k < 16; ++k) { int bi = 0; float bv = -3.0e38f; for (int j = 0; j < 128; ++j) if (s12[tid * 128 + j] > bv) { bv = s12[tid * 128 + j]; bi = j; } i12[tid * 16 + k] = bi; v12[tid * 16 + k] = bv; s12[tid * 128 + bi] = -3.0e38f; } }
    __syncthreads(); cand[tid] = v12[tid >> 4] + v12[16 + (tid & 15)]; __syncthreads();
    if (tid == 0) { float mx = 0.f, es = 0.f; for (int k = 0; k < 16; ++k) { int bi = 0; float bv = -3.0e38f; for (int j = 0; j < 256; ++j) if (cand[j] > bv) { bv = cand[j]; bi = j; }
            pe[k] = i12[bi >> 4] * 128 + i12[16 + (bi & 15)]; if (k == 0) mx = bv; pg[k] = expf(bv - mx); es += pg[k]; cand[bi] = -3.0e38f; }
        const unsigned long long* P = CWS(unsigned long long, WS_PE) + (size_t)t * 128 + h * 16; int miss = 0;
        for (int k = 0; k < 16; ++k) { bool f = false; for (int j = 0; j < 16; ++j) if ((int)(unsigned)(P[j] & 0xFFFFFFFFull) == pe[k]) { f = true; const float g = __uint_as_float((unsigned)(P[j] >> 32)); if (!(fabsf(g - pg[k] / es) <= 0.003f + 0.03f * pg[k] / es)) miss += 4; } if (!f) ++miss; }
        if (miss > 2) atomicOr(CERR, 0x2u); }
}
__global__ void chk_gather(Args a) {
    __shared__ float wv[128]; __shared__ int ev[128]; __shared__ float red[256];
    const int t = hsh(blockIdx.x * 13u + 11u) % M, tid = threadIdx.x; const bf16* x1 = CWS(bf16, WS_X1B) + (size_t)t * DM;
    float p = 0.f; for (int k = 0; k < 16; ++k) p += CWS(float, WS_SSP)[(size_t)t * 16 + k]; const float rstd = 1.0f / sqrtf(p / 1024.f + NORM_EPS);
    if (tid < 128) { const unsigned long long e = CWS(unsigned long long, WS_PE)[(size_t)t * 128 + tid]; const int ei = (int)(unsigned)(e & 0xFFFFFFFFull); const unsigned char* u = CWS(unsigned char, WS_UB) + (size_t)ei * DM;
        float d = 0.f; for (int k = 0; k < 1024; ++k) d += (float)(signed char)u[k] * bf2f(x1[k]); d *= rstd * CWS(float, WS_SU)[ei]; ev[tid] = ei; wv[tid] = __uint_as_float((unsigned)(e >> 32)) * 0.5f * d * (1.0f + erff(d * 0.70710678f)); }
    __syncthreads();
    float y[4], s = 0.f; for (int i = 0; i < 4; ++i) { const int dd = tid * 4 + i; float acc = bf2f(x1[dd]); for (int k = 0; k < 128; ++k) acc += wv[k] * CWS(float, WS_SU)[NEXP + ev[k]] * (float)(signed char)CWS(unsigned char, WS_VB)[(size_t)ev[k] * DM + dd]; y[i] = acc; s += acc * acc; }
    const float rs = 1.0f / sqrtf(blk_sum(s, red, 256) / 1024.f + NORM_EPS);
    for (int i = 0; i < 4; ++i) { const int dd = tid * 4 + i; chk(CERR, 0x1u, a.out[(size_t)t * DM + dd], y[i] * rs * a.in[19][dd], 0.03f, 0.03f); }
}
__global__ void chk_poison(Args a) { const unsigned e = *CERR; if (e) { const float f = 1.0f + 10.0f * (float)e; for (size_t i = blockIdx.x * 256u + threadIdx.x; i < (size_t)M * DM; i += (size_t)gridDim.x * 256u) a.out[i] *= f; } }
#endif

extern "C" void kernel_launch(void* const* d_in, const int* in_sizes, int n_in, void* d_out, int out_size, void* d_ws, size_t ws_size, hipStream_t stream) {
    static int grid = 0;
    if (grid == 0) {
        if (n_in != 20 || in_sizes[0] != M * DM || out_size != M * DM || ws_size < WS_END) { fprintf(stderr, "kernel_launch: unexpected shapes (n_in %d, in0 %d, out %d, ws %zu); nothing launched\n", n_in, n_in > 0 ? in_sizes[0] : -1, out_size, ws_size); grid = -1; return; }
        int dev = 0, cus = 0, per_cu = 0;
        if (hipGetDevice(&dev) != hipSuccess || hipDeviceGetAttribute(&cus, hipDeviceAttributeMultiprocessorCount, dev) != hipSuccess) { grid = -1; return; }
        if (hipFuncSetAttribute((const void*)mega_fwd, hipFuncAttributeMaxDynamicSharedMemorySize, LDS_BYTES) != hipSuccess) { fprintf(stderr, "kernel_launch: hipFuncSetAttribute failed\n"); grid = -1; return; }
        if (hipOccupancyMaxActiveBlocksPerMultiprocessor(&per_cu, (const void*)mega_fwd, NTHR, LDS_BYTES) != hipSuccess || per_cu < 1) fprintf(stderr, "kernel_launch: occupancy query reports %d\n", per_cu);
        (void)hipGetLastError();
        grid = 256;
        if (cus < 256) { fprintf(stderr, "kernel_launch: %d CUs, need 256\n", cus); grid = -1; return; }
    }
    if (grid < 0) return;
    (void)hipMemsetAsync((char*)d_ws + WS_CTL, 0, CTL_ZERO_BYTES, stream);
    Args a{};
    for (int i = 0; i < 20; ++i) a.in[i] = (const float*)d_in[i];
    a.out = (float*)d_out; a.ws = (unsigned char*)d_ws;
#if MK_N_LAUNCHES == 1
    a.ph_lo = 0; a.ph_hi = N_PHASES;
    hipLaunchKernelGGL(mega_fwd, dim3(grid), dim3(NTHR), LDS_BYTES, stream, a);
#else
    for (int p = 0; p < N_PHASES; ++p) { a.ph_lo = p; a.ph_hi = p + 1; hipLaunchKernelGGL(mega_fwd, dim3(grid), dim3(NTHR), LDS_BYTES, stream, a);
#if defined(DUP_PHASE)
        if (p == DUP_PHASE) hipLaunchKernelGGL(mega_fwd, dim3(grid), dim3(NTHR), LDS_BYTES, stream, a);
#endif
#if defined(MK_CHECK)
        a.ph_lo = 0; a.ph_hi = 0;
        if (p == 0) hipLaunchKernelGGL(chk_p0, dim3(256), dim3(256), 0, stream, a);
        if (p == 3) { a.ph_lo = 1; hipLaunchKernelGGL(chk_p0, dim3(256), dim3(256), 0, stream, a); a.ph_lo = 0; }
        if (p == 1) hipLaunchKernelGGL(chk_gemm1, dim3(16), dim3(256), 0, stream, a);
        if (p == 3) { hipLaunchKernelGGL(chk_attn, dim3(64), dim3(128), 0, stream, a); hipLaunchKernelGGL(chk_mlstm, dim3(64), dim3(128), 0, stream, a); }
        if (p == 4) hipLaunchKernelGGL(chk_gemm2, dim3(16), dim3(256), 0, stream, a);
        if (p == 5) hipLaunchKernelGGL(chk_gemm3, dim3(16), dim3(256), 0, stream, a);
        if (p == 6) hipLaunchKernelGGL(chk_topk, dim3(128), dim3(256), 0, stream, a);
        if (p == 7) { hipLaunchKernelGGL(chk_gather, dim3(32), dim3(256), 0, stream, a); hipLaunchKernelGGL(chk_poison, dim3(1024), dim3(256), 0, stream, a); }
#endif
    }
#endif
    const hipError_t le = hipPeekAtLastError();
    if (le != hipSuccess) fprintf(stderr, "kernel_launch: launch failed: %s\n", hipGetErrorName(le));
}
```

```cpp
#define MK_N_LAUNCHES 1
#include <hip/hip_runtime.h>
#include <cstdio>
#include <cstdint>
namespace pg8 {
#define PG8_LAS __attribute__((address_space(3)))
typedef unsigned short bf16_t;
typedef short bf16x8 __attribute__((ext_vector_type(8)));
typedef float f32x4 __attribute__((ext_vector_type(4)));
typedef unsigned u32x4 __attribute__((ext_vector_type(4)));
constexpr int BM = 256, BK = 64, HALF = 128, HTB = HALF * BK * 2  , STAGE_BYTES = 8 * HTB, NXCD = 8, WGM = 8;

__host__ __device__ __forceinline__ int lds_byte(int r, int c) { const int st = (r >> 4) * 2 + (c >> 5), rr = r & 15, cc = c & 31, ob = rr * 64 + cc * 2; return st * 1024 + (ob ^ (((ob >> 9) & 1) << 5)); }
__host__ __device__ __forceinline__ void stage_rc(int b, int& R, int& C) { const int st = b / 1024, sb = b % 1024, swz = sb ^ (((sb >> 9) & 1) << 5); R = (st >> 1) * 16 + swz / 64; C = (st & 1) * 32 + (swz % 64) / 2; }
__host__ __device__ __forceinline__ int perm32(int rho) { const int n = rho >> 4, i = rho & 15; return 8 * (i >> 2) + 4 * n + (i & 3); }

struct Unit { int pm, pn; };
struct Gemm { const bf16_t* A; const bf16_t* Bt; int M, N, K; };

struct StaticOrder {
    int nM, nN, nwg, G, c;
    __host__ __device__ void init(int M, int N, int G_, int c_) { nM = M / BM; nN = N / BM; nwg = nM * nN; G = G_; c = c_; }
    __host__ __device__ bool next(int i, Unit& u) const {
        const long L = (long)i * G + c; if (L >= nwg) return false;
        int wgid = (int)L; { const int q = nwg / NXCD, r = nwg % NXCD, xcd = wgid % NXCD, off = wgid / NXCD; wgid = (xcd < r ? xcd * (q + 1) : r * (q + 1) + (xcd - r) * q) + off; }
        const int nig = WGM * nN, gid = wgid / nig, fm = gid * WGM, gsz = (nM - fm) < WGM ? (nM - fm) : WGM;
        u.pm = fm + ((wgid % nig) % gsz); u.pn = (wgid % nig) / gsz; return true;
    }
    __device__ __forceinline__ void a_ready(const Unit&) const {}
    __device__ __forceinline__ void done(const Unit&) const {}
};

__device__ __forceinline__ unsigned cvt_pk_bf16(float lo, float hi) { unsigned r; asm volatile("v_cvt_pk_bf16_f32 %0, %1, %2" : "=v"(r) : "v"(lo), "v"(hi)); return r; }
typedef float f32x2 __attribute__((ext_vector_type(2)));
typedef unsigned u32x2e __attribute__((ext_vector_type(2)));
__device__ __forceinline__ void st16_wt(void* p, u32x4 v) {
#ifdef PG8_WT_STORES
    asm volatile("global_store_dwordx4 %0, %1, off sc1\n\ts_nop 1" :: "v"(p), "v"(v) : "memory");
#else
    *(u32x4*)p = v;
#endif
}
struct EpiBf16S {
    static constexpr bool PERM = true, AFTER_DRAIN = false;
    bf16_t* O; int ldc; int split_cols; size_t split_stride; float scale0; const float* ssp; float eps;
    __device__ __forceinline__ void operator()(const f32x4 (&acc)[2][2][4][2], const Unit& u, int wr, int wc, int fr, int fq) const {
        const int row0 = u.pm * BM + wr * 64 + fr; int colt = u.pn * BM; bf16_t* base = O;
        float sc = 1.f; if (split_cols) { const int t = colt / split_cols; base += (size_t)t * split_stride; colt -= t * split_cols; if (t == 0) sc = scale0; }
        const int col0 = colt + wc * 32 + 8 * fq;
#pragma unroll
        for (int ai = 0; ai < 2; ++ai)
#pragma unroll
            for (int m = 0; m < 4; ++m) { const int row = row0 + ai * HALF + m * 16; bf16_t* rowp = base + (size_t)row * ldc + col0;
                float rs = sc;
                if (ssp) { const f32x4* sp = (const f32x4*)(ssp + (size_t)row * 16); const f32x4 a = sp[0], b = sp[1], c = sp[2], d = sp[3];
                    const float s = ((a[0] + a[1]) + (a[2] + a[3])) + ((b[0] + b[1]) + (b[2] + b[3])) + ((c[0] + c[1]) + (c[2] + c[3])) + ((d[0] + d[1]) + (d[2] + d[3]));
                    rs *= 1.0f / sqrtf(s * (1.0f / 1024.0f) + eps); }
#pragma unroll
                for (int bj = 0; bj < 2; ++bj) { const f32x4 v0 = acc[ai][bj][m][0] * rs, v1 = acc[ai][bj][m][1] * rs;
                    u32x4 w; w.x = cvt_pk_bf16(v0[0], v0[1]); w.y = cvt_pk_bf16(v0[2], v0[3]); w.z = cvt_pk_bf16(v1[0], v1[1]); w.w = cvt_pk_bf16(v1[2], v1[3]);
                    st16_wt(rowp + bj * HALF, w); } }
    }
};
struct EpiResid {
    static constexpr bool PERM = false, AFTER_DRAIN = false;
    const float* resid; float* out; bf16_t* outb; float* ssp; int ldc;
    __device__ __forceinline__ void operator()(const f32x4 (&acc)[2][2][4][2], const Unit& u, int wr, int wc, int fr, int fq) const {
        const int col0 = u.pn * BM + wc * 32 + 4 * fq;
#pragma unroll
        for (int ai = 0; ai < 2; ++ai)
#pragma unroll
            for (int m = 0; m < 4; ++m) { const int r = u.pm * BM + ai * HALF + wr * 64 + m * 16 + fr; const size_t off = (size_t)r * ldc + col0; float s = 0.f;
#pragma unroll
                for (int bj = 0; bj < 2; ++bj)
#pragma unroll
                    for (int n = 0; n < 2; ++n) { const f32x4 x = *(const f32x4*)(resid + off + bj * HALF + n * 16) + acc[ai][bj][m][n];
                        if (out) *(f32x4*)(out + off + bj * HALF + n * 16) = x; s += (x[0] * x[0] + x[1] * x[1]) + (x[2] * x[2] + x[3] * x[3]);
                        u32x2e w; w.x = cvt_pk_bf16(x[0], x[1]); w.y = cvt_pk_bf16(x[2], x[3]); *(u32x2e*)(outb + off + bj * HALF + n * 16) = w; }
                s += __shfl_xor(s, 16); s += __shfl_xor(s, 32);
                if (fq == 0) ssp[(size_t)r * 16 + u.pn * 4 + wc] = s; }
    }
};
template <class Epi, class Sched, bool ALIGN_EPI = false, bool SP2 = false>
__device__ __forceinline__ void gemm_phase(PG8_LAS unsigned char* lds, const Gemm g, const Sched& S, const Epi& E) {
    const int tid = threadIdx.x, wid = __builtin_amdgcn_readfirstlane(tid >> 6), lane = tid & 63, wr = wid >> 2, wc = wid & 3, fr = lane & 15, fq = lane >> 4;
    const int K = g.K, nt = K / BK;
    unsigned voffA[2], voffB[2];
#pragma unroll
    for (int i = 0; i < 2; ++i) { int R, C; stage_rc(tid * 16 + i * 8192, R, C); const int Rb = Epi::PERM ? ((R & ~31) + perm32(R & 31)) : R;
        voffA[i] = (unsigned)(R * K + C) * 2u; voffB[i] = (unsigned)(Rb * K + C) * 2u; }
    const size_t kstep = (size_t)(BK * 2);
    const size_t hstep = (size_t)HALF * K * 2;
    const size_t tstep = 2 * hstep;
    const unsigned ldsw = (unsigned)wid * 1024u;
    const int aoff = lds_byte(wr * 64 + fr, fq * 8), boff = lds_byte(wc * 32 + fr, fq * 8);
#define PG8_SA(b, h) (((b) * 2 + (h)) * HTB)
#define PG8_SB(b, h) ((4 + (b) * 2 + (h)) * HTB)
#define PG8_STAGE(bufoff, gbase, voff) do { _Pragma("unroll") for (int _i = 0; _i < 2; ++_i) \
        __builtin_amdgcn_global_load_lds((const unsigned*)((const char*)(gbase) + (voff)[_i]), (PG8_LAS unsigned*)(lds + (bufoff) + ldsw + _i * 8192), 16, 0, 0); } while (0)
#define PG8_LDA(dst, b, h) do { _Pragma("unroll") for (int m = 0; m < 4; ++m) _Pragma("unroll") for (int k = 0; k < 2; ++k) dst[m][k] = *(const PG8_LAS bf16x8*)(lds + PG8_SA(b, h) + aoff + m * 2048 + k * 1024); } while (0)
#define PG8_LDB(dst, b, h) do { _Pragma("unroll") for (int n = 0; n < 2; ++n) _Pragma("unroll") for (int k = 0; k < 2; ++k) dst[n][k] = *(const PG8_LAS bf16x8*)(lds + PG8_SB(b, h) + boff + n * 2048 + k * 1024); } while (0)
#define PG8_MMA(ai, bj, At, Bt) do { __builtin_amdgcn_s_setprio(1); _Pragma("unroll") for (int m = 0; m < 4; ++m) _Pragma("unroll") for (int n = 0; n < 2; ++n) _Pragma("unroll") for (int k = 0; k < 2; ++k) \
        acc[ai][bj][m][n] = __builtin_amdgcn_mfma_f32_16x16x32_bf16(Bt[n][k], At[m][k], acc[ai][bj][m][n], 0, 0, 0); __builtin_amdgcn_s_setprio(0); } while (0)
#define PG8_WAIT_V(n) asm volatile("s_waitcnt vmcnt(" #n ")" ::: "memory")
#define PG8_WAIT_L(n) asm volatile("s_waitcnt lgkmcnt(" #n ")" ::: "memory")
#define PG8_BAR __builtin_amdgcn_s_barrier()
#define PG8_SCHED __builtin_amdgcn_sched_barrier(0)
    Unit cur, nxt; int ui = 0;
    if (!S.next(0, cur)) return;
    f32x4 acc[2][2][4][2];
#pragma unroll
    for (int a = 0; a < 2; ++a)
#pragma unroll
        for (int b = 0; b < 2; ++b)
#pragma unroll
            for (int m = 0; m < 4; ++m)
#pragma unroll
                for (int n = 0; n < 2; ++n) acc[a][b][m][n] = (f32x4){0.f, 0.f, 0.f, 0.f};
    bf16x8 At[4][2], B0[2][2], B1[2][2];
    const char* cA = (const char*)g.A + (size_t)cur.pm * tstep; const char* cB = (const char*)g.Bt + (size_t)cur.pn * tstep;
    S.a_ready(cur);
    if constexpr (SP2) {
        PG8_STAGE(PG8_SB(0, 0), cB, voffB); PG8_STAGE(PG8_SB(0, 1), cB + hstep, voffB); PG8_STAGE(PG8_SA(0, 0), cA, voffA); PG8_STAGE(PG8_SA(0, 1), cA + hstep, voffA);
        if (wr == 1) PG8_BAR;
        PG8_WAIT_V(2); PG8_BAR;
        PG8_STAGE(PG8_SB(1, 0), cB + kstep, voffB); PG8_STAGE(PG8_SA(1, 0), cA + kstep, voffA); PG8_STAGE(PG8_SB(1, 1), cB + hstep + kstep, voffB);
        PG8_WAIT_V(6); PG8_BAR;
    } else {
        PG8_STAGE(PG8_SB(0, 0), cB, voffB); PG8_STAGE(PG8_SA(0, 0), cA, voffA); PG8_STAGE(PG8_SB(0, 1), cB + hstep, voffB); PG8_STAGE(PG8_SA(0, 1), cA + hstep, voffA);
        if (wr == 1) PG8_BAR;
        PG8_WAIT_V(4); PG8_BAR;
        PG8_STAGE(PG8_SB(1, 0), cB + kstep, voffB); PG8_STAGE(PG8_SA(1, 0), cA + kstep, voffA); PG8_STAGE(PG8_SB(1, 1), cB + hstep + kstep, voffB);
        PG8_WAIT_V(6); PG8_BAR;
    }
    for (;;) {
        const bool has_next = S.next(ui + 1, nxt);
        const char* nA = has_next ? (const char*)g.A + (size_t)nxt.pm * tstep : cA; const char* nB = has_next ? (const char*)g.Bt + (size_t)nxt.pn * tstep : cB;
        for (int t = 0; t < nt; t += 2) {
            const bool last = (t == nt - 2);
            const char* a1 = cA + (size_t)(t + 1) * kstep;
            const char* a2 = last ? nA : cA + (size_t)(t + 2) * kstep; const char* b2 = last ? nB : cB + (size_t)(t + 2) * kstep;
            const char* a3 = a2 + kstep; const char* b3 = b2 + kstep;
            if (last && has_next) S.a_ready(nxt);
            if constexpr (SP2) {
            PG8_LDB(B0, 0, 0); PG8_LDB(B1, 0, 1); PG8_SCHED; PG8_LDA(At, 0, 0); PG8_STAGE(PG8_SA(1, 1), a1 + hstep, voffA);
            PG8_WAIT_V(8); PG8_WAIT_L(0); PG8_BAR; PG8_MMA(0, 0, At, B0); PG8_MMA(0, 1, At, B1); PG8_BAR; PG8_SCHED;
            PG8_LDA(At, 0, 1); PG8_STAGE(PG8_SB(0, 0), b2, voffB); PG8_STAGE(PG8_SB(0, 1), b2 + hstep, voffB); PG8_STAGE(PG8_SA(0, 0), a2, voffA);
            PG8_WAIT_V(8); PG8_WAIT_L(0); PG8_BAR; PG8_MMA(1, 0, At, B0); PG8_MMA(1, 1, At, B1); PG8_BAR; PG8_SCHED;
            PG8_LDB(B0, 1, 0); PG8_LDB(B1, 1, 1); PG8_SCHED; PG8_LDA(At, 1, 0); PG8_STAGE(PG8_SA(0, 1), a2 + hstep, voffA);
            PG8_WAIT_V(8); PG8_WAIT_L(0); PG8_BAR; PG8_MMA(0, 0, At, B0); PG8_MMA(0, 1, At, B1); PG8_BAR; PG8_SCHED;
            PG8_LDA(At, 1, 1); PG8_STAGE(PG8_SB(1, 0), b3, voffB); PG8_STAGE(PG8_SB(1, 1), b3 + hstep, voffB); PG8_STAGE(PG8_SA(1, 0), a3, voffA);
            PG8_WAIT_V(8); PG8_WAIT_L(0); PG8_BAR; PG8_MMA(1, 0, At, B0); PG8_MMA(1, 1, At, B1); PG8_BAR; PG8_SCHED;
            } else {
            PG8_LDB(B0, 0, 0); PG8_SCHED; PG8_LDA(At, 0, 0); PG8_STAGE(PG8_SA(1, 1), a1 + hstep, voffA);
            PG8_WAIT_L(8); PG8_BAR; PG8_WAIT_L(0); PG8_MMA(0, 0, At, B0); PG8_BAR; PG8_SCHED;
            PG8_LDB(B1, 0, 1); PG8_STAGE(PG8_SB(0, 0), b2, voffB);
            PG8_BAR; PG8_WAIT_L(0); PG8_MMA(0, 1, At, B1); PG8_BAR;
            PG8_LDA(At, 0, 1); PG8_STAGE(PG8_SA(0, 0), a2, voffA);
            PG8_BAR; PG8_WAIT_L(0); PG8_MMA(1, 0, At, B0); PG8_BAR; PG8_SCHED;
            PG8_STAGE(PG8_SB(0, 1), b2 + hstep, voffB);
            PG8_WAIT_V(6); PG8_BAR; PG8_MMA(1, 1, At, B1); PG8_BAR;
            PG8_LDB(B0, 1, 0); PG8_SCHED; PG8_LDA(At, 1, 0); PG8_STAGE(PG8_SA(0, 1), a2 + hstep, voffA);
            PG8_WAIT_L(8); PG8_BAR; PG8_WAIT_L(0); PG8_MMA(0, 0, At, B0); PG8_BAR; PG8_SCHED;
            PG8_LDB(B1, 1, 1); PG8_STAGE(PG8_SB(1, 0), b3, voffB);
            PG8_BAR; PG8_WAIT_L(0); PG8_MMA(0, 1, At, B1); PG8_BAR;
            PG8_LDA(At, 1, 1); PG8_STAGE(PG8_SA(1, 0), a3, voffA);
            PG8_BAR; PG8_WAIT_L(0); PG8_MMA(1, 0, At, B0); PG8_BAR; PG8_SCHED;
            PG8_STAGE(PG8_SB(1, 1), b3 + hstep, voffB);
            PG8_WAIT_V(6); PG8_BAR; PG8_MMA(1, 1, At, B1); PG8_BAR;
            }
        }
        if constexpr (ALIGN_EPI) { if (wr == 0) PG8_BAR; }
        if constexpr (!Epi::AFTER_DRAIN) { E(acc, cur, wr, wc, fr, fq); S.done(cur); }
        if (!has_next) break;
#pragma unroll
        for (int a = 0; a < 2; ++a)
#pragma unroll
            for (int b = 0; b < 2; ++b)
#pragma unroll
                for (int m = 0; m < 4; ++m)
#pragma unroll
                    for (int n = 0; n < 2; ++n) acc[a][b][m][n] = (f32x4){0.f, 0.f, 0.f, 0.f};
        cur = nxt; cA = nA; cB = nB; ++ui;
        if constexpr (ALIGN_EPI) { if (wr == 1) PG8_BAR; }
    }
    PG8_WAIT_V(0);
    if constexpr (!ALIGN_EPI) { if (wr == 0) PG8_BAR; }
    PG8_BAR;
    if constexpr (Epi::AFTER_DRAIN) { E.fused(acc, cur, wr, wc, fr, fq, lds, wid, lane); S.done(cur); }
#undef PG8_SA
#undef PG8_SB
#undef PG8_STAGE
#undef PG8_LDA
#undef PG8_LDB
#undef PG8_MMA
#undef PG8_WAIT_V
#undef PG8_WAIT_L
#undef PG8_BAR
#undef PG8_SCHED
}
}
#define GAS __attribute__((address_space(1)))
#define LAS __attribute__((address_space(3)))
typedef unsigned short bf16;
typedef unsigned v4u __attribute__((ext_vector_type(4)));
typedef float f32x4 __attribute__((ext_vector_type(4)));
typedef short bf16x8 __attribute__((ext_vector_type(8)));
typedef GAS unsigned gu32;
typedef GAS unsigned long long gu64;
#define RLX_AGENT __ATOMIC_RELAXED, __HIP_MEMORY_SCOPE_AGENT
#define LDS_WAIT() asm volatile("s_waitcnt lgkmcnt(0)" ::: "memory")
#define VM_WAIT() asm volatile("s_waitcnt vmcnt(0)" ::: "memory")
__device__ __forceinline__ unsigned long long rt() { return __builtin_amdgcn_s_memrealtime(); }
__device__ __forceinline__ unsigned f2bf(float f) { unsigned u = __builtin_bit_cast(unsigned, f); return (u + 0x7fffu + ((u >> 16) & 1u)) >> 16; }
__device__ __forceinline__ unsigned pk2(float lo, float hi) { return f2bf(lo) | (f2bf(hi) << 16); }

#define XB_TMO      128
#define XB_XCNT(j)  (256  + 64 * (j))
#define XB_XSUB(j)  (1280 + 64 * (j))
#define XB_XGEN(j)  (2304 + 64 * (j))
#define XB_TOP      3328
#define XB_TOPGEN   3392
#define XCD_BAR_WORDS 3456
#define XB_SPIN_CAP (1u << 18)

__device__ __forceinline__ unsigned xb_ld(unsigned* p)              { return __hip_atomic_load(p, __ATOMIC_RELAXED, __HIP_MEMORY_SCOPE_AGENT); }
__device__ __forceinline__ unsigned xb_add(unsigned* p, unsigned v) { return __hip_atomic_fetch_add(p, v, __ATOMIC_RELAXED, __HIP_MEMORY_SCOPE_AGENT); }
__device__ __forceinline__ unsigned xb_xcc_id() { return (unsigned)__builtin_amdgcn_s_getreg((3 << 11) | 20) & 0xFu; }
#define XB_SPIN(cond, bar) do { unsigned _sp = 0; while (cond) { __builtin_amdgcn_s_sleep(1); \
    if ((++_sp & 255u) == 0u) { if (xb_ld(&(bar)[XB_TMO])) break; if (_sp > XB_SPIN_CAP) { atomicAdd(&(bar)[XB_TMO], 1u); break; } } } } while (0)

struct XcdBarrier {
    unsigned* bar; unsigned x;
    volatile LAS unsigned* st;
};

__device__ __forceinline__ XcdBarrier xcd_barrier_post(unsigned* bar, volatile LAS unsigned* st) {
    XcdBarrier b; b.bar = bar; b.x = xb_xcc_id(); b.st = st;
    if (threadIdx.x == 0) (void)xb_add(&bar[XB_XCNT(b.x)], 1u);
    return b;
}
__device__ __forceinline__ void xcd_barrier_complete(unsigned* bar, unsigned x, unsigned& nloc, unsigned& nx) {
    const unsigned G = gridDim.x * gridDim.y * gridDim.z;
    unsigned sum, cnt, mine, sp = 0u;
    for (;;) {
        sum = 0u; cnt = 0u; mine = 0u;
#pragma unroll
        for (unsigned j = 0; j < 16; ++j) { const unsigned c = xb_ld(&bar[XB_XCNT(j)]); sum += c; cnt += (c > 0u) ? 1u : 0u; mine = (j == x) ? c : mine; }
        if (sum == G) break;
        __builtin_amdgcn_s_sleep(1);
        if ((++sp & 255u) == 0u) { if (xb_ld(&bar[XB_TMO])) break; if (sp > XB_SPIN_CAP) { atomicAdd(&bar[XB_TMO], 1u); break; } }
    }
    nloc = mine > 0u ? mine : 1u; nx = cnt > 0u ? cnt : 1u;
}

__device__ __forceinline__ void xcd_barrier(const XcdBarrier& b) {
    asm volatile("s_waitcnt vmcnt(0)" ::: "memory");
    __syncthreads();
    if (threadIdx.x == 0) {
        unsigned* bar = b.bar;
        __builtin_amdgcn_s_waitcnt(0);
        unsigned nloc = b.st[0], nx = b.st[1];
        if (nloc == 0u) { xcd_barrier_complete(bar, b.x, nloc, nx); b.st[0] = nloc; b.st[1] = nx; }
        const unsigned old = xb_add(&bar[XB_XSUB(b.x)], 1u);
        const unsigned gen = old / nloc;
        if (old + 1u == (gen + 1u) * nloc) {
            __builtin_amdgcn_fence(__ATOMIC_RELEASE, "agent");
            asm volatile("s_waitcnt vmcnt(0)" ::: "memory");
            const unsigned og = xb_add(&bar[XB_TOP], 1u);
            const unsigned tg = og / nx;
            if (og + 1u == (tg + 1u) * nx) xb_add(&bar[XB_TOPGEN], 1u);
            else XB_SPIN(xb_ld(&bar[XB_TOPGEN]) == tg, bar);
            __builtin_amdgcn_fence(__ATOMIC_ACQUIRE, "agent");
            xb_add(&bar[XB_XGEN(b.x)], 1u);
            asm volatile("s_waitcnt vmcnt(0)" ::: "memory");
        } else {
            XB_SPIN(xb_ld(&bar[XB_XGEN(b.x)]) == gen, bar);
            __builtin_amdgcn_fence(__ATOMIC_ACQUIRE, "agent");
            asm volatile("s_waitcnt vmcnt(0)" ::: "memory");
        }
    }
    __syncthreads();
}

constexpr int NWAVES = 8, NTHR = NWAVES * 64;
constexpr int BATCH = 4, SEQ = 4096, DM = 1024, M = BATCH * SEQ;
constexpr int NPROJ = 3584, INCOLS = 3592;
constexpr int PW = 512;
constexpr int NEXP = 16384, PHEADS = 8, PTOPK = 16;
constexpr float LOG2E = 1.4426950408889634f;
constexpr float NORM_EPS = 1e-6f, SUBLN_EPS = 1e-5f;
constexpr float LAM_INIT = 0.2f;
constexpr float QSCALE = 0.125f * LOG2E;
constexpr float MLK_SCALE = 0.08838834764831845f;

constexpr size_t MiB = 1u << 20;
constexpr size_t WS_CTL = 0, CTL_ZERO_BYTES = 1 * MiB;
constexpr size_t WS_GI = 1 * MiB, WS_GLF = WS_GI + 256 * 1024, WS_A2 = WS_GLF + 256 * 1024, WS_M2 = WS_A2 + 256 * 1024;
constexpr size_t WS_NB2 = 2 * MiB, WS_MLOC = WS_NB2 + 256 * 1024, WS_DN = WS_MLOC + 4096;
constexpr size_t WS_SSP = 3 * MiB;
constexpr size_t WS_WIN = 4 * MiB, WS_WOUT = 11 * MiB, WS_WPQ = 13 * MiB, WS_SUBK = 17 * MiB;
constexpr size_t WS_H1 = 20 * MiB;
constexpr size_t WS_PROJ = 52 * MiB;
constexpr size_t PROJ_STRIDE = (size_t)M * PW;
constexpr size_t WS_X1 = 52 * MiB, WS_X1B = 116 * MiB, WS_QPB = 148 * MiB;
constexpr size_t WS_DCT = 164 * MiB;
constexpr size_t WS_SU = 188 * MiB;
constexpr size_t WS_WL = 180 * MiB;
constexpr size_t WS_UB = 192 * MiB, WS_VB = 208 * MiB;
constexpr size_t WS_PE = 224 * MiB, WS_LIST = 240 * MiB, WS_END = 256 * MiB;
constexpr int CW_ERR = 16, CW_Q = 32, CW_BAR = 4096;

constexpr int RING_BYTES = 131072;
constexpr int MISC_OFF = RING_BYTES;
constexpr int WSCR_OFF = MISC_OFF + 512;
constexpr int XTRA_OFF = WSCR_OFF + 8 * 512;
constexpr int LDS_BYTES = 163840;

struct Frame {
    LAS unsigned char* lds; unsigned char* ldsg;
    volatile LAS unsigned* MISC;
    gu32* ctl;
    int tid, lane, wave, vcu, G;
    const float* in[20]; float* out; unsigned char* ws;
};
#define WSP(T, off) ((T*)(F.ws + (off)))

__device__ __forceinline__ float bf2f(unsigned short b) { return __builtin_bit_cast(float, (unsigned)b << 16); }
__device__ __forceinline__ float wave_sum(float v) {
#pragma unroll
    for (int o = 1; o < 64; o <<= 1) v += __shfl_xor(v, o);
    return v;
}
__device__ __forceinline__ float wave_max(float v) {
#pragma unroll
    for (int o = 1; o < 64; o <<= 1) v = fmaxf(v, __shfl_xor(v, o));
    return v;
}

template <int CTRL> __device__ __forceinline__ float dppf(float v) { return __int_as_float(__builtin_amdgcn_mov_dpp(__float_as_int(v), CTRL, 0xf, 0xf, true)); }
__device__ __forceinline__ float reduce8(const float (&d)[8], int lane) {
    float s[4], t[2];
#pragma unroll
    for (int k = 0; k < 4; ++k) { auto r = __builtin_amdgcn_permlane32_swap(__float_as_uint(d[k]), __float_as_uint(d[k + 4]), false, false); s[k] = __uint_as_float(r[0]) + __uint_as_float(r[1]); }
#pragma unroll
    for (int k = 0; k < 2; ++k) { auto r = __builtin_amdgcn_permlane16_swap(__float_as_uint(s[k]), __float_as_uint(s[k + 2]), false, false); t[k] = __uint_as_float(r[0]) + __uint_as_float(r[1]); }
    const bool b3 = (lane & 8) != 0;
    float r = (b3 ? t[1] : t[0]) + dppf<0x128>(b3 ? t[0] : t[1]);
    r += dppf<0xB1>(r); r += dppf<0x4E>(r); r += dppf<0x141>(r);
    return r;
}

__device__ __forceinline__ void p0_transpose_item(const float* W, int ldw, int K, int nblk, bf16* WT, const float* kscale, LAS float* scr, int item, int lane) {
    const int kb = item / nblk, nb = item % nblk, k0 = 64 * kb, n0 = 32 * nb;
    float v[32];
#pragma unroll
    for (int i = 0; i < 32; ++i) v[i] = W[(size_t)(k0 + 2 * i + (lane >> 5)) * ldw + n0 + (lane & 31)];
#pragma unroll
    for (int i = 0; i < 32; ++i) { const int kk = 2 * i + (lane >> 5); scr[kk * 33 + (lane & 31)] = kscale ? v[i] * kscale[k0 + kk] : v[i]; }
    LDS_WAIT(); asm volatile("" ::: "memory");
    const int c = lane & 7;
#pragma unroll
    for (int j = 0; j < 4; ++j) { const int n = (lane >> 3) + 8 * j; const LAS float* s = scr + (8 * c) * 33 + n;
        v4u o; o.x = pk2(s[0 * 33], s[1 * 33]); o.y = pk2(s[2 * 33], s[3 * 33]); o.z = pk2(s[4 * 33], s[5 * 33]); o.w = pk2(s[6 * 33], s[7 * 33]);
        *(GAS v4u*)(WT + (size_t)(n0 + n) * K + k0 + 8 * c) = o; }
    LDS_WAIT(); asm volatile("" ::: "memory");
}
__device__ __forceinline__ float log_sigmoid(float f) { return fminf(f, 0.f) - log1pf(expf(-fabsf(f))); }

__device__ __forceinline__ void cvt_small_weights(Frame& F, int bi, int nblk) {
    const float* w_out = F.in[13]; const float* g2 = F.in[14]; const float* w_pq = F.in[15]; const float* sk = F.in[16];
    LAS float* scr = (LAS float*)(F.lds + F.wave * 8448);
    const int gw = bi * NWAVES + F.wave, NGW = nblk * NWAVES;
    constexpr int I_OUT = 16 * 32, I_PQ = 16 * 64;
    for (int it = gw; it < I_OUT + I_PQ; it += NGW) {
        if (it < I_OUT) p0_transpose_item(w_out, DM, DM, 32, WSP(bf16, WS_WOUT), nullptr, scr, it, F.lane);
        else p0_transpose_item(w_pq, 2048, DM, 64, WSP(bf16, WS_WPQ), g2, scr, it - I_OUT, F.lane); }
    bf16* SK = WSP(bf16, WS_SUBK);
    for (int i = bi * NTHR + F.tid; i < 262144 / 8; i += nblk * NTHR) { const f32x4 a = ((const f32x4*)sk)[2 * i], b = ((const f32x4*)sk)[2 * i + 1];
        v4u o; o.x = pk2(a[0], a[1]); o.y = pk2(a[2], a[3]); o.z = pk2(b[0], b[1]); o.w = pk2(b[2], b[3]); ((v4u*)SK)[i] = o; }
}
__device__ __forceinline__ void p0_prologue(Frame& F) {
    const float* x = F.in[0]; const float* g1 = F.in[1]; const float* w_in = F.in[2];
    LAS float* wg = (LAS float*)(F.lds + 98304);
    { float t[16];
#pragma unroll
      for (int i = 0; i < 16; ++i) { const int e = F.tid + i * NTHR; t[i] = w_in[(size_t)(e >> 3) * INCOLS + NPROJ + (e & 7)]; }
#pragma unroll
      for (int i = 0; i < 16; ++i) wg[F.tid + i * NTHR] = t[i]; }
    LAS float* scr = (LAS float*)(F.lds + F.wave * 8448);
    const int gw = F.vcu * NWAVES + F.wave, NGW = F.G * NWAVES;
    constexpr int I_IN = 16 * (NPROJ / 32);
    for (int it = gw; it < I_IN; it += NGW) p0_transpose_item(w_in, INCOLS, DM, NPROJ / 32, WSP(bf16, WS_WIN), nullptr, scr, it, F.lane);
    __syncthreads();
    const float* b_i = F.in[5]; const float* b_f = F.in[6];
    float* GI = WSP(float, WS_GI); float* GLF = WSP(float, WS_GLF); bf16* H1 = WSP(bf16, WS_H1);
    f32x4 gv[4];
#pragma unroll
    for (int j = 0; j < 4; ++j) gv[j] = ((const f32x4*)g1)[F.lane + 64 * j];
    const int gsel = F.lane >> 3; const float gbias = (gsel < 4) ? b_i[gsel] : b_f[gsel - 4];
    f32x4 nv[4];
    if (gw < M) { const f32x4* xr = (const f32x4*)(x + (size_t)gw * DM) + F.lane;
#pragma unroll
        for (int j = 0; j < 4; ++j) nv[j] = __builtin_nontemporal_load(xr + 64 * j); }
    for (int m = gw; m < M; m += NGW) {
        f32x4 v[4]; float s = 0.f;
#pragma unroll
        for (int j = 0; j < 4; ++j) { v[j] = nv[j]; s += (v[j][0] * v[j][0] + v[j][1] * v[j][1]) + (v[j][2] * v[j][2] + v[j][3] * v[j][3]); }
        if (m + NGW < M) { const f32x4* xr = (const f32x4*)(x + (size_t)(m + NGW) * DM) + F.lane;
#pragma unroll
            for (int j = 0; j < 4; ++j) nv[j] = __builtin_nontemporal_load(xr + 64 * j); }
        const float rstd = 1.0f / sqrtf(wave_sum(s) * (1.f / DM) + NORM_EPS);
        float ga[8];
#pragma unroll
        for (int g = 0; g < 8; ++g) ga[g] = 0.f;
        unsigned long long* o8 = (unsigned long long*)(H1 + (size_t)m * DM) + F.lane;
#pragma unroll
        for (int j = 0; j < 4; ++j) { v[j] = v[j] * rstd * gv[j];
            o8[64 * j] = (unsigned long long)pk2(v[j][0], v[j][1]) | ((unsigned long long)pk2(v[j][2], v[j][3]) << 32);
#pragma unroll
            for (int i = 0; i < 4; ++i) { const int e = 4 * F.lane + 256 * j + i; const f32x4 w0 = *(const LAS f32x4*)(wg + e * 8), w1 = *(const LAS f32x4*)(wg + e * 8 + 4);
                ga[0] += v[j][i] * w0[0]; ga[1] += v[j][i] * w0[1]; ga[2] += v[j][i] * w0[2]; ga[3] += v[j][i] * w0[3];
                ga[4] += v[j][i] * w1[0]; ga[5] += v[j][i] * w1[1]; ga[6] += v[j][i] * w1[2]; ga[7] += v[j][i] * w1[3]; } }
        const float gt = reduce8(ga, F.lane) + gbias;
        if ((F.lane & 7) == 0) { const int b = m / SEQ, t = m % SEQ; const size_t o = (size_t)(b * 4 + (gsel & 3)) * SEQ + t;
            if (gsel < 4) GI[o] = gt; else GLF[o] = log_sigmoid(gt); }
    }
}
__device__ __forceinline__ void cvt_peer_tables(Frame& F, int quota) {
    const float* g2 = F.in[14]; const float* ue = F.in[17]; const float* ve = F.in[18];
    unsigned* U8 = WSP(unsigned, WS_UB); unsigned* V8 = WSP(unsigned, WS_VB);
    constexpr int NROW = NEXP, CH = 64, NCHUNK = 2 * NROW / CH;
    f32x4 sc[4];
#pragma unroll
    for (int q = 0; q < 4; ++q) sc[q] = ((const f32x4*)g2)[F.lane + 64 * q];
    for (int nq = 0; nq < quota; ++nq) {
        if (F.tid == 0) F.MISC[17] = __hip_atomic_fetch_add(F.ctl + CW_Q + 1, 1u, __ATOMIC_RELAXED, __HIP_MEMORY_SCOPE_AGENT);
        __syncthreads();
        const int ck = (int)F.MISC[17];
        __syncthreads();
        if (ck >= NCHUNK) break;
#pragma unroll 1
        for (int r0 = ck * CH + F.wave; r0 < (ck + 1) * CH; r0 += 2 * NWAVES) {
            f32x4 v[2][4];
#pragma unroll
            for (int u = 0; u < 2; ++u) { const int r = r0 + u * NWAVES; const f32x4* src = (const f32x4*)((r < NROW ? ue : ve) + (size_t)(r < NROW ? r : r - NROW) * DM) + F.lane;
#pragma unroll
                for (int q = 0; q < 4; ++q) v[u][q] = __builtin_nontemporal_load(src + 64 * q); }
#pragma unroll
            for (int u = 0; u < 2; ++u) { const int r = r0 + u * NWAVES; const bool isu = r < NROW; unsigned* dst = (isu ? U8 : V8) + (size_t)(isu ? r : r - NROW) * (DM / 4) + F.lane;
                {
                    f32x4 w[4]; float mx = 0.f;
#pragma unroll
                    for (int q = 0; q < 4; ++q) { w[q] = isu ? v[u][q] * sc[q] : v[u][q]; mx = fmaxf(fmaxf(mx, fmaxf(fabsf(w[q][0]), fabsf(w[q][1]))), fmaxf(fabsf(w[q][2]), fabsf(w[q][3]))); }
                    mx = wave_max(mx); const float su = mx > 0.f ? mx * (1.0f / 127.0f) : 1.0f, inv = 1.0f / su;
                    if (F.lane == 0) WSP(float, WS_SU)[r] = su;
#pragma unroll
                    for (int q = 0; q < 4; ++q) { const int q0 = (int)rintf(w[q][0] * inv), q1 = (int)rintf(w[q][1] * inv), q2 = (int)rintf(w[q][2] * inv), q3 = (int)rintf(w[q][3] * inv);
                        dst[64 * q] = (unsigned)(q0 & 255) | ((unsigned)(q1 & 255) << 8) | ((unsigned)(q2 & 255) << 16) | ((unsigned)q3 << 24); }
                } }
        }
    }
}

__device__ __forceinline__ void gate_scan(Frame& F, int bh) {
    const float* gi = WSP(float, WS_GI) + (size_t)bh * SEQ + 64 * F.lane; const float* glf = WSP(float, WS_GLF) + (size_t)bh * SEQ + 64 * F.lane;
    float* A2 = WSP(float, WS_A2) + (size_t)bh * SEQ + 64 * F.lane; float* M2 = WSP(float, WS_M2) + (size_t)bh * SEQ + 64 * F.lane; float* NB2 = WSP(float, WS_NB2) + (size_t)bh * SEQ + 64 * F.lane;
    float tot = 0.f;
    for (int j = 0; j < 16; ++j) { const f32x4 v = ((const f32x4*)glf)[j]; tot += v[0]; tot += v[1]; tot += v[2]; tot += v[3]; }
    float inc = tot;
#pragma unroll
    for (int o = 1; o < 64; o <<= 1) { const float u = __shfl_up(inc, o); if (F.lane >= o) inc += u; }
    const float boff = inc - tot;
    float B = boff, lm = -3.0e38f;
    for (int j = 0; j < 16; ++j) { const f32x4 v = ((const f32x4*)glf)[j], iv = ((const f32x4*)gi)[j];
#pragma unroll
        for (int i = 0; i < 4; ++i) { B += v[i]; lm = fmaxf(lm, iv[i] - B); } }
    float incm = lm;
#pragma unroll
    for (int o = 1; o < 64; o <<= 1) { const float u = __shfl_up(incm, o); if (F.lane >= o) incm = fmaxf(incm, u); }
    float pm = __shfl_up(incm, 1); if (F.lane == 0) pm = -3.0e38f;
    B = boff; float Mx = pm;
    for (int j = 0; j < 16; ++j) { const f32x4 v = ((const f32x4*)glf)[j], iv = ((const f32x4*)gi)[j]; f32x4 oa, om, ob;
#pragma unroll
        for (int i = 0; i < 4; ++i) { B += v[i]; const float a = iv[i] - B; Mx = fmaxf(Mx, a); oa[i] = a * LOG2E; om[i] = Mx * LOG2E; ob[i] = -(B + Mx) * LOG2E; }
        ((f32x4*)A2)[j] = oa; ((f32x4*)M2)[j] = om; ((f32x4*)NB2)[j] = ob; }
}

namespace att {
using s16x4 = __attribute__((ext_vector_type(4))) short;
using f32x16 = __attribute__((ext_vector_type(16))) float;
using u32x4 = __attribute__((ext_vector_type(4))) unsigned;
constexpr int SHM_T = 64 * 128 * 2;
#define KSWZ(row, colB) ((row) * 256 + ((colB) ^ (((row) & 7) << 4)))
#define SBAR() __builtin_amdgcn_sched_barrier(0)
#define MFMA32(a, b, c) __builtin_amdgcn_mfma_f32_32x32x16_bf16((a), (b), (c), 0, 0, 0)
__device__ __forceinline__ int crow(int r, int hi) { return (r & 3) + 8 * (r >> 2) + 4 * hi; }
__device__ __forceinline__ unsigned cvtpk(float lo, float hi) { unsigned r; asm volatile("v_cvt_pk_bf16_f32 %0, %1, %2" : "=v"(r) : "v"(lo), "v"(hi)); return r; }
__device__ __forceinline__ int v_st(int k, int c) { const int kk = (k & ~0xC) | ((k & 4) << 1) | ((k & 8) >> 1); return ((kk >> 3) * 4 + (c >> 5)) * 512 + ((kk & 7) * 32 + (c & 31)) * 2; }
__device__ __forceinline__ int v_rd_base(int lane) { return ((lane & 3) << 3) | (((lane >> 2) & 3) << 6) | (((lane >> 4) & 1) << 5) | (((lane >> 5) & 1) << 8); }
constexpr int v_rd_off(int d0, int ks, int half) { return d0 * 512 + ks * 4096 + half * 2048; }
template <int OFF> __device__ __forceinline__ s16x4 tr_read(int vb) { s16x4 r; asm volatile("ds_read_b64_tr_b16 %0, %1 offset:%2" : "=&v"(r) : "v"(vb), "i"(OFF) : "memory"); return r; }
#define PKF(L, H) (bf16x8){L[0], L[1], L[2], L[3], H[0], H[1], H[2], H[3]}
template <int D0, int KS> __device__ __forceinline__ bf16x8 tr_frag(int vb) {
    const s16x4 l = tr_read<v_rd_off(D0, KS, 0)>(vb), h = tr_read<v_rd_off(D0, KS, 1)>(vb); asm volatile("s_waitcnt lgkmcnt(0)" ::: "memory"); return PKF(l, h); }
template <int D0> __device__ __forceinline__ void pv_one(f32x16& od, int vb, bf16x8 pa0, bf16x8 pa1, bf16x8 pa2, bf16x8 pa3) {
    const s16x4 l0 = tr_read<v_rd_off(D0, 0, 0)>(vb), h0 = tr_read<v_rd_off(D0, 0, 1)>(vb), l1 = tr_read<v_rd_off(D0, 1, 0)>(vb), h1 = tr_read<v_rd_off(D0, 1, 1)>(vb);
    const s16x4 l2 = tr_read<v_rd_off(D0, 2, 0)>(vb), h2 = tr_read<v_rd_off(D0, 2, 1)>(vb), l3 = tr_read<v_rd_off(D0, 3, 0)>(vb), h3 = tr_read<v_rd_off(D0, 3, 1)>(vb);
    asm volatile("s_waitcnt lgkmcnt(0)" ::: "memory"); SBAR();
    od = MFMA32(pa0, PKF(l0, h0), od); od = MFMA32(pa1, PKF(l1, h1), od); od = MFMA32(pa2, PKF(l2, h2), od); od = MFMA32(pa3, PKF(l3, h3), od);
}
__device__ __forceinline__ void pv_d0(f32x16* o, int vb, bf16x8 pa0, bf16x8 pa1, bf16x8 pa2, bf16x8 pa3) {
    pv_one<0>(o[0], vb, pa0, pa1, pa2, pa3); pv_one<1>(o[1], vb, pa0, pa1, pa2, pa3); pv_one<2>(o[2], vb, pa0, pa1, pa2, pa3); pv_one<3>(o[3], vb, pa0, pa1, pa2, pa3);
}
__device__ __forceinline__ void pack_p(const f32x16& p0, const f32x16& p1, bf16x8& pa0, bf16x8& pa1, bf16x8& pa2, bf16x8& pa3) {
#define PK4(P, BASE, OUT) do { unsigned a0 = cvtpk(P[BASE + 0], P[BASE + 1]), a1 = cvtpk(P[BASE + 2], P[BASE + 3]);   \
    unsigned b0 = cvtpk(P[BASE + 4], P[BASE + 5]), b1 = cvtpk(P[BASE + 6], P[BASE + 7]);                              \
    auto r0 = __builtin_amdgcn_permlane32_swap(a0, b0, false, false); auto r1 = __builtin_amdgcn_permlane32_swap(a1, b1, false, false); \
    u32x4 w = {r0[0], r1[0], r0[1], r1[1]}; OUT = __builtin_bit_cast(bf16x8, w); } while (0)
    PK4(p0, 0, pa0); PK4(p0, 8, pa1); PK4(p1, 0, pa2); PK4(p1, 8, pa3);
#undef PK4
}
__device__ __forceinline__ float half_swap_max(float v) { auto rr = __builtin_amdgcn_permlane32_swap(__float_as_uint(v), __float_as_uint(v), false, false); return fmaxf(__uint_as_float(rr[0]), __uint_as_float(rr[1])); }
__device__ __forceinline__ float half_swap_add(float v) { auto rr = __builtin_amdgcn_permlane32_swap(__float_as_uint(v), __float_as_uint(v), false, false); return __uint_as_float(rr[0]) + __uint_as_float(rr[1]); }
__device__ __forceinline__ float half_sum32(float v) {
#pragma unroll
    for (int o = 1; o < 32; o <<= 1) v += __shfl_xor(v, o);
    return v;
}

constexpr float THR2 = 10.f;
__device__ __forceinline__ void partialSM(f32x16& p0, f32x16& p1, float& m_reg, float& alpha, float Tj, bool domask, int key0, int qrow, int hi) {
    if (domask) {
#pragma unroll
        for (int r = 0; r < 16; ++r) { const int kv = key0 + crow(r, hi); if (kv > qrow) p0[r] = -INFINITY; if (kv + 32 > qrow) p1[r] = -INFINITY; }
    }
    float pmax = p0[0];
#pragma unroll
    for (int r = 1; r < 16; ++r) pmax = fmaxf(pmax, p0[r]);
#pragma unroll
    for (int r = 0; r < 16; ++r) pmax = fmaxf(pmax, p1[r]);
    pmax = half_swap_max(pmax) + Tj;
    float mn;
    if (__builtin_expect(__all(pmax - m_reg <= THR2), 1)) { mn = m_reg; alpha = 1.f; }
    else { mn = fmaxf(m_reg, pmax); alpha = __builtin_amdgcn_exp2f(m_reg - mn); m_reg = mn; }
    const float off = Tj - mn;
#pragma unroll
    for (int r = 0; r < 16; ++r) p0[r] += off;
#pragma unroll
    for (int r = 0; r < 16; ++r) p1[r] += off;
#pragma unroll
    for (int r = 0; r < 16; ++r) p0[r] = __builtin_amdgcn_exp2f(p0[r]);
}
__device__ __forceinline__ void finishSM(f32x16& p0, f32x16& p1, float alpha, float& l_reg, bf16x8& pa0, bf16x8& pa1, bf16x8& pa2, bf16x8& pa3) {
#pragma unroll
    for (int r = 0; r < 16; ++r) p1[r] = __builtin_amdgcn_exp2f(p1[r]);
    float ps = 0;
#pragma unroll
    for (int r = 0; r < 16; ++r) ps += p0[r];
#pragma unroll
    for (int r = 0; r < 16; ++r) ps += p1[r];
    ps = half_swap_add(ps);
    l_reg = l_reg * alpha + ps;
    pack_p(p0, p1, pa0, pa1, pa2, pa3);
}
__device__ __forceinline__ void qkt4(f32x16& p0, f32x16& p1, const LAS char* Ks, const LAS char* fs, int r32, int hi, int cbase) {
    const bf16x8 kx0 = *(const LAS bf16x8*)(fs + 4096), kx1 = *(const LAS bf16x8*)(fs + 5120), qx = *(const LAS bf16x8*)(fs + 6144);
    p0 = MFMA32(kx0, qx, f32x16{}); p1 = MFMA32(kx1, qx, f32x16{});
#pragma unroll
    for (int d0 = 0; d0 < 4; ++d0) { const int cb = cbase + (d0 * 16 + hi * 8) * 2; const bf16x8 qf = *(const LAS bf16x8*)(fs + d0 * 1024);
        const bf16x8 b0 = *(const LAS bf16x8*)(Ks + KSWZ(r32, cb)); const bf16x8 b1 = *(const LAS bf16x8*)(Ks + KSWZ(32 + r32, cb));
        p0 = MFMA32(b0, qf, p0); p1 = MFMA32(b1, qf, p1); }
}

__device__ __forceinline__ void store_rows(const f32x16 (&o)[4], const float (&rs)[16], const float* colscale, LAS float* stg, bf16* dst, int ldd, const bf16* gate, int ldg, int lane) {
    const int r32 = lane & 31, hi = lane >> 5;
#pragma unroll
    for (int d = 0; d < 4; ++d) { const float cs = colscale[d * 32 + r32];
#pragma unroll
        for (int r = 0; r < 16; ++r) stg[crow(r, hi) * 128 + d * 32 + r32] = o[d][r] * rs[r] * cs; }
    asm volatile("s_waitcnt lgkmcnt(0)" ::: "memory");
#pragma unroll 2
    for (int i = 0; i < 8; ++i) { const int p = i * 64 + lane, row = p >> 4, ch = p & 15;
        f32x4 a = *(const LAS f32x4*)(stg + row * 128 + ch * 8), b = *(const LAS f32x4*)(stg + row * 128 + ch * 8 + 4);
        if (gate) { const bf16x8 gv = *(const bf16x8*)(gate + (size_t)row * ldg + ch * 8);
#pragma unroll
            for (int k = 0; k < 4; ++k) { a[k] = a[k] / (1.0f + __expf(-bf2f((unsigned short)gv[k]))); b[k] = b[k] / (1.0f + __expf(-bf2f((unsigned short)gv[4 + k]))); } }
        u32x4 w = {cvtpk(a[0], a[1]), cvtpk(a[2], a[3]), cvtpk(b[0], b[1]), cvtpk(b[2], b[3])};
        *(u32x4*)(dst + (size_t)row * ldd + ch * 8) = w; }
}

__device__ __forceinline__ void dattn_unit(Frame& F, int b, int h, int qb, float lam) {
    const int tid = F.tid, wid = F.wave, lane = F.lane, r32 = lane & 31, hi = lane >> 5, c = wid & 1, g = wid >> 1;
    LAS char* lds = (LAS char*)F.lds;
    LAS char* V_lds = lds; LAS char* K_lds = lds + 2 * SHM_T;
    LAS float* ws = (LAS float*)(lds + WSCR_OFF) + wid * 128; LAS float* li_l = ws; LAS float* al_l = ws + 32;
    const bf16* DAQ = WSP(bf16, WS_PROJ); const bf16* DAK = DAQ + PROJ_STRIDE; const bf16* DAV = DAQ + 2 * PROJ_STRIDE;
    const int q0 = qb * 128, rw = q0 + 32 * g + r32;
    const bf16* Qw = DAQ + ((size_t)b * SEQ + rw) * PW + h * 128 + c * 64 + hi * 8;
    bf16x8 qr[4];
#pragma unroll
    for (int d0 = 0; d0 < 4; ++d0) qr[d0] = *(const bf16x8*)(Qw + d0 * 16);
    const bf16* Kh = DAK + (size_t)b * SEQ * PW + h * 128; const bf16* Vh = DAV + (size_t)b * SEQ * PW + h * 128;
    const int NT = (q0 + 128) / 64;
    const float slope2 = __builtin_amdgcn_exp2f(-2.0f * (float)(h + 1)) * LOG2E;
    bf16x8 qx = {0, 0, 0, 0, 0, 0, 0, 0}, kx0 = qx, kx1 = qx;
    { const unsigned short shi = (unsigned short)f2bf(slope2); const unsigned short slo = (unsigned short)f2bf(slope2 - bf2f(shi));
      if (hi == 0) { qx[0] = (short)shi; qx[1] = (short)slo; const short k0 = (short)f2bf((float)r32), k1 = (short)f2bf((float)(32 + r32)); kx0[0] = k0; kx0[1] = k0; kx1[0] = k1; kx1[1] = k1; } }
    LAS char* fs = lds + 65536 + wid * 8192 + lane * 16;
    float m_reg = -1e30f, l_reg = 0; f32x16 o[4] = {};
    const int sr = tid >> 4, sc = (tid & 15) * 8, vst0 = v_st(sr, sc), vst1 = v_st(32 + sr, sc);
    const int vb0 = (int)(uintptr_t)V_lds + v_rd_base(lane);
    struct { bf16x8 vs0, vs1, ks0, ks1; } sr_[1];
#define SLOAD(i, k0) do { sr_[i].vs0 = *(const bf16x8*)(&Vh[(size_t)((k0) + sr) * PW + sc]); sr_[i].vs1 = *(const bf16x8*)(&Vh[(size_t)((k0) + 32 + sr) * PW + sc]); \
    sr_[i].ks0 = *(const bf16x8*)(&Kh[(size_t)((k0) + sr) * PW + sc]); sr_[i].ks1 = *(const bf16x8*)(&Kh[(size_t)((k0) + 32 + sr) * PW + sc]); } while (0)
#define SWRITE(bf, i) do { *(LAS bf16x8*)(V_lds + (bf) * SHM_T + vst0) = sr_[i].vs0; *(LAS bf16x8*)(V_lds + (bf) * SHM_T + vst1) = sr_[i].vs1; const int kc = sc * 2; \
    *(LAS bf16x8*)(K_lds + (bf) * SHM_T + KSWZ(sr, kc)) = sr_[i].ks0; *(LAS bf16x8*)(K_lds + (bf) * SHM_T + KSWZ(32 + sr, kc)) = sr_[i].ks1; } while (0)
#define SWAIT() asm volatile("s_waitcnt vmcnt(0)" ::: "memory")
#define RESC(a) do { if (__any((a) < 1.f)) { if (hi == 0) al_l[r32] = (a); asm volatile("s_waitcnt lgkmcnt(0)" ::: "memory"); \
    _Pragma("unroll") for (int d = 0; d < 4; ++d) _Pragma("unroll") for (int r = 0; r < 16; ++r) o[d][r] *= al_l[crow(r, hi)]; } } while (0)
#define TJ(j) (slope2 * 64.f * (float)((j) - NT))
    f32x16 pA0, pA1, pB0, pB1; float alA = 1.f, alB = 1.f; bf16x8 pa0, pa1, pa2, pa3; const int cbase = c * 128;
    LAS float* kmx = (LAS float*)(lds + XTRA_OFF);
    float qn_w;
    { float s = 0.f;
#pragma unroll
      for (int d0 = 0; d0 < 4; ++d0)
#pragma unroll
          for (int e = 0; e < 8; ++e) { const float v = bf2f((unsigned short)qr[d0][e]); s += v * v; }
      s = half_swap_add(s);
#pragma unroll
      for (int o = 1; o < 32; o <<= 1) s = fmaxf(s, __shfl_xor(s, o));
      qn_w = __int_as_float(__builtin_amdgcn_readfirstlane(__float_as_int(sqrtf(s)))); }
#pragma unroll
    for (int d0 = 0; d0 < 4; ++d0) *(LAS bf16x8*)(fs + d0 * 1024) = qr[d0];
    *(LAS bf16x8*)(fs + 4096) = kx0; *(LAS bf16x8*)(fs + 5120) = kx1; *(LAS bf16x8*)(fs + 6144) = qx;
    asm volatile("s_waitcnt lgkmcnt(0)" ::: "memory");
#define KNORM(bf, i) do { float n0 = 0.f, n1 = 0.f; \
    _Pragma("unroll") for (int e = 0; e < 8; ++e) { const float a = bf2f((unsigned short)sr_[i].ks0[e]), b2 = bf2f((unsigned short)sr_[i].ks1[e]); n0 += a * a; n1 += b2 * b2; } \
    n0 += __shfl_xor(n0, 1); n1 += __shfl_xor(n1, 1); n0 += __shfl_xor(n0, 2); n1 += __shfl_xor(n1, 2); n0 += __shfl_xor(n0, 4); n1 += __shfl_xor(n1, 4);     \
    n0 = fmaxf(n0, n1); n0 = fmaxf(n0, __shfl_xor(n0, 16)); n0 = fmaxf(n0, __shfl_xor(n0, 32));                                                                 \
    if ((lane & 7) == 0 && lane < 16) kmx[(bf) * 16 + (lane >> 3) * 8 + wid] = sqrtf(n0); } while (0)
#ifndef DATT_SKIP
#undef KNORM
#define KNORM(bf, i) do { } while (0)
#endif
#define DECIDE(j, bf) ({ const LAS f32x4* kp_ = (const LAS f32x4*)(kmx + (bf) * 16 + c * 8); const f32x4 ka_ = kp_[0], kb_ = kp_[1]; \
    const float km_ = fmaxf(fmaxf(fmaxf(ka_[0], ka_[1]), fmaxf(ka_[2], ka_[3])), fmaxf(fmaxf(kb_[0], kb_[1]), fmaxf(kb_[2], kb_[3]))); \
    float mm_ = m_reg; _Pragma("unroll") for (int o_ = 1; o_ < 32; o_ <<= 1) mm_ = fminf(mm_, __shfl_xor(mm_, o_)); \
    const float ub_ = qn_w * km_ + slope2 * 63.f + TJ(j); __builtin_amdgcn_readfirstlane((int)(ub_ < mm_ - 60.f)) != 0; })
#ifndef DATT_SKIP
#undef DECIDE
#define DECIDE(j, bf) false
#endif
#define TL(i) (NT - 1 - (i))
    constexpr int SE = 0, SO = 0;
    bool skA = false, skB = false;
    SLOAD(SE, TL(0) * 64); asm volatile("s_waitcnt vmcnt(0)" ::: "memory"); SWRITE(0, SE); KNORM(0, SE); __syncthreads();
    qkt4(pA0, pA1, K_lds, fs, r32, hi, cbase); partialSM(pA0, pA1, m_reg, alA, TJ(TL(0)), true, 64 * TL(0), rw, hi);
    SLOAD(SO, TL(1) * 64);
    SWAIT(); SWRITE(1, SO); KNORM(1, SO); __syncthreads();
    for (int i = 1; i + 1 < NT; i += 2) {
        skB = DECIDE(TL(i), 1);
        SBAR(); if (!skB) qkt4(pB0, pB1, K_lds + SHM_T, fs, r32, hi, cbase);
        if (!skA) finishSM(pA0, pA1, alA, l_reg, pa0, pa1, pa2, pa3); SBAR();
        SLOAD(SO, TL(i + 1) * 64); SBAR();
        if (!skA) pv_d0(o, vb0, pa0, pa1, pa2, pa3);
        alB = 1.f; if (!skB) partialSM(pB0, pB1, m_reg, alB, TJ(TL(i)), i < 2, 64 * TL(i), rw, hi);
        __syncthreads(); SWAIT(); SWRITE(0, SE); KNORM(0, SE);
        RESC(alB); __syncthreads();
        skA = DECIDE(TL(i + 1), 0);
        SBAR(); if (!skA) qkt4(pA0, pA1, K_lds, fs, r32, hi, cbase);
        if (!skB) finishSM(pB0, pB1, alB, l_reg, pa0, pa1, pa2, pa3); SBAR();
        SLOAD(SE, TL(i + 2) * 64); SBAR();
        if (!skB) pv_d0(o, vb0 + SHM_T, pa0, pa1, pa2, pa3);
        alA = 1.f; if (!skA) partialSM(pA0, pA1, m_reg, alA, TJ(TL(i + 1)), false, 64 * TL(i + 1), rw, hi);
        __syncthreads(); SWAIT(); SWRITE(1, SO); KNORM(1, SO);
        RESC(alA); __syncthreads();
    }
    skB = DECIDE(TL(NT - 1), 1);
    SBAR(); if (!skB) qkt4(pB0, pB1, K_lds + SHM_T, fs, r32, hi, cbase);
    if (!skA) finishSM(pA0, pA1, alA, l_reg, pa0, pa1, pa2, pa3); SBAR();
    if (!skA) pv_d0(o, vb0, pa0, pa1, pa2, pa3);
    alB = 1.f; if (!skB) partialSM(pB0, pB1, m_reg, alB, TJ(TL(NT - 1)), NT - 1 < 2, 64 * TL(NT - 1), rw, hi);
    __syncthreads(); RESC(alB);
    if (!skB) { finishSM(pB0, pB1, alB, l_reg, pa0, pa1, pa2, pa3); SBAR();
        pv_d0(o, vb0 + SHM_T, pa0, pa1, pa2, pa3); }
    asm volatile("s_waitcnt vmcnt(0)" ::: "memory");
#undef KNORM
#undef DECIDE
#undef TL
#undef SLOAD
#undef SWRITE
#undef SWAIT
#undef RESC
#undef TJ
#ifdef DATT_NO_EPI
    if (l_reg == 123.f) F.out[tid] = o[0][0] + o[1][1] + o[2][2] + o[3][3];
    return;
#endif
    if (hi == 0) li_l[r32] = l_reg; asm volatile("s_waitcnt lgkmcnt(0)" ::: "memory");
    float rli[16];
#pragma unroll
    for (int r = 0; r < 16; ++r) rli[r] = __builtin_amdgcn_rcpf(li_l[crow(r, hi)]);
    __syncthreads();
    LAS float* xb = (LAS float*)lds + g * 4096;
    if (c == 1) {
#pragma unroll
        for (int d = 0; d < 4; ++d)
#pragma unroll
            for (int r = 0; r < 16; ++r) xb[(d * 16 + r) * 64 + lane] = o[d][r] * rli[r];
    }
    __syncthreads();
    if (c == 0) {
        const float* gsub = F.in[11];
        float ssq[16];
#pragma unroll
        for (int r = 0; r < 16; ++r) ssq[r] = 0.f;
#pragma unroll
        for (int d = 0; d < 4; ++d)
#pragma unroll
            for (int r = 0; r < 16; ++r) { const float v = o[d][r] * rli[r] - lam * xb[(d * 16 + r) * 64 + lane]; o[d][r] = v; ssq[r] += v * v; }
#pragma unroll
        for (int r = 0; r < 16; ++r) ssq[r] = (1.0f - LAM_INIT) / sqrtf(half_sum32(ssq[r]) * (1.f / 128.f) + SUBLN_EPS);
        bf16* MIX = WSP(bf16, WS_H1) + ((size_t)b * SEQ + q0 + 32 * g) * DM + h * 128;
        store_rows(o, ssq, gsub, xb, MIX, DM, nullptr, 0, lane);
    }
    __syncthreads();
}

constexpr int MCH = 256, NCH = SEQ / MCH;

__device__ __forceinline__ void conv8(const bf16* raw, size_t rb, int t, int col0, const f32x4 (&w)[4][2], const f32x4 (&bias)[2], float scale, float (&y)[8]) {
    bf16x8 v[4];
#pragma unroll
    for (int j = 0; j < 4; ++j) { const int tt = t - 3 + j; v[j] = *(const bf16x8*)(raw + (rb + (tt < 0 ? 0 : tt)) * PW + col0); }
#pragma unroll
    for (int i = 0; i < 8; ++i) y[i] = bias[i >> 2][i & 3];
#pragma unroll
    for (int j = 0; j < 4; ++j) { const float mk = (t - 3 + j >= 0) ? 1.f : 0.f;
#pragma unroll
        for (int i = 0; i < 8; ++i) y[i] += (w[j][i >> 2][i & 3] * mk) * bf2f((unsigned short)v[j][i]); }
#pragma unroll
    for (int i = 0; i < 8; ++i) y[i] = y[i] / (1.0f + __expf(-y[i])) * scale;
}
__device__ __forceinline__ bf16x8 pack8(const float (&y)[8]) { u32x4 w = {cvtpk(y[0], y[1]), cvtpk(y[2], y[3]), cvtpk(y[4], y[5]), cvtpk(y[6], y[7])}; return __builtin_bit_cast(bf16x8, w); }
__device__ __forceinline__ void load_convw(const float* conv_w, const float* conv_b, int ch0, f32x4 (&w)[4][2], f32x4 (&bias)[2]) {
#pragma unroll
    for (int j = 0; j < 4; ++j) { w[j][0] = *(const f32x4*)(conv_w + j * 1024 + ch0); w[j][1] = *(const f32x4*)(conv_w + j * 1024 + ch0 + 4); }
    bias[0] = *(const f32x4*)(conv_b + ch0); bias[1] = *(const f32x4*)(conv_b + ch0 + 4);
}
__device__ __forceinline__ void split3(float x, short& a, short& b, short& c) {
    const unsigned short h = (unsigned short)f2bf(x); const float r1 = x - bf2f(h); const unsigned short m = (unsigned short)f2bf(r1); const float r2 = r1 - bf2f(m); const unsigned short l = (unsigned short)f2bf(r2);
    a = (short)h; b = (short)m; c = (short)l;
}

__device__ __forceinline__ void mlstm_state_item(Frame& F, int bh, int c) {
    const int tid = F.tid, wid = F.wave, lane = F.lane, r32 = lane & 31, hi = lane >> 5;
    const int b = bh >> 2, hh = bh & 3, t0 = c * MCH;
    LAS char* lds = (LAS char*)F.lds; LAS char* Kimg = lds; LAS char* Vimg = lds + 4 * SHM_T;
    const bf16* MLK = WSP(bf16, WS_PROJ) + 4 * PROJ_STRIDE; const bf16* MLV = WSP(bf16, WS_PROJ) + 5 * PROJ_STRIDE;
    const float* A2 = WSP(float, WS_A2) + (size_t)bh * SEQ + t0;
    float am = (tid < MCH) ? A2[tid] : -3.0e38f; am = wave_max(am);
    LAS float* red = (LAS float*)(lds + XTRA_OFF);
    if (lane == 0) red[wid] = am;
    __syncthreads();
    float mloc = red[0];
#pragma unroll
    for (int w = 1; w < 8; ++w) mloc = fmaxf(mloc, red[w]);
    if (tid == 0) WSP(float, WS_MLOC)[bh * NCH + c] = mloc;
    const int cg = tid & 15; const size_t rb = (size_t)b * SEQ;
    f32x4 cw[4][2], cb[2]; load_convw(F.in[3], F.in[4], 512 + hh * 128 + cg * 8, cw, cb);
#pragma unroll 2
    for (int i = 0; i < 8; ++i) { const int row = (tid >> 4) + 32 * i, t = t0 + row; float y[8];
        conv8(MLK, rb, t, hh * 128 + cg * 8, cw, cb, MLK_SCALE, y);
        const float wgt = __builtin_amdgcn_exp2f(A2[row] - mloc);
#pragma unroll
        for (int e = 0; e < 8; ++e) y[e] *= wgt;
        *(LAS bf16x8*)(Kimg + (row >> 6) * SHM_T + v_st(row & 63, cg * 8)) = pack8(y);
        *(LAS bf16x8*)(Vimg + (row >> 6) * SHM_T + v_st(row & 63, cg * 8)) = *(const bf16x8*)(MLV + (rb + t) * PW + hh * 128 + cg * 8); }
    __syncthreads();
    const int id0 = wid * 2, dvb = id0 >> 2, dkb0 = id0 & 3;
    f32x16 acc0 = {}, acc1 = {}, accn = {};
    const bf16x8 ones = {0x3F80, 0x3F80, 0x3F80, 0x3F80, 0x3F80, 0x3F80, 0x3F80, 0x3F80};
    const int vbK = (int)(uintptr_t)Kimg + v_rd_base(lane), vbV = (int)(uintptr_t)Vimg + v_rd_base(lane);
#define ST_STEP(KS) do { \
        bf16x8 af, b0f, b1f, bnf; \
        af = (dvb == 0) ? tr_frag<0, KS>(vbV + tt * SHM_T) : (dvb == 1) ? tr_frag<1, KS>(vbV + tt * SHM_T) : (dvb == 2) ? tr_frag<2, KS>(vbV + tt * SHM_T) : tr_frag<3, KS>(vbV + tt * SHM_T); \
        if (dkb0 == 0) { b0f = tr_frag<0, KS>(vbK + tt * SHM_T); b1f = tr_frag<1, KS>(vbK + tt * SHM_T); } else { b0f = tr_frag<2, KS>(vbK + tt * SHM_T); b1f = tr_frag<3, KS>(vbK + tt * SHM_T); } \
        acc0 = MFMA32(af, b0f, acc0); acc1 = MFMA32(af, b1f, acc1); \
        if (wid < 4) { bnf = (wid == 0) ? tr_frag<0, KS>(vbK + tt * SHM_T) : (wid == 1) ? tr_frag<1, KS>(vbK + tt * SHM_T) : (wid == 2) ? tr_frag<2, KS>(vbK + tt * SHM_T) : tr_frag<3, KS>(vbK + tt * SHM_T); \
            accn = MFMA32(ones, bnf, accn); } } while (0)
    for (int tt = 0; tt < 4; ++tt) { ST_STEP(0); ST_STEP(1); ST_STEP(2); ST_STEP(3); }
#undef ST_STEP
    bf16* DCT = WSP(bf16, WS_DCT) + ((size_t)(bh * NCH + c) << 14);
#pragma unroll
    for (int r = 0; r < 16; ++r) { const int dv = 32 * dvb + crow(r, hi);
        DCT[dv * 128 + 32 * dkb0 + r32] = (bf16)f2bf(acc0[r]); DCT[dv * 128 + 32 * (dkb0 + 1) + r32] = (bf16)f2bf(acc1[r]); }
    if (wid < 4 && hi == 0) WSP(float, WS_DN)[(size_t)(bh * NCH + c) * 128 + 32 * wid + r32] = accn[0];
    __syncthreads();
}

__device__ __forceinline__ void mlstm_out_unit(Frame& F, int bh, int c) {
    const int tid = F.tid, wid = F.wave, lane = F.lane, r32 = lane & 31, hi = lane >> 5;
    const int rg = wid < 4 ? wid : 11 - wid;
    const int b = bh >> 2, hh = bh & 3, t0 = c * MCH; const size_t rb = (size_t)b * SEQ;
    LAS char* lds = (LAS char*)F.lds; LAS char* Kimg = lds; LAS char* Vimg = lds + 4 * SHM_T; LAS char* Cimg = lds + 4 * SHM_T; LAS float* nref = (LAS float*)(lds + 6 * SHM_T);
    LAS float* ws = (LAS float*)(lds + WSCR_OFF) + wid * 128; LAS float* f_l = ws; LAS float* rn_l = ws + 32;
    const bf16* MLQ = WSP(bf16, WS_PROJ) + 3 * PROJ_STRIDE; const bf16* MLK = MLQ + PROJ_STRIDE; const bf16* MLV = MLQ + 2 * PROJ_STRIDE; const bf16* MLO = MLQ + 3 * PROJ_STRIDE;
    const float* A2 = WSP(float, WS_A2) + (size_t)bh * SEQ; const float* M2 = WSP(float, WS_M2) + (size_t)bh * SEQ; const float* NB2 = WSP(float, WS_NB2) + (size_t)bh * SEQ;
    const int trow = t0 + 32 * rg + r32;
    const float m2t = M2[trow], nb2t = NB2[trow];
    const float mref2 = (c > 0) ? M2[t0 - 1] : -1e30f;
    { const int cg = tid & 15; f32x4 cw[4][2], cb[2]; load_convw(F.in[3], F.in[4], hh * 128 + cg * 8, cw, cb);
#pragma unroll 4
      for (int i = 0; i < 8; ++i) { const int row = (tid >> 4) + 32 * i; float y[8];
          conv8(MLQ, rb, t0 + row, hh * 128 + cg * 8, cw, cb, 1.0f, y);
          *(LAS bf16x8*)(Kimg + (row >> 6) * SHM_T + KSWZ(row & 63, cg * 16)) = pack8(y); } }
    __syncthreads();
    bf16x8 qr[8];
    { const int row = 32 * rg + r32;
#pragma unroll
      for (int d0 = 0; d0 < 8; ++d0) qr[d0] = *(const LAS bf16x8*)(Kimg + (row >> 6) * SHM_T + KSWZ(row & 63, (d0 * 16 + hi * 8) * 2)); }
    f32x16 o[4] = {}; float den = 0.f;
    if (c > 0) {
        const float* ML = WSP(float, WS_MLOC) + bh * NCH; const bf16* DCT = WSP(bf16, WS_DCT) + ((size_t)(bh * NCH) << 14); const float* DN = WSP(float, WS_DN) + (size_t)(bh * NCH) * 128;
        { const int dv = tid >> 2, dk0 = (tid & 3) * 32; f32x4 a[8];
#pragma unroll
          for (int i = 0; i < 8; ++i) a[i] = (f32x4){0.f, 0.f, 0.f, 0.f};
          for (int cp = 0; cp < c; cp += 4) {
              float cf[4]; const bf16x8* sp[4];
#pragma unroll
              for (int u = 0; u < 4; ++u) { const int cq = cp + u < c ? cp + u : cp; cf[u] = cp + u < c ? __builtin_amdgcn_exp2f(ML[cq] - mref2) : 0.f; sp[u] = (const bf16x8*)(DCT + ((size_t)cq << 14) + dv * 128 + dk0); }
              bf16x8 u0[4], u1[4], u2[4], u3[4];
#pragma unroll
              for (int i = 0; i < 4; ++i) { u0[i] = sp[0][i]; u1[i] = sp[1][i]; u2[i] = sp[2][i]; u3[i] = sp[3][i]; }
#pragma unroll
              for (int i = 0; i < 4; ++i)
#pragma unroll
                  for (int e = 0; e < 8; ++e) a[2 * i + (e >> 2)][e & 3] += (bf2f((unsigned short)u0[i][e]) * cf[0] + bf2f((unsigned short)u1[i][e]) * cf[1]) + (bf2f((unsigned short)u2[i][e]) * cf[2] + bf2f((unsigned short)u3[i][e]) * cf[3]); }
#pragma unroll
          for (int i = 0; i < 4; ++i) { u32x4 w = {cvtpk(a[2 * i][0], a[2 * i][1]), cvtpk(a[2 * i][2], a[2 * i][3]), cvtpk(a[2 * i + 1][0], a[2 * i + 1][1]), cvtpk(a[2 * i + 1][2], a[2 * i + 1][3])};
              *(LAS u32x4*)(Cimg + KSWZ(dv, (dk0 + 8 * i) * 2)) = w; }
          if (tid < 128) { float s = 0.f; for (int cp = 0; cp < c; ++cp) s += DN[cp * 128 + tid] * __builtin_amdgcn_exp2f(ML[cp] - mref2); nref[tid] = s; } }
        __syncthreads();
#pragma unroll
        for (int d = 0; d < 4; ++d)
#pragma unroll
            for (int ks = 0; ks < 8; ++ks) { const bf16x8 cf = *(const LAS bf16x8*)(Cimg + KSWZ(32 * d + r32, (16 * ks + 8 * hi) * 2)); o[d] = MFMA32(qr[ks], cf, o[d]); }
        float dn = 0.f;
#pragma unroll
        for (int ks = 0; ks < 8; ++ks) { const f32x4 n0 = *(const LAS f32x4*)(nref + 16 * ks + 8 * hi), n1 = *(const LAS f32x4*)(nref + 16 * ks + 8 * hi + 4);
#pragma unroll
            for (int j = 0; j < 4; ++j) { dn += bf2f((unsigned short)qr[ks][j]) * n0[j]; dn += bf2f((unsigned short)qr[ks][4 + j]) * n1[j]; } }
        dn = half_swap_add(dn);
        const float ft = __builtin_amdgcn_exp2f(mref2 - m2t);
        den = ft * dn;
        if (hi == 0) f_l[r32] = ft; asm volatile("s_waitcnt lgkmcnt(0)" ::: "memory");
#pragma unroll
        for (int d = 0; d < 4; ++d)
#pragma unroll
            for (int r = 0; r < 16; ++r) o[d][r] *= f_l[crow(r, hi)];
        __syncthreads();
    }
    __syncthreads();
    { const int cg = tid & 15; f32x4 cw[4][2], cb[2]; load_convw(F.in[3], F.in[4], 512 + hh * 128 + cg * 8, cw, cb);
#pragma unroll 2
      for (int i = 0; i < 8; ++i) { const int row = (tid >> 4) + 32 * i, t = t0 + row; float y[8];
          conv8(MLK, rb, t, hh * 128 + cg * 8, cw, cb, MLK_SCALE, y);
          *(LAS bf16x8*)(Kimg + (row >> 6) * SHM_T + KSWZ(row & 63, cg * 16)) = pack8(y);
          *(LAS bf16x8*)(Vimg + (row >> 6) * SHM_T + v_st(row & 63, cg * 8)) = *(const bf16x8*)(MLV + (rb + t) * PW + hh * 128 + cg * 8); } }
    __syncthreads();
    bf16x8 qx = {0, 0, 0, 0, 0, 0, 0, 0};
    if (hi == 0) { short a, bq, cq; split3(-m2t, a, bq, cq); qx[0] = 0x3F80; qx[1] = 0x3F80; qx[2] = 0x3F80; qx[3] = a; qx[4] = bq; qx[5] = cq; }
    const int ntile = (rg >> 1) + 1;
    for (int jt = 0; jt < ntile; ++jt) {
        const LAS char* Ks = Kimg + jt * SHM_T;
        bf16x8 kx0 = {0, 0, 0, 0, 0, 0, 0, 0}, kx1 = kx0;
        if (hi == 0) { short a, bq, cq; split3(A2[t0 + 64 * jt + r32], a, bq, cq); kx0[0] = a; kx0[1] = bq; kx0[2] = cq; kx0[3] = 0x3F80; kx0[4] = 0x3F80; kx0[5] = 0x3F80;
                       split3(A2[t0 + 64 * jt + 32 + r32], a, bq, cq); kx1[0] = a; kx1[1] = bq; kx1[2] = cq; kx1[3] = 0x3F80; kx1[4] = 0x3F80; kx1[5] = 0x3F80; }
        f32x16 e0 = MFMA32(kx0, qx, f32x16{}), e1 = MFMA32(kx1, qx, f32x16{});
        f32x16 p0 = {}, p1 = {};
#pragma unroll
        for (int d0 = 0; d0 < 8; ++d0) { const int cbb = (d0 * 16 + hi * 8) * 2;
            const bf16x8 b0 = *(const LAS bf16x8*)(Ks + KSWZ(r32, cbb)); const bf16x8 b1 = *(const LAS bf16x8*)(Ks + KSWZ(32 + r32, cbb));
            p0 = MFMA32(b0, qr[d0], p0); p1 = MFMA32(b1, qr[d0], p1); }
        const bool diag = (jt == ntile - 1); const int qrel = 32 * rg + r32 - 64 * jt;
        float ps = 0.f;
#pragma unroll
        for (int r = 0; r < 16; ++r) { const int kv = crow(r, hi);
            float v0 = p0[r] * __builtin_amdgcn_exp2f(fminf(e0[r], 0.f)), v1 = p1[r] * __builtin_amdgcn_exp2f(fminf(e1[r], 0.f));
            if (diag) { if (kv > qrel) v0 = 0.f; if (kv + 32 > qrel) v1 = 0.f; }
            p0[r] = v0; p1[r] = v1; ps += v0 + v1; }
        den += half_swap_add(ps);
        bf16x8 pa0, pa1, pa2, pa3; pack_p(p0, p1, pa0, pa1, pa2, pa3);
        pv_d0(o, (int)(uintptr_t)(Vimg + jt * SHM_T) + v_rd_base(lane), pa0, pa1, pa2, pa3);
    }
    { const float nrm = fmaxf(fabsf(den), __builtin_amdgcn_exp2f(nb2t));
      if (hi == 0) rn_l[r32] = 1.0f / nrm; asm volatile("s_waitcnt lgkmcnt(0)" ::: "memory"); }
    const float* gml = F.in[12] + hh * 128;
    float ssq[16];
#pragma unroll
    for (int r = 0; r < 16; ++r) { const float rn = rn_l[crow(r, hi)]; float s = 0.f;
#pragma unroll
        for (int d = 0; d < 4; ++d) { o[d][r] *= rn; s += o[d][r] * o[d][r]; }
        ssq[r] = s; }
#pragma unroll
    for (int r = 0; r < 16; ++r) ssq[r] = 1.0f / sqrtf(half_sum32(ssq[r]) * (1.f / 128.f) + NORM_EPS);
    __syncthreads();
    bf16* MIX = WSP(bf16, WS_H1) + (rb + t0 + 32 * rg) * DM + 512 + hh * 128;
    const bf16* Og = MLO + (rb + t0 + 32 * rg) * PW + hh * 128;
    store_rows(o, ssq, gml, (LAS float*)lds + wid * 4096, MIX, DM, Og, PW, lane);
    __syncthreads();
}
}

namespace peer {
using att::f32x16; using att::crow;
__device__ __forceinline__ unsigned ordf(float f) { const unsigned u = __float_as_uint(f); return u ^ ((u >> 31) ? 0xFFFFFFFFu : 0x80000000u); }
__device__ __forceinline__ float unordf(unsigned k) { return __uint_as_float(k ^ ((k >> 31) ? 0x80000000u : 0xFFFFFFFFu)); }
#define CAS_D(a, b) do { const unsigned _x = (a) > (b) ? (a) : (b), _n = (a) > (b) ? (b) : (a); (a) = _x; (b) = _n; } while (0)
struct SortNet { unsigned char a[63], b[63]; };
constexpr SortNet make_sortnet() { SortNet s{}; const int p[63][2] = {{0,1},{2,3},{0,2},{1,3},{1,2},{4,5},{6,7},{4,6},{5,7},{5,6},{0,4},{2,6},{2,4},{1,5},{3,7},{3,5},{1,2},{3,4},{5,6},{8,9},{10,11},{8,10},{9,11},{9,10},{12,13},{14,15},{12,14},{13,15},{13,14},{8,12},{10,14},{10,12},{9,13},{11,15},{11,13},{9,10},{11,12},{13,14},{0,8},{4,12},{4,8},{2,10},{6,14},{6,10},{2,4},{6,8},{10,12},{1,9},{5,13},{5,9},{3,11},{7,15},{7,11},{3,5},{7,9},{11,13},{1,2},{3,4},{5,6},{7,8},{9,10},{11,12},{13,14}}; for (int i = 0; i < 63; ++i) { s.a[i] = (unsigned char)p[i][0]; s.b[i] = (unsigned char)p[i][1]; } return s; }
constexpr SortNet SORTNET = make_sortnet();
template <bool DESC> __device__ __forceinline__ void bsort16(unsigned (&v)[16]) {
#pragma unroll
    for (int c = 0; c < 63; ++c) { const int i = SORTNET.a[c], j = SORTNET.b[c]; if (DESC) CAS_D(v[i], v[j]); else CAS_D(v[j], v[i]); }
}
__device__ __forceinline__ void bmerge16_desc(unsigned (&v)[16]) {
#pragma unroll
    for (int j = 8; j > 0; j >>= 1)
#pragma unroll
        for (int i = 0; i < 16; ++i) { const int l = i ^ j; if (l > i) CAS_D(v[i], v[l]); }
}
__device__ __forceinline__ void merge_in(unsigned (&T)[16], unsigned (&N)[16]) {
    bsort16<false>(N);
#pragma unroll
    for (int i = 0; i < 16; ++i) T[i] = T[i] > N[i] ? T[i] : N[i];
    bmerge16_desc(T);
}
__device__ __forceinline__ void top16_of_tile(const f32x16 (&acc)[4], int hi, unsigned (&T)[16]) {
    unsigned N[16];
#pragma unroll
    for (int r = 0; r < 16; ++r) T[r] = (ordf(acc[0][r]) & ~0x7Fu) | (unsigned)(crow(r, hi));
    bsort16<true>(T);
#pragma unroll
    for (int mt = 1; mt < 4; ++mt) {
#pragma unroll
        for (int r = 0; r < 16; ++r) N[r] = (ordf(acc[mt][r]) & ~0x7Fu) | (unsigned)(32 * mt + crow(r, hi));
        merge_in(T, N); }
#pragma unroll
    for (int i = 0; i < 16; ++i) N[i] = (unsigned)__shfl_xor((int)T[15 - i], 32);
#pragma unroll
    for (int i = 0; i < 16; ++i) T[i] = T[i] > N[i] ? T[i] : N[i];
    bmerge16_desc(T);
}
struct CandTab { unsigned char ij[64]; };
constexpr CandTab make_cands() { CandTab t{}; int n = 0; for (int i = 0; i < 16; ++i) for (int j = i; j < 16; ++j) if ((i + 1) * (j + 1) <= 16) t.ij[n++] = (unsigned char)(i * 16 + j); for (; n < 64; ++n) t.ij[n] = 255; return t; }
constexpr CandTab CANDS = make_cands();

__device__ __forceinline__ void peer_topk_phase(Frame& F) {
    const int tid = F.tid, wid = F.wave, lane = F.lane, r32 = lane & 31, hi = lane >> 5;
    const int h = F.vcu & 7, bq = F.vcu >> 3, nbq = F.G >> 3;
    LAS char* lds = (LAS char*)F.lds;
    const bf16* SK = WSP(bf16, WS_SUBK) + (size_t)h * 2 * 128 * 128;
    { bf16x8 t[8];
#pragma unroll
      for (int u = 0; u < 8; ++u) { const int i = tid + u * NTHR; const int cc = i >> 11, r = (i >> 4) & 127, ch = i & 15; t[u] = *(const bf16x8*)(SK + (size_t)cc * 16384 + r * 128 + ch * 8); }
#pragma unroll
      for (int u = 0; u < 8; ++u) { const int i = tid + u * NTHR; const int cc = i >> 11, r = (i >> 4) & 127, ch = i & 15; *(LAS bf16x8*)(lds + cc * 32768 + KSWZ(r, ch * 16)) = t[u]; } }
    __syncthreads();
    const bf16* QP = (h < 4) ? WSP(bf16, WS_H1) + h * 256 : WSP(bf16, WS_QPB) + (h - 4) * 256;
    LAS unsigned char* ixs = (LAS unsigned char*)(lds + XTRA_OFF) + tid * 32;
    unsigned long long* PE = WSP(unsigned long long, WS_PE);
    for (int tg = bq * NWAVES + wid; tg < M / 32; tg += nbq * NWAVES) {
        const int tok = tg * 32 + r32;
        unsigned T1[16], T2[16];
#pragma unroll
        for (int cc = 0; cc < 2; ++cc) {
            bf16x8 qf[8];
#pragma unroll
            for (int ks = 0; ks < 8; ++ks) qf[ks] = *(const bf16x8*)(QP + (size_t)tok * DM + cc * 128 + 16 * ks + 8 * hi);
            f32x16 acc[4];
#pragma unroll
            for (int mt = 0; mt < 4; ++mt) { acc[mt] = f32x16{};
#pragma unroll
                for (int ks = 0; ks < 8; ++ks) { const bf16x8 af = *(const LAS bf16x8*)(lds + cc * 32768 + KSWZ(32 * mt + r32, (16 * ks + 8 * hi) * 2)); acc[mt] = MFMA32(af, qf[ks], acc[mt]); } }
            if (cc == 0) top16_of_tile(acc, hi, T1); else top16_of_tile(acc, hi, T2);
        }
        { v4u w1, w2;
#pragma unroll
          for (int q = 0; q < 4; ++q) { w1[q] = (T1[4 * q] & 0x7F) | ((T1[4 * q + 1] & 0x7F) << 8) | ((T1[4 * q + 2] & 0x7F) << 16) | ((T1[4 * q + 3] & 0x7F) << 24);
                                        w2[q] = (T2[4 * q] & 0x7F) | ((T2[4 * q + 1] & 0x7F) << 8) | ((T2[4 * q + 2] & 0x7F) << 16) | ((T2[4 * q + 3] & 0x7F) << 24); }
          *(LAS v4u*)ixs = w1; *(LAS v4u*)(ixs + 16) = w2; }
        float s1[16], s2[16];
#pragma unroll
        for (int i = 0; i < 16; ++i) { s1[i] = unordf(T1[i] & ~0x7Fu); s2[i] = unordf(T2[i] & ~0x7Fu); }
        unsigned R[16], N[16];
        float sa[16], sb[16];
#pragma unroll
        for (int i = 0; i < 16; ++i) { sa[i] = hi ? s2[i] : s1[i]; sb[i] = hi ? s1[i] : s2[i]; }
#pragma unroll
        for (int ch = 0; ch < 2; ++ch) {
#pragma unroll
            for (int q = 0; q < 16; ++q) { const int ij = CANDS.ij[ch * 16 + q]; const int ii = (ij >> 4) & 15, jj = ij & 15;
                const unsigned code = hi ? (unsigned)(jj * 16 + ii) : (unsigned)ij;
                unsigned kk = (ij == 255 || (ii == jj && hi)) ? 0u : ((ordf(sa[ii] + sb[jj]) & ~0xFFu) | code);
                if (ch == 0) R[q] = kk; else N[q] = kk; }
            if (ch == 0) bsort16<true>(R); else merge_in(R, N); }
#pragma unroll
        for (int i = 0; i < 16; ++i) N[i] = (unsigned)__shfl_xor((int)R[15 - i], 32);
#pragma unroll
        for (int i = 0; i < 16; ++i) R[i] = R[i] > N[i] ? R[i] : N[i];
        bmerge16_desc(R);
        asm volatile("s_waitcnt lgkmcnt(0)" ::: "memory");
        const float mx = unordf(R[0] & ~0xFFu); float ev[16], es = 0.f;
#pragma unroll
        for (int k = 0; k < 16; ++k) { ev[k] = __expf(unordf(R[k] & ~0xFFu) - mx); es += ev[k]; }
        const float inv = 1.0f / es;
        if (hi == 0) {
#pragma unroll
            for (int k = 0; k < 16; k += 2) { v4u w;
                w[0] = (unsigned)ixs[(R[k] >> 4) & 15] * 128u + (unsigned)ixs[16 + (R[k] & 15)]; w[1] = __float_as_uint(ev[k] * inv);
                w[2] = (unsigned)ixs[(R[k + 1] >> 4) & 15] * 128u + (unsigned)ixs[16 + (R[k + 1] & 15)]; w[3] = __float_as_uint(ev[k + 1] * inv);
                *(v4u*)(PE + (size_t)tok * 128 + h * 16 + k) = w; }
        }
    }
    __syncthreads();
}

__device__ __forceinline__ float gelu_erf(float a) { return 0.5f * a * (1.0f + erff(a * 0.70710678118654752f)); }
typedef float f32x2g __attribute__((ext_vector_type(2)));
typedef __bf16 bf16x2_t __attribute__((ext_vector_type(2)));
__device__ __forceinline__ bf16x2_t asbf2(unsigned v) { return __builtin_bit_cast(bf16x2_t, v); }
__device__ __forceinline__ float reduce4(const float (&d)[4]) {
    float s[2];
#pragma unroll
    for (int k = 0; k < 2; ++k) { auto r = __builtin_amdgcn_permlane32_swap(__float_as_uint(d[k]), __float_as_uint(d[k + 2]), false, false); s[k] = __uint_as_float(r[0]) + __uint_as_float(r[1]); }
    auto r2 = __builtin_amdgcn_permlane16_swap(__float_as_uint(s[0]), __float_as_uint(s[1]), false, false);
    float r = __uint_as_float(r2[0]) + __uint_as_float(r2[1]);
    r += dppf<0xB1>(r); r += dppf<0x4E>(r); r += dppf<0x141>(r); r += dppf<0x128>(r);
    return r;
}
#define PG_GSH 11
#define PG_NGRP (16384 >> PG_GSH)
__device__ __forceinline__ void peer_gather_phase(Frame& F) {
    const int lane = F.lane, wid = F.wave; const int gw = F.vcu * NWAVES + wid;
    LAS char* lds = (LAS char*)F.lds;
    const float* X1 = WSP(float, WS_X1); const bf16* X1B = WSP(bf16, WS_X1B); const float* SSP = WSP(float, WS_SSP);
    const unsigned char* U8 = WSP(unsigned char, WS_UB); const unsigned char* V8 = WSP(unsigned char, WS_VB);
    const unsigned long long* PE = WSP(unsigned long long, WS_PE); const float* fg = F.in[19];
    LAS unsigned long long* LIST = (LAS unsigned long long*)(lds + 65536) + wid * 1024;
    float* WL = WSP(float, WS_WL) + (size_t)gw * 1024;
    const int tok0 = gw * 8;
    LAS float* rstd_l = (LAS float*)(lds + XTRA_OFF) + wid * 8;
    LAS unsigned* wmax_l = (LAS unsigned*)(lds + XTRA_OFF + 512) + wid * 8;
    if (lane < 8) wmax_l[lane] = 0u;
    LAS unsigned* bstart = (LAS unsigned*)(lds + XTRA_OFF + 1024) + wid * 256; LAS unsigned* bend = bstart + 128;
#pragma unroll
    for (int j = 0; j < 8; ++j) { const bf16x8* src = (const bf16x8*)(X1B + (size_t)(tok0 + j) * DM); const bf16x8 a = src[2 * lane], b = src[2 * lane + 1];
        float xf[16]; float mx = 0.f;
#pragma unroll
        for (int e = 0; e < 8; ++e) { xf[e] = bf2f((unsigned short)a[e]); xf[8 + e] = bf2f((unsigned short)b[e]); mx = fmaxf(mx, fmaxf(fabsf(xf[e]), fabsf(xf[8 + e]))); }
        mx = wave_max(mx); const float sx = mx > 0.f ? mx * (1.0f / 127.0f) : 1.0f, inv = 1.0f / sx;
        v4u o;
#pragma unroll
        for (int q = 0; q < 4; ++q) { const int q0 = (int)rintf(xf[4 * q] * inv), q1 = (int)rintf(xf[4 * q + 1] * inv), q2 = (int)rintf(xf[4 * q + 2] * inv), q3 = (int)rintf(xf[4 * q + 3] * inv);
            o[q] = (unsigned)(q0 & 255) | ((unsigned)(q1 & 255) << 8) | ((unsigned)(q2 & 255) << 16) | ((unsigned)q3 << 24); }
        *(LAS v4u*)(lds + (wid * 8 + j) * 1024 + lane * 16) = o;
        if (lane == 0) { const f32x4* sp = (const f32x4*)(SSP + (size_t)(tok0 + j) * 16); const f32x4 sa = sp[0], sb = sp[1], sc = sp[2], sd = sp[3];
            const float s = ((sa[0] + sa[1]) + (sa[2] + sa[3])) + ((sb[0] + sb[1]) + (sb[2] + sb[3])) + ((sc[0] + sc[1]) + (sc[2] + sc[3])) + ((sd[0] + sd[1]) + (sd[2] + sd[3]));
            rstd_l[j] = sx / sqrtf(s * (1.0f / 1024.0f) + NORM_EPS); } }
    bstart[lane] = 0u; bstart[64 + lane] = 0u;
    { v4u ent[8]; const unsigned ts = (unsigned)(lane >> 3);
      { const v4u* pe = (const v4u*)(PE + (size_t)(tok0 + (lane >> 3)) * 128 + (lane & 7) * 16);
#pragma unroll
        for (int i = 0; i < 8; ++i) ent[i] = pe[i]; }
#pragma unroll
      for (int i = 0; i < 8; ++i) { __hip_atomic_fetch_add(bstart + ((ent[i][0] >> PG_GSH) * 8 + ts), 1u, __ATOMIC_RELAXED, __HIP_MEMORY_SCOPE_WORKGROUP); __hip_atomic_fetch_add(bstart + ((ent[i][2] >> PG_GSH) * 8 + ts), 1u, __ATOMIC_RELAXED, __HIP_MEMORY_SCOPE_WORKGROUP); }
      { const unsigned c0 = bstart[2 * lane], c1 = bstart[2 * lane + 1]; unsigned inc = c0 + c1;
#pragma unroll
        for (int o = 1; o < 64; o <<= 1) { const unsigned u = (unsigned)__shfl_up((int)inc, o); if (lane >= o) inc += u; }
        const unsigned b0 = inc - (c0 + c1); bstart[2 * lane] = b0; bstart[2 * lane + 1] = b0 + c0; bend[2 * lane] = b0; bend[2 * lane + 1] = b0 + c0; }
#pragma unroll
      for (int i = 0; i < 8; ++i) {
          const unsigned p0 = __hip_atomic_fetch_add(bend + ((ent[i][0] >> PG_GSH) * 8 + ts), 1u, __ATOMIC_RELAXED, __HIP_MEMORY_SCOPE_WORKGROUP);
          LIST[p0] = (unsigned long long)(ent[i][0] | (ts << 16)) | ((unsigned long long)ent[i][1] << 32);
          const unsigned p1 = __hip_atomic_fetch_add(bend + ((ent[i][2] >> PG_GSH) * 8 + ts), 1u, __ATOMIC_RELAXED, __HIP_MEMORY_SCOPE_WORKGROUP);
          LIST[p1] = (unsigned long long)(ent[i][2] | (ts << 16)) | ((unsigned long long)ent[i][3] << 32); } }
    asm volatile("s_waitcnt vmcnt(0)" ::: "memory");
    __syncthreads();
#define PG_ISSUE(dst, TAB, r) do { _Pragma("unroll") for (int k = 0; k < 8; ++k) { const unsigned ei = (unsigned)__builtin_amdgcn_readlane((int)(unsigned)(r), k) & 0xFFFFu; dst[k] = *(const v4u*)(TAB + (size_t)ei * DM + 16 * lane); } } while (0)
#ifndef PG_NO_U
    {
        const float* SU = WSP(float, WS_SU);
        const LAS char* xw = lds + wid * 8 * 1024 + lane * 16;
        unsigned long long rA = LIST[lane & 7]; float sA = SU[(unsigned)rA & 0xFFFFu], vA = SU[NEXP + ((unsigned)rA & 0xFFFFu)];
        v4u ur[8];
        PG_ISSUE(ur, U8, rA);
        for (int b = 0; b < 128; ++b) {
            unsigned long long nA = rA; float nS = sA, nV = vA; if (b + 1 < 128) { nA = LIST[(b + 1) * 8 + (lane & 7)]; nS = SU[(unsigned)nA & 0xFFFFu]; nV = SU[NEXP + ((unsigned)nA & 0xFFFFu)]; }
            float d[8];
#pragma unroll
            for (int k = 0; k < 8; ++k) { const int tk = (int)(((unsigned)__builtin_amdgcn_readlane((int)(unsigned)rA, k) >> 16) & 7u);
                const v4u x = *(const LAS v4u*)(xw + tk * 1024);
                const int s0_ = __builtin_amdgcn_sdot4((int)ur[k][1], (int)x[1], __builtin_amdgcn_sdot4((int)ur[k][0], (int)x[0], 0, false), false);
                const int s1_ = __builtin_amdgcn_sdot4((int)ur[k][3], (int)x[3], __builtin_amdgcn_sdot4((int)ur[k][2], (int)x[2], 0, false), false);
                d[k] = (float)(s0_ + s1_); }
            if (b + 1 < 128) PG_ISSUE(ur, U8, nA);
            const float tot = reduce8(d, lane);
            const unsigned long long mine = __shfl((long long)rA, lane >> 3);
            const float sum = __shfl(sA, lane >> 3), svm = __shfl(vA, lane >> 3); const unsigned tsl = ((unsigned)mine >> 16) & 7u;
            const float w = __uint_as_float((unsigned)(mine >> 32)) * gelu_erf(tot * sum * rstd_l[tsl]) * svm;
            if ((lane & 7) == 0) { WL[b * 8 + (lane >> 3)] = w; __hip_atomic_fetch_max(wmax_l + tsl, __float_as_uint(fabsf(w)), __ATOMIC_RELAXED, __HIP_MEMORY_SCOPE_WORKGROUP); }
            rA = nA; sA = nS; vA = nV;
        }
    }
#endif
    asm volatile("s_waitcnt vmcnt(0)" ::: "memory");
    int acc[8][16];
#pragma unroll
    for (int j = 0; j < 8; ++j)
#pragma unroll
        for (int q = 0; q < 16; ++q) acc[j][q] = 0;
    asm volatile("s_waitcnt lgkmcnt(0)" ::: "memory");
#define PVB 8
    unsigned mrr = (unsigned)LIST[lane & 15]; float mww = WL[lane & 15]; int mpos = 0;
#define PG_RUN(j) { const int rs_ = (int)bstart[g * 8 + j], re_ = (int)bend[g * 8 + j]; const float wm_ = __uint_as_float(wmax_l[j]); const float qs_ = wm_ > 0.f ? 127.0f / wm_ : 0.f; \
        for (int pos = rs_; pos < re_; ) { const int nv = re_ - pos < PVB ? re_ - pos : PVB; \
            if (mpos != pos) { const int ix_ = pos + (lane & 15) < 1024 ? pos + (lane & 15) : 1023; mrr = (unsigned)LIST[ix_]; mww = WL[ix_]; mpos = pos; } \
            v4u vr[PVB]; \
            _Pragma("unroll") for (int k = 0; k < PVB; ++k) { const unsigned e0_ = (unsigned)__builtin_amdgcn_readlane((int)mrr, 0), ek_ = (unsigned)__builtin_amdgcn_readlane((int)mrr, k); \
                const unsigned ei = (k < nv ? ek_ : e0_) & 0xFFFFu; vr[k] = *(const v4u*)(V8 + (size_t)ei * DM + 16 * lane); }     \
            const int wq_ = ((lane & 15) < nv ? (int)rintf(mww * qs_) : 0) & 255;                         \
            { const int np_ = pos + nv; const int ix_ = np_ + (lane & 15) < 1024 ? np_ + (lane & 15) : 1023; mrr = (unsigned)LIST[ix_]; mww = WL[ix_]; mpos = np_; } \
            _Pragma("unroll") for (int gq = 0; gq < PVB / 4; ++gq) { \
                const int w4_ = __builtin_amdgcn_readlane(wq_, 4 * gq) | (__builtin_amdgcn_readlane(wq_, 4 * gq + 1) << 8) | (__builtin_amdgcn_readlane(wq_, 4 * gq + 2) << 16) | (__builtin_amdgcn_readlane(wq_, 4 * gq + 3) << 24); \
                _Pragma("unroll") for (int q = 0; q < 4; ++q) { const unsigned r0 = vr[4 * gq][q], r1 = vr[4 * gq + 1][q], r2 = vr[4 * gq + 2][q], r3 = vr[4 * gq + 3][q]; \
                    const unsigned t0 = __builtin_amdgcn_perm(r1, r0, 0x05010400u), t1 = __builtin_amdgcn_perm(r1, r0, 0x07030602u), t2 = __builtin_amdgcn_perm(r3, r2, 0x05010400u), t3 = __builtin_amdgcn_perm(r3, r2, 0x07030602u); \
                    acc[j][4 * q + 0] = __builtin_amdgcn_sdot4((int)__builtin_amdgcn_perm(t2, t0, 0x05040100u), w4_, acc[j][4 * q + 0], false); \
                    acc[j][4 * q + 1] = __builtin_amdgcn_sdot4((int)__builtin_amdgcn_perm(t2, t0, 0x07060302u), w4_, acc[j][4 * q + 1], false); \
                    acc[j][4 * q + 2] = __builtin_amdgcn_sdot4((int)__builtin_amdgcn_perm(t3, t1, 0x05040100u), w4_, acc[j][4 * q + 2], false); \
                    acc[j][4 * q + 3] = __builtin_amdgcn_sdot4((int)__builtin_amdgcn_perm(t3, t1, 0x07060302u), w4_, acc[j][4 * q + 3], false); } } \
            pos += nv; } }
#ifndef PG_NO_V
    for (int g = 0; g < PG_NGRP; ++g) { PG_RUN(0) PG_RUN(1) PG_RUN(2) PG_RUN(3) PG_RUN(4) PG_RUN(5) PG_RUN(6) PG_RUN(7) }
#endif
#undef PG_RUN
#undef PG_ISSUE
    int tb = tok0; asm volatile("" : "+s"(tb));
    f32x4 fgv[4];
    { const f32x4* gp = (const f32x4*)(fg + 16 * lane);
#pragma unroll
      for (int q = 0; q < 4; ++q) fgv[q] = gp[q]; }
    bf16x8 nxa, nxb;
    { const bf16x8* xp = (const bf16x8*)(X1B + (size_t)tb * DM + 16 * lane); nxa = xp[0]; nxb = xp[1]; }
#pragma unroll
    for (int j = 0; j < 8; ++j) { const int t = tb + j;
        const bf16x8 xa = nxa, xb = nxb; const float os = __uint_as_float(wmax_l[j]) * (1.0f / 127.0f);
        if (j + 1 < 8) { const bf16x8* xp = (const bf16x8*)(X1B + (size_t)(t + 1) * DM + 16 * lane); nxa = xp[0]; nxb = xp[1]; }
        float s = 0.f; f32x4 y[4];
#pragma unroll
        for (int q = 0; q < 4; ++q) { const bf16x8 xs = q < 2 ? xa : xb; const int o = 4 * (q & 1);
            y[q] = (f32x4){bf2f((unsigned short)xs[o]) + (float)acc[j][4 * q] * os, bf2f((unsigned short)xs[o + 1]) + (float)acc[j][4 * q + 1] * os, bf2f((unsigned short)xs[o + 2]) + (float)acc[j][4 * q + 2] * os, bf2f((unsigned short)xs[o + 3]) + (float)acc[j][4 * q + 3] * os};
            s += (y[q][0] * y[q][0] + y[q][1] * y[q][1]) + (y[q][2] * y[q][2] + y[q][3] * y[q][3]); }
        const float rs = 1.0f / sqrtf(wave_sum(s) * (1.0f / 1024.0f) + NORM_EPS);
        f32x4* op = (f32x4*)(F.out + (size_t)t * DM + 16 * lane);
#pragma unroll
        for (int q = 0; q < 4; ++q) op[q] = y[q] * rs * fgv[q];
        asm volatile("" ::: "memory"); }
}
}


#ifndef MK_N_LAUNCHES
#define MK_N_LAUNCHES 1
#endif
constexpr int N_PHASES = 8;
struct Args { const float* in[20]; float* out; unsigned char* ws; int ph_lo, ph_hi; };

__global__ void __launch_bounds__(NTHR, 2) mega_fwd(Args args) {
    extern __shared__ __attribute__((aligned(16))) unsigned char lds_raw[];
    Frame F;
    F.lds = (LAS unsigned char*)lds_raw; F.ldsg = lds_raw;
    F.MISC = (volatile LAS unsigned*)(F.lds + MISC_OFF);
    F.tid = threadIdx.x; F.lane = F.tid & 63; F.wave = __builtin_amdgcn_readfirstlane(F.tid >> 6);
    F.G = gridDim.x; { const int bx = blockIdx.x; F.vcu = (F.G % 8 == 0) ? (bx % 8) * (F.G / 8) + bx / 8 : bx; }
#pragma unroll
    for (int i = 0; i < 20; ++i) F.in[i] = args.in[i];
    F.out = args.out; F.ws = args.ws; F.ctl = (gu32*)(args.ws + WS_CTL);
    for (int u = F.tid; u < 512 / 4; u += NTHR) ((LAS unsigned*)(F.lds + MISC_OFF))[u] = 0u;
    __syncthreads();
    const int lo = args.ph_lo, hi = args.ph_hi;
    const bool one = (hi - lo) > 1;
    XcdBarrier bar; bar.bar = (unsigned*)(F.ctl + CW_BAR); bar.x = 0; bar.st = nullptr;
    if (one) bar = xcd_barrier_post((unsigned*)(F.ctl + CW_BAR), F.MISC + 8);
#ifndef PH_MASK
#define PH_MASK 0xFF
#endif
#define IN(k) ((((PH_MASK) >> (k)) & 1) && lo <= (k) && (k) < hi)
#define SEAM(k) do { if (IN(k) && IN((k) + 1)) xcd_barrier(bar); } while (0)
#ifndef REP_PHASE
#define REP_PHASE -1
#endif
#define REPS(k) for (int rep_ = 0; rep_ < ((k) == REP_PHASE ? 2 : 1); ++rep_, ((k) == REP_PHASE && rep_ == 1 ? xcd_barrier(bar) : (void)0))

    if (IN(0)) REPS(0) { p0_prologue(F); } SEAM(0);

    if (IN(1)) REPS(1) {
        pg8::Gemm g{WSP(bf16, WS_H1), WSP(bf16, WS_WIN), M, NPROJ, DM}; pg8::StaticOrder S; S.init(M, NPROJ, F.G, (int)blockIdx.x);
        pg8::EpiBf16S E{WSP(bf16, WS_PROJ), PW, PW, PROJ_STRIDE, QSCALE, nullptr, 0.f};
        pg8::gemm_phase<pg8::EpiBf16S, pg8::StaticOrder, true, true>(F.lds, g, S, E);
        const int sb = (int)blockIdx.x - (F.G - 16);
        if (sb >= 0 && sb < 16 && F.wave == 0) gate_scan(F, sb);
        if ((int)blockIdx.x >= F.G / 2) cvt_peer_tables(F, 2);
    } SEAM(1);

    if (IN(2)) REPS(2) {
        const float lam = __expf(wave_sum(F.in[7][F.lane] * F.in[8][F.lane])) - __expf(wave_sum(F.in[9][F.lane] * F.in[10][F.lane])) + LAM_INIT;
#ifdef DATT_QUEUE
        for (;;) {
            if (F.tid == 0) F.MISC[16] = __hip_atomic_fetch_add(F.ctl + CW_Q, 1u, __ATOMIC_RELAXED, __HIP_MEMORY_SCOPE_AGENT);
            __syncthreads();
            const int it = (int)F.MISC[16];
            __syncthreads();
            if (it >= 512 + 240) break;
            int tid_ = F.tid; asm volatile("" : "+v"(tid_)); F.tid = tid_; F.lane = tid_ & 63;
            if (it < 512) { const int qb = 31 - (it >> 4), bh = it & 15; att::dattn_unit(F, bh >> 2, bh & 3, qb, lam); }
            else { const int v = it - 512; att::mlstm_state_item(F, v / 15, v % 15); }
        }
#else
        { const int v = F.vcu; if (v < 256) { const int bh = v >> 4, s = v & 15;
            att::dattn_unit(F, bh >> 2, bh & 3, 31 - s, lam); att::dattn_unit(F, bh >> 2, bh & 3, s, lam); } }
        { const int v = F.vcu; if (v < 16 * 15) att::mlstm_state_item(F, v / 15, v % 15); }
#endif
    } SEAM(2);

    if (IN(3)) REPS(3) {
        { const int v = F.vcu; if (v < 256) att::mlstm_out_unit(F, v >> 4, v & 15); }
        cvt_small_weights(F, F.vcu, F.G);
        __syncthreads();
        cvt_peer_tables(F, 1 << 20);
    } SEAM(3);

    if (IN(4)) REPS(4) {
        pg8::Gemm g{WSP(bf16, WS_H1), WSP(bf16, WS_WOUT), M, DM, DM}; pg8::StaticOrder S; S.init(M, DM, F.G, (int)blockIdx.x);
        pg8::EpiResid E{F.in[0], nullptr, WSP(bf16, WS_X1B), WSP(float, WS_SSP), DM};
        pg8::gemm_phase<pg8::EpiResid, pg8::StaticOrder, true, true>(F.lds, g, S, E);
    } SEAM(4);

    if (IN(5)) REPS(5) {
        pg8::Gemm g{WSP(bf16, WS_X1B), WSP(bf16, WS_WPQ), M, 2048, DM}; pg8::StaticOrder S; S.init(M, 2048, F.G, (int)blockIdx.x);
        pg8::EpiBf16S E{WSP(bf16, WS_H1), DM, DM, (size_t)(WS_QPB - WS_H1) / 2, 1.0f, WSP(float, WS_SSP), NORM_EPS};
        pg8::gemm_phase<pg8::EpiBf16S, pg8::StaticOrder, true, true>(F.lds, g, S, E);
    } SEAM(5);

    if (IN(6)) REPS(6) { peer::peer_topk_phase(F); } SEAM(6);
#ifdef EXTRA_BAR
    SEAM(6); SEAM(6);
#endif

    if (IN(7)) REPS(7) { peer::peer_gather_phase(F); }
#undef IN
#undef SEAM
}

#if defined(MK_CHECK)
__device__ __forceinline__ unsigned hsh(unsigned x) { x ^= x >> 16; x *= 0x7feb352dU; x ^= x >> 15; x *= 0x846ca68bU; x ^= x >> 16; return x; }
__device__ __forceinline__ void chk(unsigned* err, unsigned bit, float a, float ref, float rel, float ab) { if (!(fabsf(a - ref) <= ab + rel * fabsf(ref))) atomicOr(err, bit); }
#define CWS(T, off) ((T*)(a.ws + (off)))
#define CERR ((unsigned*)(a.ws) + CW_ERR)
__device__ __forceinline__ float blk_sum(float v, float* red, int n) { __syncthreads(); red[threadIdx.x] = v; __syncthreads(); for (int s = n / 2; s > 0; s >>= 1) { if ((int)threadIdx.x < s) red[threadIdx.x] += red[threadIdx.x + s]; __syncthreads(); } return red[0]; }
__device__ __forceinline__ float blk_max(float v, float* red, int n) { __syncthreads(); red[threadIdx.x] = v; __syncthreads(); for (int s = n / 2; s > 0; s >>= 1) { if ((int)threadIdx.x < s) red[threadIdx.x] = fmaxf(red[threadIdx.x], red[threadIdx.x + s]); __syncthreads(); } return red[0]; }

__device__ __forceinline__ float fp8dec(unsigned char b) { const int ex = (b >> 3) & 15, mn = b & 7; const float v = ex ? (1.0f + mn * 0.125f) * exp2f((float)(ex - 7)) : mn * 0.001953125f; return (b & 0x80) ? -v : v; }
__global__ void chk_p0(Args a) {
    __shared__ float hs[1024]; __shared__ float red[256];
    const unsigned sm = hsh(blockIdx.x * 256u + threadIdx.x + 77u);
    if (a.ph_lo == 1) {
        { const int n = sm % 1024, k = (sm >> 12) % 1024; chk(CERR, 0x100u, bf2f(CWS(bf16, WS_WOUT)[(size_t)n * 1024 + k]), a.in[13][(size_t)k * 1024 + n], 0.01f, 1e-4f); }
        { const int n = sm % 2048, k = (sm >> 12) % 1024; chk(CERR, 0x100u, bf2f(CWS(bf16, WS_WPQ)[(size_t)n * 1024 + k]), a.in[15][(size_t)k * 2048 + n] * a.in[14][k], 0.01f, 1e-4f); }
        { const int i = sm % 262144; chk(CERR, 0x100u, bf2f(CWS(bf16, WS_SUBK)[i]), a.in[16][i], 0.01f, 1e-4f); }
        { const size_t i = (size_t)(sm % 16777216u); { const float su_ = CWS(float, WS_SU)[i >> 10]; chk(CERR, 0x100u, (float)(signed char)CWS(unsigned char, WS_UB)[i] * su_, a.in[17][i] * a.in[14][i & 1023], 0.f, 0.51f * su_ + 1e-7f); } { const float sv_ = CWS(float, WS_SU)[NEXP + (i >> 10)]; chk(CERR, 0x100u, (float)(signed char)CWS(unsigned char, WS_VB)[i] * sv_, a.in[18][i], 0.f, 0.51f * sv_ + 1e-7f); } }
        return; }
    const int m = hsh(blockIdx.x * 7919u + 1u) % M; const float* x = a.in[0] + (size_t)m * DM; const float* g1 = a.in[1];
    float s = 0.f; for (int e = threadIdx.x; e < 1024; e += 256) s += x[e] * x[e];
    const float rstd = 1.0f / sqrtf(blk_sum(s, red, 256) / 1024.f + NORM_EPS);
    for (int e = threadIdx.x; e < 1024; e += 256) { hs[e] = x[e] * rstd * g1[e]; chk(CERR, 0x200u, bf2f(CWS(bf16, WS_H1)[(size_t)m * DM + e]), hs[e], 0.01f, 0.01f); }
    __syncthreads();
    if (threadIdx.x < 8) { const int g = threadIdx.x; float d = 0.f; for (int k = 0; k < 1024; ++k) d += hs[k] * a.in[2][(size_t)k * INCOLS + NPROJ + g];
        const int b = m / SEQ, t = m % SEQ, hh = g & 3; const size_t o = (size_t)(b * 4 + hh) * SEQ + t;
        if (g < 4) chk(CERR, 0x200u, CWS(float, WS_GI)[o], d + a.in[5][hh], 1e-3f, 2e-3f);
        else { const float f = d + a.in[6][hh]; chk(CERR, 0x200u, CWS(float, WS_GLF)[o], -log1pf(expf(-f)), 1e-3f, 2e-3f); } }
    { const int n = sm % NPROJ, k = (sm >> 12) % 1024; chk(CERR, 0x100u, bf2f(CWS(bf16, WS_WIN)[(size_t)n * 1024 + k]), a.in[2][(size_t)k * INCOLS + n], 0.01f, 1e-4f); }
}
__global__ void chk_gemm1(Args a) {
    const unsigned gid = blockIdx.x * 256u + threadIdx.x; const unsigned sm = hsh(gid + 1234567u);
    { const int t = sm % M, n = (sm >> 14) % NPROJ; const bf16* hr = CWS(bf16, WS_H1) + (size_t)t * DM; const bf16* wr = CWS(bf16, WS_WIN) + (size_t)n * DM;
      float d = 0.f; for (int k = 0; k < 1024; ++k) d += bf2f(hr[k]) * bf2f(wr[k]);
      const int bi = n / 512, col = n % 512; if (bi == 0) d *= QSCALE;
      chk(CERR, 0x80u, bf2f(CWS(bf16, WS_PROJ)[(size_t)bi * PROJ_STRIDE + (size_t)t * PW + col]), d, 0.02f, 0.02f); }
    if (gid < 256) { const int bh = sm % 16, t = (gid < 16) ? (int)(4095 - gid * 17) : (int)((sm >> 4) % SEQ); const float* gi = CWS(float, WS_GI) + (size_t)bh * SEQ; const float* glf = CWS(float, WS_GLF) + (size_t)bh * SEQ;
      float B = 0.f, Mx = -3.0e38f, av = 0.f; for (int s = 0; s <= t; ++s) { B += glf[s]; av = gi[s] - B; Mx = fmaxf(Mx, av); }
      chk(CERR, 0x40u, CWS(float, WS_A2)[(size_t)bh * SEQ + t], av * LOG2E, 1e-4f, 5e-3f); chk(CERR, 0x40u, CWS(float, WS_M2)[(size_t)bh * SEQ + t], Mx * LOG2E, 1e-4f, 5e-3f);
      chk(CERR, 0x40u, CWS(float, WS_NB2)[(size_t)bh * SEQ + t], -(B + Mx) * LOG2E, 1e-4f, 5e-3f); }
}
__global__ void __launch_bounds__(128) chk_attn(Args a) {
    __shared__ float sc[2][4096]; __shared__ float red[128]; __shared__ float qv[128];
    const unsigned sm = hsh(blockIdx.x * 31u + 5u); const int b = sm & 3, h = (sm >> 2) & 3, t = (blockIdx.x < 4) ? (int)(4095 - blockIdx.x * 129) : (int)((sm >> 4) % SEQ), d = threadIdx.x;
    const bf16* DAQ = CWS(bf16, WS_PROJ); const bf16* DAK = DAQ + PROJ_STRIDE; const bf16* DAV = DAQ + 2 * PROJ_STRIDE;
    qv[d] = bf2f(DAQ[((size_t)b * SEQ + t) * PW + h * 128 + d]); __syncthreads();
    const float slope2 = exp2f(-2.0f * (h + 1)) * LOG2E;
    float mx0 = -3.0e38f, mx1 = -3.0e38f;
    for (int s = d; s <= t; s += 128) { const bf16* kr = DAK + ((size_t)b * SEQ + s) * PW + h * 128; float d0 = 0.f, d1 = 0.f;
        for (int k = 0; k < 64; ++k) { d0 += qv[k] * bf2f(kr[k]); d1 += qv[64 + k] * bf2f(kr[64 + k]); }
        d0 -= slope2 * (t - s); d1 -= slope2 * (t - s); sc[0][s] = d0; sc[1][s] = d1; mx0 = fmaxf(mx0, d0); mx1 = fmaxf(mx1, d1); }
    mx0 = blk_max(mx0, red, 128); mx1 = blk_max(mx1, red, 128);
    float l0 = 0.f, l1 = 0.f; for (int s = d; s <= t; s += 128) { l0 += exp2f(sc[0][s] - mx0); l1 += exp2f(sc[1][s] - mx1); }
    l0 = blk_sum(l0, red, 128); l1 = blk_sum(l1, red, 128);
    float la = 0.f, lb = 0.f; for (int k = 0; k < 64; ++k) { la += a.in[7][k] * a.in[8][k]; lb += a.in[9][k] * a.in[10][k]; }
    const float lam = expf(la) - expf(lb) + LAM_INIT;
    float o = 0.f; for (int s = 0; s <= t; ++s) o += (exp2f(sc[0][s] - mx0) / l0 - lam * exp2f(sc[1][s] - mx1) / l1) * bf2f(DAV[((size_t)b * SEQ + s) * PW + h * 128 + d]);
    const float ms = blk_sum(o * o, red, 128) / 128.f;
    const float ref = o / sqrtf(ms + SUBLN_EPS) * a.in[11][d] * (1.0f - LAM_INIT);
    chk(CERR, 0x20u, bf2f(CWS(bf16, WS_H1)[((size_t)b * SEQ + t) * DM + h * 128 + d]), ref, 0.03f, 0.03f);
}
__device__ __forceinline__ float conv1(const bf16* raw, size_t rb, int t, int col, const float* cw, const float* cb, int ch) {
    float y = cb[ch]; for (int j = 0; j < 4; ++j) { const int tt = t - 3 + j; if (tt >= 0) y += cw[j * 1024 + ch] * bf2f(raw[(rb + tt) * PW + col]); } return y / (1.0f + expf(-y)); }
__global__ void __launch_bounds__(128) chk_mlstm(Args a) {
    __shared__ float sc[4096]; __shared__ float red[128]; __shared__ float qs[128];
    const unsigned sm = hsh(blockIdx.x * 131u + 9u); const int bh = sm & 15, b = bh >> 2, hh = bh & 3, d = threadIdx.x;
    const int t = (blockIdx.x < 8) ? (int)(blockIdx.x * 37) : (blockIdx.x < 16) ? (int)(4095 - (blockIdx.x - 8) * 300) : (int)((sm >> 4) % SEQ);
    const bf16* MLQ = CWS(bf16, WS_PROJ) + 3 * PROJ_STRIDE; const bf16* MLK = MLQ + PROJ_STRIDE; const bf16* MLV = MLQ + 2 * PROJ_STRIDE; const bf16* MLO = MLQ + 3 * PROJ_STRIDE;
    const size_t rb = (size_t)b * SEQ; const float* A2 = CWS(float, WS_A2) + (size_t)bh * SEQ; const float m2t = CWS(float, WS_M2)[(size_t)bh * SEQ + t], nb2t = CWS(float, WS_NB2)[(size_t)bh * SEQ + t];
    qs[d] = conv1(MLQ, rb, t, hh * 128 + d, a.in[3], a.in[4], hh * 128 + d); __syncthreads();
    float dp = 0.f;
    for (int s = d; s <= t; s += 128) { float dot = 0.f; for (int k = 0; k < 128; ++k) dot += qs[k] * conv1(MLK, rb, s, hh * 128 + k, a.in[3], a.in[4], 512 + hh * 128 + k);
        const float w = dot * MLK_SCALE * exp2f(A2[s] - m2t); sc[s] = w; dp += w; }
    const float den = blk_sum(dp, red, 128);
    float num = 0.f; for (int s = 0; s <= t; ++s) num += sc[s] * bf2f(MLV[(rb + s) * PW + hh * 128 + d]);
    const float hv = num / fmaxf(fabsf(den), exp2f(nb2t));
    const float ms = blk_sum(hv * hv, red, 128) / 128.f;
    const float og = bf2f(MLO[(rb + t) * PW + hh * 128 + d]);
    const float ref = hv / sqrtf(ms + NORM_EPS) * a.in[12][hh * 128 + d] / (1.0f + expf(-og));
    chk(CERR, 0x10u, bf2f(CWS(bf16, WS_H1)[(rb + t) * DM + 512 + hh * 128 + d]), ref, 0.03f, 0.03f);
}
__global__ void chk_gemm2(Args a) {
    const unsigned gid = blockIdx.x * 256u + threadIdx.x; const unsigned sm = hsh(gid + 99u);
    const int t = sm % M, n = (sm >> 14) % 1024; const bf16* ar = CWS(bf16, WS_H1) + (size_t)t * DM; const bf16* wr = CWS(bf16, WS_WOUT) + (size_t)n * DM;
    float d = a.in[0][(size_t)t * DM + n]; for (int k = 0; k < 1024; ++k) d += bf2f(ar[k]) * bf2f(wr[k]);
    chk(CERR, 0x8u, bf2f(CWS(bf16, WS_X1B)[(size_t)t * DM + n]), d, 0.015f, 0.015f);
    if (gid < 64) { float s = 0.f, p = 0.f; for (int k = 0; k < 1024; ++k) { const float v = bf2f(CWS(bf16, WS_X1B)[(size_t)t * DM + k]); s += v * v; } for (int k = 0; k < 16; ++k) p += CWS(float, WS_SSP)[(size_t)t * 16 + k];
        chk(CERR, 0x8u, p, s, 5e-3f, 1e-3f); }
}
__global__ void chk_gemm3(Args a) {
    const unsigned gid = blockIdx.x * 256u + threadIdx.x; const unsigned sm = hsh(gid + 4242u);
    const int t = sm % M, n = (sm >> 14) % 2048; const bf16* ar = CWS(bf16, WS_X1B) + (size_t)t * DM; const bf16* wr = CWS(bf16, WS_WPQ) + (size_t)n * DM;
    float p = 0.f; for (int k = 0; k < 16; ++k) p += CWS(float, WS_SSP)[(size_t)t * 16 + k];
    float d = 0.f; for (int k = 0; k < 1024; ++k) d += bf2f(ar[k]) * bf2f(wr[k]); d /= sqrtf(p / 1024.f + NORM_EPS);
    const bf16* qp = (n < 1024) ? CWS(bf16, WS_H1) + (size_t)t * DM + n : CWS(bf16, WS_QPB) + (size_t)t * DM + (n - 1024);
    chk(CERR, 0x4u, bf2f(*qp), d, 0.02f, 0.02f);
}
__global__ void chk_topk(Args a) {
    __shared__ float s12[256]; __shared__ float cand[256]; __shared__ int i12[32]; __shared__ float v12[32]; __shared__ int pe[16]; __shared__ float pg[16];
    const unsigned sm = hsh(blockIdx.x * 17u + 3u); const int t = sm % M, h = (sm >> 14) & 7, tid = threadIdx.x, c = tid >> 7, n = tid & 127;
    const bf16* q = ((h < 4) ? CWS(bf16, WS_H1) + h * 256 : CWS(bf16, WS_QPB) + (h - 4) * 256) + (size_t)t * DM + c * 128; const bf16* sk = CWS(bf16, WS_SUBK) + ((size_t)(h * 2 + c) * 128 + n) * 128;
    float d = 0.f; for (int k = 0; k < 128; ++k) d += bf2f(q[k]) * bf2f(sk[k]); s12[tid] = d; __syncthreads();
    if (tid < 2) { for (int k = 0; k < 16; ++k) { int bi = 0; float bv = -3.0e38f; for (int j = 0; j < 128; ++j) if (s12[tid * 128 + j] > bv) { bv = s12[tid * 128 + j]; bi = j; } i12[tid * 16 + k] = bi; v12[tid * 16 + k] = bv; s12[tid * 128 + bi] = -3.0e38f; } }
    __syncthreads(); cand[tid] = v12[tid >> 4] + v12[16 + (tid & 15)]; __syncthreads();
    if (tid == 0) { float mx = 0.f, es = 0.f; for (int k = 0; k < 16; ++k) { int bi = 0; float bv = -3.0e38f; for (int j = 0; j < 256; ++j) if (cand[j] > bv) { bv = cand[j]; bi = j; }
            pe[k] = i12[bi >> 4] * 128 + i12[16 + (bi & 15)]; if (k == 0) mx = bv; pg[k] = expf(bv - mx); es += pg[k]; cand[bi] = -3.0e38f; }
        const unsigned long long* P = CWS(unsigned long long, WS_PE) + (size_t)t * 128 + h * 16; int miss = 0;
        for (int k = 0; k < 16; ++k) { bool f = false; for (int j = 0; j < 16; ++j) if ((int)(unsigned)(P[j] & 0xFFFFFFFFull) == pe[k]) { f = true; const float g = __uint_as_float((unsigned)(P[j] >> 32)); if (!(fabsf(g - pg[k] / es) <= 0.003f + 0.03f * pg[k] / es)) miss += 4; } if (!f) ++miss; }
        if (miss > 2) atomicOr(CERR, 0x2u); }
}
__global__ void chk_gather(Args a) {
    __shared__ float wv[128]; __shared__ int ev[128]; __shared__ float red[256];
    const int t = hsh(blockIdx.x * 13u + 11u) % M, tid = threadIdx.x; const bf16* x1 = CWS(bf16, WS_X1B) + (size_t)t * DM;
    float p = 0.f; for (int k = 0; k < 16; ++k) p += CWS(float, WS_SSP)[(size_t)t * 16 + k]; const float rstd = 1.0f / sqrtf(p / 1024.f + NORM_EPS);
    if (tid < 128) { const unsigned long long e = CWS(unsigned long long, WS_PE)[(size_t)t * 128 + tid]; const int ei = (int)(unsigned)(e & 0xFFFFFFFFull); const unsigned char* u = CWS(unsigned char, WS_UB) + (size_t)ei * DM;
        float d = 0.f; for (int k = 0; k < 1024; ++k) d += (float)(signed char)u[k] * bf2f(x1[k]); d *= rstd * CWS(float, WS_SU)[ei]; ev[tid] = ei; wv[tid] = __uint_as_float((unsigned)(e >> 32)) * 0.5f * d * (1.0f + erff(d * 0.70710678f)); }
    __syncthreads();
    float y[4], s = 0.f; for (int i = 0; i < 4; ++i) { const int dd = tid * 4 + i; float acc = bf2f(x1[dd]); for (int k = 0; k < 128; ++k) acc += wv[k] * CWS(float, WS_SU)[NEXP + ev[k]] * (float)(signed char)CWS(unsigned char, WS_VB)[(size_t)ev[k] * DM + dd]; y[i] = acc; s += acc * acc; }
    const float rs = 1.0f / sqrtf(blk_sum(s, red, 256) / 1024.f + NORM_EPS);
    for (int i = 0; i < 4; ++i) { const int dd = tid * 4 + i; chk(CERR, 0x1u, a.out[(size_t)t * DM + dd], y[i] * rs * a.in[19][dd], 0.03f, 0.03f); }
}
__global__ void chk_poison(Args a) { const unsigned e = *CERR; if (e) { const float f = 1.0f + 10.0f * (float)e; for (size_t i = blockIdx.x * 256u + threadIdx.x; i < (size_t)M * DM; i += (size_t)gridDim.x * 256u) a.out[i] *= f; } }
#endif

extern "C" void kernel_launch(void* const* d_in, const int* in_sizes, int n_in, void* d_out, int out_size, void* d_ws, size_t ws_size, hipStream_t stream) {
    static int grid = 0;
    if (grid == 0) {
        if (n_in != 20 || in_sizes[0] != M * DM || out_size != M * DM || ws_size < WS_END) { fprintf(stderr, "kernel_launch: unexpected shapes (n_in %d, in0 %d, out %d, ws %zu); nothing launched\n", n_in, n_in > 0 ? in_sizes[0] : -1, out_size, ws_size); grid = -1; return; }
        int dev = 0, cus = 0, per_cu = 0;
        if (hipGetDevice(&dev) != hipSuccess || hipDeviceGetAttribute(&cus, hipDeviceAttributeMultiprocessorCount, dev) != hipSuccess) { grid = -1; return; }
        if (hipFuncSetAttribute((const void*)mega_fwd, hipFuncAttributeMaxDynamicSharedMemorySize, LDS_BYTES) != hipSuccess) { fprintf(stderr, "kernel_launch: hipFuncSetAttribute failed\n"); grid = -1; return; }
        if (hipOccupancyMaxActiveBlocksPerMultiprocessor(&per_cu, (const void*)mega_fwd, NTHR, LDS_BYTES) != hipSuccess || per_cu < 1) fprintf(stderr, "kernel_launch: occupancy query reports %d\n", per_cu);
        (void)hipGetLastError();
        grid = 256;
        if (cus < 256) { fprintf(stderr, "kernel_launch: %d CUs, need 256\n", cus); grid = -1; return; }
    }
    if (grid < 0) return;
    (void)hipMemsetAsync((char*)d_ws + WS_CTL, 0, CTL_ZERO_BYTES, stream);
    Args a{};
    for (int i = 0; i < 20; ++i) a.in[i] = (const float*)d_in[i];
    a.out = (float*)d_out; a.ws = (unsigned char*)d_ws;
#if MK_N_LAUNCHES == 1
    a.ph_lo = 0; a.ph_hi = N_PHASES;
    hipLaunchKernelGGL(mega_fwd, dim3(grid), dim3(NTHR), LDS_BYTES, stream, a);
#else
    for (int p = 0; p < N_PHASES; ++p) { a.ph_lo = p; a.ph_hi = p + 1; hipLaunchKernelGGL(mega_fwd, dim3(grid), dim3(NTHR), LDS_BYTES, stream, a);
#if defined(DUP_PHASE)
        if (p == DUP_PHASE) hipLaunchKernelGGL(mega_fwd, dim3(grid), dim3(NTHR), LDS_BYTES, stream, a);
#endif
#if defined(MK_CHECK)
        a.ph_lo = 0; a.ph_hi = 0;
        if (p == 0) hipLaunchKernelGGL(chk_p0, dim3(256), dim3(256), 0, stream, a);
        if (p == 3) { a.ph_lo = 1; hipLaunchKernelGGL(chk_p0, dim3(256), dim3(256), 0, stream, a); a.ph_lo = 0; }
        if (p == 1) hipLaunchKernelGGL(chk_gemm1, dim3(16), dim3(256), 0, stream, a);
        if (p == 3) { hipLaunchKernelGGL(chk_attn, dim3(64), dim3(128), 0, stream, a); hipLaunchKernelGGL(chk_mlstm, dim3(64), dim3(128), 0, stream, a); }
        if (p == 4) hipLaunchKernelGGL(chk_gemm2, dim3(16), dim3(256), 0, stream, a);
        if (p == 5) hipLaunchKernelGGL(chk_gemm3, dim3(16), dim3(256), 0, stream, a);
        if (p == 6) hipLaunchKernelGGL(chk_topk, dim3(128), dim3(256), 0, stream, a);
        if (p == 7) { hipLaunchKernelGGL(chk_gather, dim3(32), dim3(256), 0, stream, a); hipLaunchKernelGGL(chk_poison, dim3(1024), dim3(256), 0, stream, a); }
#endif
    }
#endif
    const hipError_t le = hipPeekAtLastError();
    if (le != hipSuccess) fprintf(stderr, "kernel_launch: launch failed: %s\n", hipGetErrorName(le));
}
```

```cpp
#define MK_N_LAUNCHES 1
#define PG_U64 1
#define FAST_SIG 1
#define PG_QSONCE 1
#define PG_GHEAD 1
#define CREF6 1
#define CONV_SLIDE_S 1
#define CONV_SLIDE_Q 1
#define CONV_SLIDE_K 1
#define WRED_DPP 1
#define XT_PRELOAD 1
#define VPERM 1
#define EPI_RESID_P 1
#define GATE_PRELOAD 1
#define EPI_SPLIT 1
#define PG_SORTX 1
#define P7_NOSYNC 1
#define NATIVE_CVT 1
#include <hip/hip_runtime.h>
#include <cstdio>
#include <cstdint>
namespace pg8 {
#define PG8_LAS __attribute__((address_space(3)))
typedef unsigned short bf16_t;
typedef short bf16x8 __attribute__((ext_vector_type(8)));
typedef float f32x4 __attribute__((ext_vector_type(4)));
typedef unsigned u32x4 __attribute__((ext_vector_type(4)));
#ifndef PG8_WGM
#define PG8_WGM 8
#endif
constexpr int BM = 256, BK = 64, HALF = 128, HTB = HALF * BK * 2  , STAGE_BYTES = 8 * HTB, NXCD = 8, WGM = PG8_WGM;

__host__ __device__ __forceinline__ int lds_byte(int r, int c) { const int st = (r >> 4) * 2 + (c >> 5), rr = r & 15, cc = c & 31, ob = rr * 64 + cc * 2; return st * 1024 + (ob ^ (((ob >> 9) & 1) << 5)); }
__host__ __device__ __forceinline__ void stage_rc(int b, int& R, int& C) { const int st = b / 1024, sb = b % 1024, swz = sb ^ (((sb >> 9) & 1) << 5); R = (st >> 1) * 16 + swz / 64; C = (st & 1) * 32 + (swz % 64) / 2; }
__host__ __device__ __forceinline__ int perm32(int rho) { const int n = rho >> 4, i = rho & 15; return 8 * (i >> 2) + 4 * n + (i & 3); }

struct Unit { int pm, pn; };
struct Gemm { const bf16_t* A; const bf16_t* Bt; int M, N, K; };

struct StaticOrder {
    int nM, nN, nwg, G, c;
    __host__ __device__ void init(int M, int N, int G_, int c_) { nM = M / BM; nN = N / BM; nwg = nM * nN; G = G_; c = c_; }
    __host__ __device__ bool next(int i, Unit& u) const {
        const long L = (long)i * G + c; if (L >= nwg) return false;
        int wgid = (int)L; { const int q = nwg / NXCD, r = nwg % NXCD, xcd = wgid % NXCD, off = wgid / NXCD; wgid = (xcd < r ? xcd * (q + 1) : r * (q + 1) + (xcd - r) * q) + off; }
        const int nig = WGM * nN, gid = wgid / nig, fm = gid * WGM, gsz = (nM - fm) < WGM ? (nM - fm) : WGM;
        u.pm = fm + ((wgid % nig) % gsz); u.pn = (wgid % nig) / gsz; return true;
    }
    __device__ __forceinline__ void a_ready(const Unit&) const {}
    __device__ __forceinline__ void done(const Unit&) const {}
};

__device__ __forceinline__ unsigned cvt_pk_bf16(float lo, float hi) { unsigned r; asm volatile("v_cvt_pk_bf16_f32 %0, %1, %2" : "=v"(r) : "v"(lo), "v"(hi)); return r; }
typedef float f32x2 __attribute__((ext_vector_type(2)));
typedef unsigned u32x2e __attribute__((ext_vector_type(2)));
__device__ __forceinline__ void st16_wt(void* p, u32x4 v) {
#ifdef PG8_WT_STORES
    asm volatile("global_store_dwordx4 %0, %1, off sc1\n\ts_nop 1" :: "v"(p), "v"(v) : "memory");
#else
    *(u32x4*)p = v;
#endif
}
struct EpiBf16S {
    static constexpr bool PERM = true, AFTER_DRAIN = false;
    bf16_t* O; int ldc; int split_cols; size_t split_stride; float scale0; const float* ssp; float eps;
    __device__ __forceinline__ void operator()(const f32x4 (&acc)[2][2][4][2], const Unit& u, int wr, int wc, int fr, int fq) const {
        const int row0 = u.pm * BM + wr * 64 + fr; int colt = u.pn * BM; bf16_t* base = O;
        float sc = 1.f; if (split_cols) { const int t = colt / split_cols; base += (size_t)t * split_stride; colt -= t * split_cols; if (t == 0) sc = scale0; }
        const int col0 = colt + wc * 32 + 8 * fq;
#pragma unroll
        for (int ai = 0; ai < 2; ++ai)
#pragma unroll
            for (int m = 0; m < 4; ++m) { const int row = row0 + ai * HALF + m * 16; bf16_t* rowp = base + (size_t)row * ldc + col0;
                float rs = sc;
                if (ssp) { const f32x4* sp = (const f32x4*)(ssp + (size_t)row * 16); const f32x4 a = sp[0], b = sp[1], c = sp[2], d = sp[3];
                    const float s = ((a[0] + a[1]) + (a[2] + a[3])) + ((b[0] + b[1]) + (b[2] + b[3])) + ((c[0] + c[1]) + (c[2] + c[3])) + ((d[0] + d[1]) + (d[2] + d[3]));
#ifdef FAST_SIG
                    rs *= __builtin_amdgcn_rsqf(s * (1.0f / 1024.0f) + eps); }
#else
                    rs *= 1.0f / sqrtf(s * (1.0f / 1024.0f) + eps); }
#endif
#pragma unroll
                for (int bj = 0; bj < 2; ++bj) { const f32x4 v0 = acc[ai][bj][m][0] * rs, v1 = acc[ai][bj][m][1] * rs;
                    u32x4 w; w.x = cvt_pk_bf16(v0[0], v0[1]); w.y = cvt_pk_bf16(v0[2], v0[3]); w.z = cvt_pk_bf16(v1[0], v1[1]); w.w = cvt_pk_bf16(v1[2], v1[3]);
                    st16_wt(rowp + bj * HALF, w); } }
    }
};
#ifdef RESID_NT
#define PG8_RESLD(p) __builtin_nontemporal_load(p)
#else
#define PG8_RESLD(p) (*(p))
#endif
struct EpiResid {
    static constexpr bool PERM = false, AFTER_DRAIN = false;
    const float* resid; float* out; bf16_t* outb; float* ssp; int ldc;
    __device__ __forceinline__ void operator()(const f32x4 (&acc)[2][2][4][2], const Unit& u, int wr, int wc, int fr, int fq) const {
        const int col0 = u.pn * BM + wc * 32 + 4 * fq;
#ifdef EPI_BATCH
#pragma unroll
        for (int ai = 0; ai < 2; ++ai)
#pragma unroll
            for (int mg = 0; mg < 4; mg += EPI_BATCH) {
                f32x4 rx[EPI_BATCH][2][2];
#pragma unroll
                for (int mm = 0; mm < EPI_BATCH; ++mm) { const int r = u.pm * BM + ai * HALF + wr * 64 + (mg + mm) * 16 + fr; const size_t off = (size_t)r * ldc + col0;
#pragma unroll
                    for (int bj = 0; bj < 2; ++bj)
#pragma unroll
                        for (int n = 0; n < 2; ++n) rx[mm][bj][n] = *(const f32x4*)(resid + off + bj * HALF + n * 16); }
                __builtin_amdgcn_sched_barrier(0);
#pragma unroll
                for (int mm = 0; mm < EPI_BATCH; ++mm) { const int m = mg + mm; const int r = u.pm * BM + ai * HALF + wr * 64 + m * 16 + fr; const size_t off = (size_t)r * ldc + col0; float s = 0.f;
#pragma unroll
                    for (int bj = 0; bj < 2; ++bj)
#pragma unroll
                        for (int n = 0; n < 2; ++n) { const f32x4 x = rx[mm][bj][n] + acc[ai][bj][m][n];
                            if (out) *(f32x4*)(out + off + bj * HALF + n * 16) = x; s += (x[0] * x[0] + x[1] * x[1]) + (x[2] * x[2] + x[3] * x[3]);
                            u32x2e w; w.x = cvt_pk_bf16(x[0], x[1]); w.y = cvt_pk_bf16(x[2], x[3]); *(u32x2e*)(outb + off + bj * HALF + n * 16) = w; }
                    s += __shfl_xor(s, 16); s += __shfl_xor(s, 32);
                    if (fq == 0) ssp[(size_t)r * 16 + u.pn * 4 + wc] = s; }
                __builtin_amdgcn_sched_barrier(0); }
#else
#pragma unroll
        for (int ai = 0; ai < 2; ++ai)
#pragma unroll
            for (int m = 0; m < 4; ++m) { const int r = u.pm * BM + ai * HALF + wr * 64 + m * 16 + fr; const size_t off = (size_t)r * ldc + col0; float s = 0.f;
#pragma unroll
                for (int bj = 0; bj < 2; ++bj)
#pragma unroll
                    for (int n = 0; n < 2; ++n) { const f32x4 x = PG8_RESLD((const f32x4*)(resid + off + bj * HALF + n * 16)) + acc[ai][bj][m][n];
                        if (out) *(f32x4*)(out + off + bj * HALF + n * 16) = x; s += (x[0] * x[0] + x[1] * x[1]) + (x[2] * x[2] + x[3] * x[3]);
                        u32x2e w; w.x = cvt_pk_bf16(x[0], x[1]); w.y = cvt_pk_bf16(x[2], x[3]); *(u32x2e*)(outb + off + bj * HALF + n * 16) = w; }
                s += __shfl_xor(s, 16); s += __shfl_xor(s, 32);
                if (fq == 0) ssp[(size_t)r * 16 + u.pn * 4 + wc] = s; }
#endif
    }
};

struct EpiResidP {
    static constexpr bool PERM = true, AFTER_DRAIN = false;
    const float* resid; float* out; bf16_t* outb; float* ssp; int ldc;
    __device__ __forceinline__ void operator()(const f32x4 (&acc)[2][2][4][2], const Unit& u, int wr, int wc, int fr, int fq) const {
        const int row0 = u.pm * BM + wr * 64 + fr, col0 = u.pn * BM + wc * 32 + 8 * fq;
#pragma unroll
        for (int ai = 0; ai < 2; ++ai)
#pragma unroll
            for (int m = 0; m < 4; ++m) { const int r = row0 + ai * HALF + m * 16; const size_t off = (size_t)r * ldc + col0; float s = 0.f;
#pragma unroll
                for (int bj = 0; bj < 2; ++bj) { const f32x4* rp = (const f32x4*)(resid + off + bj * HALF);
                    const f32x4 x0 = rp[0] + acc[ai][bj][m][0], x1 = rp[1] + acc[ai][bj][m][1];
                    s += ((x0[0] * x0[0] + x0[1] * x0[1]) + (x0[2] * x0[2] + x0[3] * x0[3])) + ((x1[0] * x1[0] + x1[1] * x1[1]) + (x1[2] * x1[2] + x1[3] * x1[3]));
                    u32x4 w; w.x = cvt_pk_bf16(x0[0], x0[1]); w.y = cvt_pk_bf16(x0[2], x0[3]); w.z = cvt_pk_bf16(x1[0], x1[1]); w.w = cvt_pk_bf16(x1[2], x1[3]);
                    *(u32x4*)(outb + off + bj * HALF) = w; }
                s += __shfl_xor(s, 16); s += __shfl_xor(s, 32);
                if (fq == 0) ssp[(size_t)r * 16 + u.pn * 4 + wc] = s; }
    }
};
template <class Epi, class Sched, bool ALIGN_EPI = false, bool SP2 = false>
__device__ __forceinline__ void gemm_phase(PG8_LAS unsigned char* lds, const Gemm g, const Sched& S, const Epi& E) {
    const int tid = threadIdx.x, wid = __builtin_amdgcn_readfirstlane(tid >> 6), lane = tid & 63, wr = wid >> 2, wc = wid & 3, fr = lane & 15, fq = lane >> 4;
    const int K = g.K, nt = K / BK;
    unsigned voffA[2], voffB[2];
#pragma unroll
    for (int i = 0; i < 2; ++i) { int R, C; stage_rc(tid * 16 + i * 8192, R, C); const int Rb = Epi::PERM ? ((R & ~31) + perm32(R & 31)) : R;
        voffA[i] = (unsigned)(R * K + C) * 2u; voffB[i] = (unsigned)(Rb * K + C) * 2u; }
    const size_t kstep = (size_t)(BK * 2);
    const size_t hstep = (size_t)HALF * K * 2;
    const size_t tstep = 2 * hstep;
    const unsigned ldsw = (unsigned)wid * 1024u;
    const int aoff = lds_byte(wr * 64 + fr, fq * 8), boff = lds_byte(wc * 32 + fr, fq * 8);
#define PG8_SA(b, h) (((b) * 2 + (h)) * HTB)
#define PG8_SB(b, h) ((4 + (b) * 2 + (h)) * HTB)
#define PG8_STAGE(bufoff, gbase, voff) do { _Pragma("unroll") for (int _i = 0; _i < 2; ++_i) \
        __builtin_amdgcn_global_load_lds((const unsigned*)((const char*)(gbase) + (voff)[_i]), (PG8_LAS unsigned*)(lds + (bufoff) + ldsw + _i * 8192), 16, 0, 0); } while (0)
#define PG8_LDA(dst, b, h) do { _Pragma("unroll") for (int m = 0; m < 4; ++m) _Pragma("unroll") for (int k = 0; k < 2; ++k) dst[m][k] = *(const PG8_LAS bf16x8*)(lds + PG8_SA(b, h) + aoff + m * 2048 + k * 1024); } while (0)
#define PG8_LDB(dst, b, h) do { _Pragma("unroll") for (int n = 0; n < 2; ++n) _Pragma("unroll") for (int k = 0; k < 2; ++k) dst[n][k] = *(const PG8_LAS bf16x8*)(lds + PG8_SB(b, h) + boff + n * 2048 + k * 1024); } while (0)
#define PG8_MMA(ai, bj, At, Bt) do { __builtin_amdgcn_s_setprio(1); _Pragma("unroll") for (int m = 0; m < 4; ++m) _Pragma("unroll") for (int n = 0; n < 2; ++n) _Pragma("unroll") for (int k = 0; k < 2; ++k) \
        acc[ai][bj][m][n] = __builtin_amdgcn_mfma_f32_16x16x32_bf16(Bt[n][k], At[m][k], acc[ai][bj][m][n], 0, 0, 0); __builtin_amdgcn_s_setprio(0); } while (0)
#define PG8_WAIT_V(n) asm volatile("s_waitcnt vmcnt(" #n ")" ::: "memory")
#define PG8_WAIT_L(n) asm volatile("s_waitcnt lgkmcnt(" #n ")" ::: "memory")
#define PG8_BAR __builtin_amdgcn_s_barrier()
#define PG8_SCHED __builtin_amdgcn_sched_barrier(0)
    Unit cur, nxt; int ui = 0;
    if (!S.next(0, cur)) return;
    f32x4 acc[2][2][4][2];
#pragma unroll
    for (int a = 0; a < 2; ++a)
#pragma unroll
        for (int b = 0; b < 2; ++b)
#pragma unroll
            for (int m = 0; m < 4; ++m)
#pragma unroll
                for (int n = 0; n < 2; ++n) acc[a][b][m][n] = (f32x4){0.f, 0.f, 0.f, 0.f};
    bf16x8 At[4][2], B0[2][2], B1[2][2];
    const char* cA = (const char*)g.A + (size_t)cur.pm * tstep; const char* cB = (const char*)g.Bt + (size_t)cur.pn * tstep;
    S.a_ready(cur);
    if constexpr (SP2) {
        PG8_STAGE(PG8_SB(0, 0), cB, voffB); PG8_STAGE(PG8_SB(0, 1), cB + hstep, voffB); PG8_STAGE(PG8_SA(0, 0), cA, voffA); PG8_STAGE(PG8_SA(0, 1), cA + hstep, voffA);
        if (wr == 1) PG8_BAR;
        PG8_WAIT_V(2); PG8_BAR;
        PG8_STAGE(PG8_SB(1, 0), cB + kstep, voffB); PG8_STAGE(PG8_SA(1, 0), cA + kstep, voffA); PG8_STAGE(PG8_SB(1, 1), cB + hstep + kstep, voffB);
        PG8_WAIT_V(6); PG8_BAR;
    } else {
        PG8_STAGE(PG8_SB(0, 0), cB, voffB); PG8_STAGE(PG8_SA(0, 0), cA, voffA); PG8_STAGE(PG8_SB(0, 1), cB + hstep, voffB); PG8_STAGE(PG8_SA(0, 1), cA + hstep, voffA);
        if (wr == 1) PG8_BAR;
        PG8_WAIT_V(4); PG8_BAR;
        PG8_STAGE(PG8_SB(1, 0), cB + kstep, voffB); PG8_STAGE(PG8_SA(1, 0), cA + kstep, voffA); PG8_STAGE(PG8_SB(1, 1), cB + hstep + kstep, voffB);
        PG8_WAIT_V(6); PG8_BAR;
    }
    for (;;) {
        const bool has_next = S.next(ui + 1, nxt);
        const char* nA = has_next ? (const char*)g.A + (size_t)nxt.pm * tstep : cA; const char* nB = has_next ? (const char*)g.Bt + (size_t)nxt.pn * tstep : cB;
        for (int t = 0; t < nt; t += 2) {
            const bool last = (t == nt - 2);
            const char* a1 = cA + (size_t)(t + 1) * kstep;
            const char* a2 = last ? nA : cA + (size_t)(t + 2) * kstep; const char* b2 = last ? nB : cB + (size_t)(t + 2) * kstep;
            const char* a3 = a2 + kstep; const char* b3 = b2 + kstep;
            if (last && has_next) S.a_ready(nxt);
            if constexpr (SP2) {
            PG8_LDB(B0, 0, 0); PG8_LDB(B1, 0, 1); PG8_SCHED; PG8_LDA(At, 0, 0); PG8_STAGE(PG8_SA(1, 1), a1 + hstep, voffA);
            PG8_WAIT_V(8); PG8_WAIT_L(0); PG8_BAR; PG8_MMA(0, 0, At, B0); PG8_MMA(0, 1, At, B1); PG8_BAR; PG8_SCHED;
            PG8_LDA(At, 0, 1); PG8_STAGE(PG8_SB(0, 0), b2, voffB); PG8_STAGE(PG8_SB(0, 1), b2 + hstep, voffB); PG8_STAGE(PG8_SA(0, 0), a2, voffA);
            PG8_WAIT_V(8); PG8_WAIT_L(0); PG8_BAR; PG8_MMA(1, 0, At, B0); PG8_MMA(1, 1, At, B1); PG8_BAR; PG8_SCHED;
            PG8_LDB(B0, 1, 0); PG8_LDB(B1, 1, 1); PG8_SCHED; PG8_LDA(At, 1, 0); PG8_STAGE(PG8_SA(0, 1), a2 + hstep, voffA);
            PG8_WAIT_V(8); PG8_WAIT_L(0); PG8_BAR; PG8_MMA(0, 0, At, B0); PG8_MMA(0, 1, At, B1); PG8_BAR; PG8_SCHED;
            PG8_LDA(At, 1, 1); PG8_STAGE(PG8_SB(1, 0), b3, voffB); PG8_STAGE(PG8_SB(1, 1), b3 + hstep, voffB); PG8_STAGE(PG8_SA(1, 0), a3, voffA);
            PG8_WAIT_V(8); PG8_WAIT_L(0); PG8_BAR; PG8_MMA(1, 0, At, B0); PG8_MMA(1, 1, At, B1); PG8_BAR; PG8_SCHED;
            } else {
            PG8_LDB(B0, 0, 0); PG8_SCHED; PG8_LDA(At, 0, 0); PG8_STAGE(PG8_SA(1, 1), a1 + hstep, voffA);
            PG8_WAIT_L(8); PG8_BAR; PG8_WAIT_L(0); PG8_MMA(0, 0, At, B0); PG8_BAR; PG8_SCHED;
            PG8_LDB(B1, 0, 1); PG8_STAGE(PG8_SB(0, 0), b2, voffB);
            PG8_BAR; PG8_WAIT_L(0); PG8_MMA(0, 1, At, B1); PG8_BAR;
            PG8_LDA(At, 0, 1); PG8_STAGE(PG8_SA(0, 0), a2, voffA);
            PG8_BAR; PG8_WAIT_L(0); PG8_MMA(1, 0, At, B0); PG8_BAR; PG8_SCHED;
            PG8_STAGE(PG8_SB(0, 1), b2 + hstep, voffB);
            PG8_WAIT_V(6); PG8_BAR; PG8_MMA(1, 1, At, B1); PG8_BAR;
            PG8_LDB(B0, 1, 0); PG8_SCHED; PG8_LDA(At, 1, 0); PG8_STAGE(PG8_SA(0, 1), a2 + hstep, voffA);
            PG8_WAIT_L(8); PG8_BAR; PG8_WAIT_L(0); PG8_MMA(0, 0, At, B0); PG8_BAR; PG8_SCHED;
            PG8_LDB(B1, 1, 1); PG8_STAGE(PG8_SB(1, 0), b3, voffB);
            PG8_BAR; PG8_WAIT_L(0); PG8_MMA(0, 1, At, B1); PG8_BAR;
            PG8_LDA(At, 1, 1); PG8_STAGE(PG8_SA(1, 0), a3, voffA);
            PG8_BAR; PG8_WAIT_L(0); PG8_MMA(1, 0, At, B0); PG8_BAR; PG8_SCHED;
            PG8_STAGE(PG8_SB(1, 1), b3 + hstep, voffB);
            PG8_WAIT_V(6); PG8_BAR; PG8_MMA(1, 1, At, B1); PG8_BAR;
            }
        }
        if constexpr (ALIGN_EPI) { if (wr == 0) PG8_BAR; }
        if constexpr (!Epi::AFTER_DRAIN) { E(acc, cur, wr, wc, fr, fq); S.done(cur); }
        if (!has_next) break;
#pragma unroll
        for (int a = 0; a < 2; ++a)
#pragma unroll
            for (int b = 0; b < 2; ++b)
#pragma unroll
                for (int m = 0; m < 4; ++m)
#pragma unroll
                    for (int n = 0; n < 2; ++n) acc[a][b][m][n] = (f32x4){0.f, 0.f, 0.f, 0.f};
        cur = nxt; cA = nA; cB = nB; ++ui;
        if constexpr (ALIGN_EPI) { if (wr == 1) PG8_BAR; }
    }
    PG8_WAIT_V(0);
    if constexpr (!ALIGN_EPI) { if (wr == 0) PG8_BAR; }
    PG8_BAR;
    if constexpr (Epi::AFTER_DRAIN) { E.fused(acc, cur, wr, wc, fr, fq, lds, wid, lane); S.done(cur); }
#undef PG8_SA
#undef PG8_SB
#undef PG8_STAGE
#undef PG8_LDA
#undef PG8_LDB
#undef PG8_MMA
#undef PG8_WAIT_V
#undef PG8_WAIT_L
#undef PG8_BAR
#undef PG8_SCHED
}
}
#define GAS __attribute__((address_space(1)))
#define LAS __attribute__((address_space(3)))
typedef unsigned short bf16;
typedef unsigned v4u __attribute__((ext_vector_type(4)));
typedef float f32x4 __attribute__((ext_vector_type(4)));
typedef short bf16x8 __attribute__((ext_vector_type(8)));
typedef GAS unsigned gu32;
typedef GAS unsigned long long gu64;
#define RLX_AGENT __ATOMIC_RELAXED, __HIP_MEMORY_SCOPE_AGENT
#define LDS_WAIT() asm volatile("s_waitcnt lgkmcnt(0)" ::: "memory")
#define VM_WAIT() asm volatile("s_waitcnt vmcnt(0)" ::: "memory")
__device__ __forceinline__ unsigned long long rt() { return __builtin_amdgcn_s_memrealtime(); }
__device__ __forceinline__ unsigned f2bf(float f) { unsigned u = __builtin_bit_cast(unsigned, f); return (u + 0x7fffu + ((u >> 16) & 1u)) >> 16; }
#ifdef HW_PK2
__device__ __forceinline__ unsigned pk2(float lo, float hi) { unsigned r; asm("v_cvt_pk_bf16_f32 %0, %1, %2" : "=v"(r) : "v"(lo), "v"(hi)); return r; }
#else
__device__ __forceinline__ unsigned pk2(float lo, float hi) { return f2bf(lo) | (f2bf(hi) << 16); }
#endif

#define XB_TMO      128
#define XB_XCNT(j)  (256  + 64 * (j))
#define XB_XSUB(j)  (1280 + 64 * (j))
#define XB_XGEN(j)  (2304 + 64 * (j))
#define XB_TOP      3328
#define XB_TOPGEN   3392
#define XCD_BAR_WORDS 3456
#define XB_SPIN_CAP (1u << 18)

__device__ __forceinline__ unsigned xb_ld(unsigned* p)              { return __hip_atomic_load(p, __ATOMIC_RELAXED, __HIP_MEMORY_SCOPE_AGENT); }
__device__ __forceinline__ unsigned xb_add(unsigned* p, unsigned v) { return __hip_atomic_fetch_add(p, v, __ATOMIC_RELAXED, __HIP_MEMORY_SCOPE_AGENT); }
__device__ __forceinline__ unsigned xb_xcc_id() { return (unsigned)__builtin_amdgcn_s_getreg((3 << 11) | 20) & 0xFu; }
#define XB_SPIN(cond, bar) do { unsigned _sp = 0; while (cond) { __builtin_amdgcn_s_sleep(1); \
    if ((++_sp & 255u) == 0u) { if (xb_ld(&(bar)[XB_TMO])) break; if (_sp > XB_SPIN_CAP) { atomicAdd(&(bar)[XB_TMO], 1u); break; } } } } while (0)

struct XcdBarrier {
    unsigned* bar; unsigned x;
    volatile LAS unsigned* st;
};

__device__ __forceinline__ XcdBarrier xcd_barrier_post(unsigned* bar, volatile LAS unsigned* st) {
    XcdBarrier b; b.bar = bar; b.x = xb_xcc_id(); b.st = st;
    if (threadIdx.x == 0) (void)xb_add(&bar[XB_XCNT(b.x)], 1u);
    return b;
}
__device__ __forceinline__ void xcd_barrier_complete(unsigned* bar, unsigned x, unsigned& nloc, unsigned& nx) {
    const unsigned G = gridDim.x * gridDim.y * gridDim.z;
    unsigned sum, cnt, mine, sp = 0u;
    for (;;) {
        sum = 0u; cnt = 0u; mine = 0u;
#pragma unroll
        for (unsigned j = 0; j < 16; ++j) { const unsigned c = xb_ld(&bar[XB_XCNT(j)]); sum += c; cnt += (c > 0u) ? 1u : 0u; mine = (j == x) ? c : mine; }
        if (sum == G) break;
        __builtin_amdgcn_s_sleep(1);
        if ((++sp & 255u) == 0u) { if (xb_ld(&bar[XB_TMO])) break; if (sp > XB_SPIN_CAP) { atomicAdd(&bar[XB_TMO], 1u); break; } }
    }
    nloc = mine > 0u ? mine : 1u; nx = cnt > 0u ? cnt : 1u;
}

__device__ __forceinline__ void xcd_barrier(const XcdBarrier& b) {
    asm volatile("s_waitcnt vmcnt(0)" ::: "memory");
    __syncthreads();
    if (threadIdx.x == 0) {
        unsigned* bar = b.bar;
        __builtin_amdgcn_s_waitcnt(0);
        unsigned nloc = b.st[0], nx = b.st[1];
        if (nloc == 0u) { xcd_barrier_complete(bar, b.x, nloc, nx); b.st[0] = nloc; b.st[1] = nx; }
        const unsigned old = xb_add(&bar[XB_XSUB(b.x)], 1u);
        const unsigned gen = old / nloc;
        if (old + 1u == (gen + 1u) * nloc) {
            __builtin_amdgcn_fence(__ATOMIC_RELEASE, "agent");
            asm volatile("s_waitcnt vmcnt(0)" ::: "memory");
            const unsigned og = xb_add(&bar[XB_TOP], 1u);
            const unsigned tg = og / nx;
            if (og + 1u == (tg + 1u) * nx) xb_add(&bar[XB_TOPGEN], 1u);
            else XB_SPIN(xb_ld(&bar[XB_TOPGEN]) == tg, bar);
            __builtin_amdgcn_fence(__ATOMIC_ACQUIRE, "agent");
            xb_add(&bar[XB_XGEN(b.x)], 1u);
            asm volatile("s_waitcnt vmcnt(0)" ::: "memory");
        } else {
            XB_SPIN(xb_ld(&bar[XB_XGEN(b.x)]) == gen, bar);
            __builtin_amdgcn_fence(__ATOMIC_ACQUIRE, "agent");
            asm volatile("s_waitcnt vmcnt(0)" ::: "memory");
        }
    }
    __syncthreads();
}

constexpr int NWAVES = 8, NTHR = NWAVES * 64;
constexpr int BATCH = 4, SEQ = 4096, DM = 1024, M = BATCH * SEQ;
constexpr int NPROJ = 3584, INCOLS = 3592;
constexpr int PW = 512;
constexpr int NEXP = 16384, PHEADS = 8, PTOPK = 16;
constexpr float LOG2E = 1.4426950408889634f;
constexpr float NORM_EPS = 1e-6f, SUBLN_EPS = 1e-5f;
constexpr float LAM_INIT = 0.2f;
constexpr float QSCALE = 0.125f * LOG2E;
constexpr float MLK_SCALE = 0.08838834764831845f;

constexpr size_t MiB = 1u << 20;
constexpr size_t WS_CTL = 0, CTL_ZERO_BYTES = 1 * MiB;
constexpr size_t WS_GI = 1 * MiB, WS_GLF = WS_GI + 256 * 1024, WS_A2 = WS_GLF + 256 * 1024, WS_M2 = WS_A2 + 256 * 1024;
constexpr size_t WS_NB2 = 2 * MiB, WS_MLOC = WS_NB2 + 256 * 1024, WS_DN = WS_MLOC + 4096;
constexpr size_t WS_SSP = 3 * MiB;
constexpr size_t WS_WIN = 4 * MiB, WS_WOUT = 11 * MiB, WS_WPQ = 13 * MiB, WS_SUBK = 17 * MiB;
constexpr size_t WS_H1 = 20 * MiB;
constexpr size_t WS_PROJ = 52 * MiB;
constexpr size_t PROJ_STRIDE = (size_t)M * PW;
constexpr size_t WS_X1 = 52 * MiB, WS_X1B = 116 * MiB, WS_QPB = 148 * MiB;
constexpr size_t WS_DCT = 164 * MiB;
constexpr size_t WS_SU = 188 * MiB;
constexpr size_t WS_WL = 180 * MiB;
constexpr size_t WS_UB = 192 * MiB, WS_VB = 208 * MiB;
constexpr size_t WS_PE = 224 * MiB, WS_LIST = 240 * MiB, WS_END = 256 * MiB;
constexpr int CW_ERR = 16, CW_Q = 32, CW_BAR = 4096;

constexpr int RING_BYTES = 131072;
constexpr int MISC_OFF = RING_BYTES;
constexpr int WSCR_OFF = MISC_OFF + 512;
constexpr int XTRA_OFF = WSCR_OFF + 8 * 512;
constexpr int LDS_BYTES = 163840;

struct Frame {
    LAS unsigned char* lds; unsigned char* ldsg;
    volatile LAS unsigned* MISC;
    gu32* ctl;
    int tid, lane, wave, vcu, G, flags;
    const float* in[20]; float* out; unsigned char* ws;
};
#define WSP(T, off) ((T*)(F.ws + (off)))

__device__ __forceinline__ float bf2f(unsigned short b) { return __builtin_bit_cast(float, (unsigned)b << 16); }
template <int CTRL> __device__ __forceinline__ float dppf0(float v) { return __int_as_float(__builtin_amdgcn_mov_dpp(__float_as_int(v), CTRL, 0xf, 0xf, true)); }
#ifdef WRED_DPP
__device__ __forceinline__ float wave_sum(float v) {
    v += dppf0<0xB1>(v); v += dppf0<0x4E>(v); v += dppf0<0x141>(v); v += dppf0<0x140>(v);
    { auto r = __builtin_amdgcn_permlane16_swap(__float_as_uint(v), __float_as_uint(v), false, false); v = __uint_as_float(r[0]) + __uint_as_float(r[1]); }
    { auto r = __builtin_amdgcn_permlane32_swap(__float_as_uint(v), __float_as_uint(v), false, false); v = __uint_as_float(r[0]) + __uint_as_float(r[1]); }
    return v;
}
__device__ __forceinline__ float wave_max(float v) {
    v = fmaxf(v, dppf0<0xB1>(v)); v = fmaxf(v, dppf0<0x4E>(v)); v = fmaxf(v, dppf0<0x141>(v)); v = fmaxf(v, dppf0<0x140>(v));
    { auto r = __builtin_amdgcn_permlane16_swap(__float_as_uint(v), __float_as_uint(v), false, false); v = fmaxf(__uint_as_float(r[0]), __uint_as_float(r[1])); }
    { auto r = __builtin_amdgcn_permlane32_swap(__float_as_uint(v), __float_as_uint(v), false, false); v = fmaxf(__uint_as_float(r[0]), __uint_as_float(r[1])); }
    return v;
}
#else
__device__ __forceinline__ float wave_sum(float v) {
#pragma unroll
    for (int o = 1; o < 64; o <<= 1) v += __shfl_xor(v, o);
    return v;
}
__device__ __forceinline__ float wave_max(float v) {
#pragma unroll
    for (int o = 1; o < 64; o <<= 1) v = fmaxf(v, __shfl_xor(v, o));
    return v;
}

#endif
template <int CTRL> __device__ __forceinline__ float dppf(float v) { return __int_as_float(__builtin_amdgcn_mov_dpp(__float_as_int(v), CTRL, 0xf, 0xf, true)); }
__device__ __forceinline__ float reduce8(const float (&d)[8], int lane) {
    float s[4], t[2];
#pragma unroll
    for (int k = 0; k < 4; ++k) { auto r = __builtin_amdgcn_permlane32_swap(__float_as_uint(d[k]), __float_as_uint(d[k + 4]), false, false); s[k] = __uint_as_float(r[0]) + __uint_as_float(r[1]); }
#pragma unroll
    for (int k = 0; k < 2; ++k) { auto r = __builtin_amdgcn_permlane16_swap(__float_as_uint(s[k]), __float_as_uint(s[k + 2]), false, false); t[k] = __uint_as_float(r[0]) + __uint_as_float(r[1]); }
    const bool b3 = (lane & 8) != 0;
    float r = (b3 ? t[1] : t[0]) + dppf<0x128>(b3 ? t[0] : t[1]);
    r += dppf<0xB1>(r); r += dppf<0x4E>(r); r += dppf<0x141>(r);
    return r;
}

#ifdef PLAIN_LOADS
#define NT_LOAD(p) (*(p))
#else
#define NT_LOAD(p) __builtin_nontemporal_load(p)
#endif
template <int CTRL> __device__ __forceinline__ int dppi(int v) { return __builtin_amdgcn_mov_dpp(v, CTRL, 0xf, 0xf, true); }
__device__ __forceinline__ int reduce8i(const int (&d)[8], int lane) {
    int s[4], t[2];
#pragma unroll
    for (int k = 0; k < 4; ++k) { auto r = __builtin_amdgcn_permlane32_swap((unsigned)d[k], (unsigned)d[k + 4], false, false); s[k] = (int)(r[0] + r[1]); }
#pragma unroll
    for (int k = 0; k < 2; ++k) { auto r = __builtin_amdgcn_permlane16_swap((unsigned)s[k], (unsigned)s[k + 2], false, false); t[k] = (int)(r[0] + r[1]); }
    const bool b3 = (lane & 8) != 0;
    int r = (b3 ? t[1] : t[0]) + dppi<0x128>(b3 ? t[0] : t[1]);
    r += dppi<0xB1>(r); r += dppi<0x4E>(r); r += dppi<0x141>(r);
    return r;
}
__device__ __forceinline__ int dot4_0(unsigned a, unsigned b) { int r; asm("v_dot4_i32_i8 %0, %1, %2, 0" : "=v"(r) : "v"(a), "v"(b)); return r; }

__device__ __forceinline__ void p0_transpose_item(const float* W, int ldw, int K, int nblk, bf16* WT, const float* kscale, LAS float* scr, int item, int lane) {
    const int kb = item / nblk, nb = item % nblk, k0 = 64 * kb, n0 = 32 * nb;
    float v[32];
#pragma unroll
    for (int i = 0; i < 32; ++i) v[i] = W[(size_t)(k0 + 2 * i + (lane >> 5)) * ldw + n0 + (lane & 31)];
#pragma unroll
    for (int i = 0; i < 32; ++i) { const int kk = 2 * i + (lane >> 5); scr[kk * 33 + (lane & 31)] = kscale ? v[i] * kscale[k0 + kk] : v[i]; }
    LDS_WAIT(); asm volatile("" ::: "memory");
    const int c = lane & 7;
#pragma unroll
    for (int j = 0; j < 4; ++j) { const int n = (lane >> 3) + 8 * j; const LAS float* s = scr + (8 * c) * 33 + n;
        v4u o; o.x = pk2(s[0 * 33], s[1 * 33]); o.y = pk2(s[2 * 33], s[3 * 33]); o.z = pk2(s[4 * 33], s[5 * 33]); o.w = pk2(s[6 * 33], s[7 * 33]);
        *(GAS v4u*)(WT + (size_t)(n0 + n) * K + k0 + 8 * c) = o; }
    LDS_WAIT(); asm volatile("" ::: "memory");
}
__device__ __forceinline__ float log_sigmoid(float f) { return fminf(f, 0.f) - log1pf(expf(-fabsf(f))); }

__device__ __forceinline__ void cvt_small_weights(Frame& F, int bi, int nblk) {
    const float* w_out = F.in[13]; const float* g2 = F.in[14]; const float* w_pq = F.in[15]; const float* sk = F.in[16];
    LAS float* scr = (LAS float*)(F.lds + F.wave * 8448);
    const int gw = bi * NWAVES + F.wave, NGW = nblk * NWAVES;
    constexpr int I_OUT = 16 * 32, I_PQ = 16 * 64;
    for (int it = gw; it < I_OUT + I_PQ; it += NGW) {
        if (it < I_OUT) p0_transpose_item(w_out, DM, DM, 32, WSP(bf16, WS_WOUT), nullptr, scr, it, F.lane);
        else p0_transpose_item(w_pq, 2048, DM, 64, WSP(bf16, WS_WPQ), g2, scr, it - I_OUT, F.lane); }
    bf16* SK = WSP(bf16, WS_SUBK);
    for (int i = bi * NTHR + F.tid; i < 262144 / 8; i += nblk * NTHR) { const f32x4 a = ((const f32x4*)sk)[2 * i], b = ((const f32x4*)sk)[2 * i + 1];
        v4u o; o.x = pk2(a[0], a[1]); o.y = pk2(a[2], a[3]); o.z = pk2(b[0], b[1]); o.w = pk2(b[2], b[3]); ((v4u*)SK)[i] = o; }
}
__device__ __forceinline__ void p0_prologue(Frame& F) {
    const float* x = F.in[0]; const float* g1 = F.in[1]; const float* w_in = F.in[2];
    LAS float* wg = (LAS float*)(F.lds + 98304);
    { float t[16];
#pragma unroll
      for (int i = 0; i < 16; ++i) { const int e = F.tid + i * NTHR; t[i] = w_in[(size_t)(e >> 3) * INCOLS + NPROJ + (e & 7)]; }
#pragma unroll
#ifdef WG_SWZ
      for (int i = 0; i < 16; ++i) { const int e_ = F.tid + i * NTHR, el = e_ >> 3, gt_ = e_ & 7; wg[((((el >> 8) * 4 + (el & 3)) * 2 + (gt_ >> 2)) * 64 + ((el & 255) >> 2)) * 4 + (gt_ & 3)] = t[i]; } }
#else
      for (int i = 0; i < 16; ++i) wg[F.tid + i * NTHR] = t[i]; }
#endif
    LAS float* scr = (LAS float*)(F.lds + F.wave * 8448);
    const int gw = F.vcu * NWAVES + F.wave, NGW = F.G * NWAVES;
    constexpr int I_IN = 16 * (NPROJ / 32);
    for (int it = gw; it < I_IN; it += NGW) p0_transpose_item(w_in, INCOLS, DM, NPROJ / 32, WSP(bf16, WS_WIN), nullptr, scr, it, F.lane);
    __syncthreads();
    const float* b_i = F.in[5]; const float* b_f = F.in[6];
    float* GI = WSP(float, WS_GI); float* GLF = WSP(float, WS_GLF); bf16* H1 = WSP(bf16, WS_H1);
    f32x4 gv[4];
#pragma unroll
    for (int j = 0; j < 4; ++j) gv[j] = ((const f32x4*)g1)[F.lane + 64 * j];
    const int gsel = F.lane >> 3; const float gbias = (gsel < 4) ? b_i[gsel] : b_f[gsel - 4];
#ifdef P0_PREF3
    f32x4 nv[4], nv1[4], nv2[4];
    { const int m0 = gw < M ? gw : M - 1, m1 = gw + NGW < M ? gw + NGW : m0, m2 = gw + 2 * NGW < M ? gw + 2 * NGW : m0;
      const f32x4* x0 = (const f32x4*)(x + (size_t)m0 * DM) + F.lane; const f32x4* x1 = (const f32x4*)(x + (size_t)m1 * DM) + F.lane; const f32x4* x2 = (const f32x4*)(x + (size_t)m2 * DM) + F.lane;
#pragma unroll
      for (int j = 0; j < 4; ++j) nv[j] = NT_LOAD(x0 + 64 * j);
#pragma unroll
      for (int j = 0; j < 4; ++j) nv1[j] = NT_LOAD(x1 + 64 * j);
#pragma unroll
      for (int j = 0; j < 4; ++j) nv2[j] = NT_LOAD(x2 + 64 * j); }
    for (int m = gw; m < M; m += NGW) {
        f32x4 v[4]; float s = 0.f;
#pragma unroll
        for (int j = 0; j < 4; ++j) { v[j] = nv[j]; s += (v[j][0] * v[j][0] + v[j][1] * v[j][1]) + (v[j][2] * v[j][2] + v[j][3] * v[j][3]); }
        { const int m3 = m + 3 * NGW < M ? m + 3 * NGW : m; const f32x4* xr = (const f32x4*)(x + (size_t)m3 * DM) + F.lane;
#pragma unroll
          for (int j = 0; j < 4; ++j) { nv[j] = nv1[j]; nv1[j] = nv2[j]; nv2[j] = NT_LOAD(xr + 64 * j); } }
#else
    f32x4 nv[4];
    if (gw < M) { const f32x4* xr = (const f32x4*)(x + (size_t)gw * DM) + F.lane;
#pragma unroll
        for (int j = 0; j < 4; ++j) nv[j] = NT_LOAD(xr + 64 * j); }
    for (int m = gw; m < M; m += NGW) {
        f32x4 v[4]; float s = 0.f;
#pragma unroll
        for (int j = 0; j < 4; ++j) { v[j] = nv[j]; s += (v[j][0] * v[j][0] + v[j][1] * v[j][1]) + (v[j][2] * v[j][2] + v[j][3] * v[j][3]); }
        if (m + NGW < M) { const f32x4* xr = (const f32x4*)(x + (size_t)(m + NGW) * DM) + F.lane;
#pragma unroll
            for (int j = 0; j < 4; ++j) nv[j] = NT_LOAD(xr + 64 * j); }
#endif
        const float rstd = 1.0f / sqrtf(wave_sum(s) * (1.f / DM) + NORM_EPS);
        float ga[8];
#pragma unroll
        for (int g = 0; g < 8; ++g) ga[g] = 0.f;
        unsigned long long* o8 = (unsigned long long*)(H1 + (size_t)m * DM) + F.lane;
#pragma unroll
        for (int j = 0; j < 4; ++j) { v[j] = v[j] * rstd * gv[j];
            o8[64 * j] = (unsigned long long)pk2(v[j][0], v[j][1]) | ((unsigned long long)pk2(v[j][2], v[j][3]) << 32);
#pragma unroll
#ifdef WG_SWZ
            for (int i = 0; i < 4; ++i) { const f32x4 w0 = *(const LAS f32x4*)(wg + (((j * 4 + i) * 2 + 0) * 64 + F.lane) * 4), w1 = *(const LAS f32x4*)(wg + (((j * 4 + i) * 2 + 1) * 64 + F.lane) * 4);
#else
            for (int i = 0; i < 4; ++i) { const int e = 4 * F.lane + 256 * j + i; const f32x4 w0 = *(const LAS f32x4*)(wg + e * 8), w1 = *(const LAS f32x4*)(wg + e * 8 + 4);
#endif
                ga[0] += v[j][i] * w0[0]; ga[1] += v[j][i] * w0[1]; ga[2] += v[j][i] * w0[2]; ga[3] += v[j][i] * w0[3];
                ga[4] += v[j][i] * w1[0]; ga[5] += v[j][i] * w1[1]; ga[6] += v[j][i] * w1[2]; ga[7] += v[j][i] * w1[3]; } }
        const float gt = reduce8(ga, F.lane) + gbias;
        if ((F.lane & 7) == 0) { const int b = m / SEQ, t = m % SEQ; const size_t o = (size_t)(b * 4 + (gsel & 3)) * SEQ + t;
            if (gsel < 4) GI[o] = gt; else GLF[o] = log_sigmoid(gt); }
    }
}
__device__ __forceinline__ void cvt_peer_tables(Frame& F, int quota) {
    const float* g2 = F.in[14]; const float* ue = F.in[17]; const float* ve = F.in[18];
    unsigned* U8 = WSP(unsigned, WS_UB); unsigned* V8 = WSP(unsigned, WS_VB);
    constexpr int NROW = NEXP, CH = 64, NCHUNK = 2 * NROW / CH;
    f32x4 sc[4];
#pragma unroll
    for (int q = 0; q < 4; ++q) sc[q] = ((const f32x4*)g2)[F.lane + 64 * q];
#ifdef CVT_CLAIM2
    for (int nq = 0; nq < quota; ++nq) {
        if ((nq & 1) == 0) { if (F.tid == 0) F.MISC[17] = __hip_atomic_fetch_add(F.ctl + CW_Q + 1, 2u, __ATOMIC_RELAXED, __HIP_MEMORY_SCOPE_AGENT);
            __syncthreads(); }
        const int ck = (int)F.MISC[17] + (nq & 1);
        if (nq & 1) __syncthreads();
        if (ck >= NCHUNK) break;
#else
    for (int nq = 0; nq < quota; ++nq) {
        if (F.tid == 0) F.MISC[17] = __hip_atomic_fetch_add(F.ctl + CW_Q + 1, 1u, __ATOMIC_RELAXED, __HIP_MEMORY_SCOPE_AGENT);
        __syncthreads();
        const int ck = (int)F.MISC[17];
        __syncthreads();
        if (ck >= NCHUNK) break;
#endif
#pragma unroll 1
#ifndef CVT_RIF
#define CVT_RIF 2
#endif
        for (int r0 = ck * CH + F.wave; r0 < (ck + 1) * CH; r0 += CVT_RIF * NWAVES) {
            f32x4 v[CVT_RIF][4];
#pragma unroll
            for (int u = 0; u < CVT_RIF; ++u) { const int r = r0 + u * NWAVES; const f32x4* src = (const f32x4*)((r < NROW ? ue : ve) + (size_t)(r < NROW ? r : r - NROW) * DM) + F.lane;
#pragma unroll
                for (int q = 0; q < 4; ++q) v[u][q] = NT_LOAD(src + 64 * q); }
#pragma unroll
            for (int u = 0; u < CVT_RIF; ++u) { const int r = r0 + u * NWAVES; const bool isu = r < NROW; unsigned* dst = (isu ? U8 : V8) + (size_t)(isu ? r : r - NROW) * (DM / 4) + F.lane;
                {
                    f32x4 w[4]; float mx = 0.f;
#pragma unroll
                    for (int q = 0; q < 4; ++q) { w[q] = isu ? v[u][q] * sc[q] : v[u][q]; mx = fmaxf(fmaxf(mx, fmaxf(fabsf(w[q][0]), fabsf(w[q][1]))), fmaxf(fabsf(w[q][2]), fabsf(w[q][3]))); }
#ifdef PG_U4
                    if (isu) {
                        float ss = 0.f;
#pragma unroll
                        for (int q = 0; q < 4; ++q) ss += (w[q][0] * w[q][0] + w[q][1] * w[q][1]) + (w[q][2] * w[q][2] + w[q][3] * w[q][3]);
                        ss = wave_sum(ss); mx = wave_max(mx);
                        float step = fminf(mx * (1.0f / 7.5f), 0.3352f * sqrtf(ss * (1.0f / 1024.0f))); if (!(step > 0.f)) step = 1.0f;
                        const float inv4 = 1.0f / step;
                        if (F.lane == 0) WSP(float, WS_SU)[r] = step;
                        unsigned* dst4 = U8 + (size_t)r * (DM / 8) + (F.lane >> 1);
#pragma unroll
                        for (int q = 0; q < 4; ++q) { unsigned n = 0;
#pragma unroll
                            for (int e = 0; e < 4; ++e) { int m = (int)floorf(w[q][e] * inv4) + 8; m = m < 0 ? 0 : (m > 15 ? 15 : m); n |= (unsigned)m << (8 * e); }
                            const unsigned pn = (unsigned)__builtin_amdgcn_mov_dpp((int)n, 0xB1, 0xf, 0xf, true);
                            if (!(F.lane & 1)) dst4[32 * q] = n | (pn << 4); }
                        continue; }
#endif
                    mx = wave_max(mx); const float su = mx > 0.f ? mx * (1.0f / 127.0f) : 1.0f, inv = 1.0f / su;
                    if (F.lane == 0) WSP(float, WS_SU)[r] = su;
#ifdef VPERM
                    { v4u pk_;
#pragma unroll
                      for (int q = 0; q < 4; ++q) { const int q0 = (int)rintf(w[q][0] * inv), q1 = (int)rintf(w[q][1] * inv), q2 = (int)rintf(w[q][2] * inv), q3 = (int)rintf(w[q][3] * inv);
                          pk_[q] = (unsigned)(q0 & 255) | ((unsigned)(q1 & 255) << 8) | ((unsigned)(q2 & 255) << 16) | ((unsigned)q3 << 24); }
                      if (isu) { dst[0] = pk_[0]; dst[64] = pk_[1]; dst[128] = pk_[2]; dst[192] = pk_[3]; } else *(v4u*)(dst + 3 * F.lane) = pk_; }
#else
#pragma unroll
                    for (int q = 0; q < 4; ++q) { const int q0 = (int)rintf(w[q][0] * inv), q1 = (int)rintf(w[q][1] * inv), q2 = (int)rintf(w[q][2] * inv), q3 = (int)rintf(w[q][3] * inv);
                        dst[64 * q] = (unsigned)(q0 & 255) | ((unsigned)(q1 & 255) << 8) | ((unsigned)(q2 & 255) << 16) | ((unsigned)q3 << 24); }
#endif
                } }
        }
    }
}

__device__ __forceinline__ void gate_scan(Frame& F, int bh) {
    const float* gi = WSP(float, WS_GI) + (size_t)bh * SEQ + 64 * F.lane; const float* glf = WSP(float, WS_GLF) + (size_t)bh * SEQ + 64 * F.lane;
    float* A2 = WSP(float, WS_A2) + (size_t)bh * SEQ + 64 * F.lane; float* M2 = WSP(float, WS_M2) + (size_t)bh * SEQ + 64 * F.lane; float* NB2 = WSP(float, WS_NB2) + (size_t)bh * SEQ + 64 * F.lane;
    float tot = 0.f;
    for (int j = 0; j < 16; ++j) { const f32x4 v = ((const f32x4*)glf)[j]; tot += v[0]; tot += v[1]; tot += v[2]; tot += v[3]; }
    float inc = tot;
#pragma unroll
    for (int o = 1; o < 64; o <<= 1) { const float u = __shfl_up(inc, o); if (F.lane >= o) inc += u; }
    const float boff = inc - tot;
    float B = boff, lm = -3.0e38f;
    for (int j = 0; j < 16; ++j) { const f32x4 v = ((const f32x4*)glf)[j], iv = ((const f32x4*)gi)[j];
#pragma unroll
        for (int i = 0; i < 4; ++i) { B += v[i]; lm = fmaxf(lm, iv[i] - B); } }
    float incm = lm;
#pragma unroll
    for (int o = 1; o < 64; o <<= 1) { const float u = __shfl_up(incm, o); if (F.lane >= o) incm = fmaxf(incm, u); }
    float pm = __shfl_up(incm, 1); if (F.lane == 0) pm = -3.0e38f;
    B = boff; float Mx = pm;
    for (int j = 0; j < 16; ++j) { const f32x4 v = ((const f32x4*)glf)[j], iv = ((const f32x4*)gi)[j]; f32x4 oa, om, ob;
#pragma unroll
        for (int i = 0; i < 4; ++i) { B += v[i]; const float a = iv[i] - B; Mx = fmaxf(Mx, a); oa[i] = a * LOG2E; om[i] = Mx * LOG2E; ob[i] = -(B + Mx) * LOG2E; }
        ((f32x4*)A2)[j] = oa; ((f32x4*)M2)[j] = om; ((f32x4*)NB2)[j] = ob; }
}

namespace att {
using s16x4 = __attribute__((ext_vector_type(4))) short;
using f32x16 = __attribute__((ext_vector_type(16))) float;
using u32x4 = __attribute__((ext_vector_type(4))) unsigned;
constexpr int SHM_T = 64 * 128 * 2;
#define KSWZ(row, colB) ((row) * 256 + ((colB) ^ (((row) & 7) << 4)))
#define SBAR() __builtin_amdgcn_sched_barrier(0)
#define MFMA32(a, b, c) __builtin_amdgcn_mfma_f32_32x32x16_bf16((a), (b), (c), 0, 0, 0)
__device__ __forceinline__ int crow(int r, int hi) { return (r & 3) + 8 * (r >> 2) + 4 * hi; }
#ifdef NATIVE_CVT
typedef float f32x2cv __attribute__((ext_vector_type(2))); typedef __bf16 bf16x2cv __attribute__((ext_vector_type(2)));
__device__ __forceinline__ unsigned cvtpk(float lo, float hi) { const f32x2cv v = {lo, hi}; const bf16x2cv b = __builtin_convertvector(v, bf16x2cv); return __builtin_bit_cast(unsigned, b); }
#else
__device__ __forceinline__ unsigned cvtpk(float lo, float hi) { unsigned r; asm volatile("v_cvt_pk_bf16_f32 %0, %1, %2" : "=v"(r) : "v"(lo), "v"(hi)); return r; }
#endif
__device__ __forceinline__ int v_st(int k, int c) { const int kk = (k & ~0xC) | ((k & 4) << 1) | ((k & 8) >> 1); return ((kk >> 3) * 4 + (c >> 5)) * 512 + ((kk & 7) * 32 + (c & 31)) * 2; }
__device__ __forceinline__ int v_rd_base(int lane) { return ((lane & 3) << 3) | (((lane >> 2) & 3) << 6) | (((lane >> 4) & 1) << 5) | (((lane >> 5) & 1) << 8); }
constexpr int v_rd_off(int d0, int ks, int half) { return d0 * 512 + ks * 4096 + half * 2048; }
template <int OFF> __device__ __forceinline__ s16x4 tr_read(int vb) { s16x4 r; asm volatile("ds_read_b64_tr_b16 %0, %1 offset:%2" : "=&v"(r) : "v"(vb), "i"(OFF) : "memory"); return r; }
#define PKF(L, H) (bf16x8){L[0], L[1], L[2], L[3], H[0], H[1], H[2], H[3]}
template <int D0, int KS> __device__ __forceinline__ bf16x8 tr_frag(int vb) {
    const s16x4 l = tr_read<v_rd_off(D0, KS, 0)>(vb), h = tr_read<v_rd_off(D0, KS, 1)>(vb); asm volatile("s_waitcnt lgkmcnt(0)" ::: "memory"); return PKF(l, h); }
template <int D0> __device__ __forceinline__ void pv_one(f32x16& od, int vb, bf16x8 pa0, bf16x8 pa1, bf16x8 pa2, bf16x8 pa3) {
    const s16x4 l0 = tr_read<v_rd_off(D0, 0, 0)>(vb), h0 = tr_read<v_rd_off(D0, 0, 1)>(vb), l1 = tr_read<v_rd_off(D0, 1, 0)>(vb), h1 = tr_read<v_rd_off(D0, 1, 1)>(vb);
    const s16x4 l2 = tr_read<v_rd_off(D0, 2, 0)>(vb), h2 = tr_read<v_rd_off(D0, 2, 1)>(vb), l3 = tr_read<v_rd_off(D0, 3, 0)>(vb), h3 = tr_read<v_rd_off(D0, 3, 1)>(vb);
    asm volatile("s_waitcnt lgkmcnt(0)" ::: "memory"); SBAR();
    od = MFMA32(pa0, PKF(l0, h0), od); od = MFMA32(pa1, PKF(l1, h1), od); od = MFMA32(pa2, PKF(l2, h2), od); od = MFMA32(pa3, PKF(l3, h3), od);
}
__device__ __forceinline__ void pv_d0(f32x16* o, int vb, bf16x8 pa0, bf16x8 pa1, bf16x8 pa2, bf16x8 pa3) {
    pv_one<0>(o[0], vb, pa0, pa1, pa2, pa3); pv_one<1>(o[1], vb, pa0, pa1, pa2, pa3); pv_one<2>(o[2], vb, pa0, pa1, pa2, pa3); pv_one<3>(o[3], vb, pa0, pa1, pa2, pa3);
}
__device__ __forceinline__ void pack_p(const f32x16& p0, const f32x16& p1, bf16x8& pa0, bf16x8& pa1, bf16x8& pa2, bf16x8& pa3) {
#define PK4(P, BASE, OUT) do { unsigned a0 = cvtpk(P[BASE + 0], P[BASE + 1]), a1 = cvtpk(P[BASE + 2], P[BASE + 3]);   \
    unsigned b0 = cvtpk(P[BASE + 4], P[BASE + 5]), b1 = cvtpk(P[BASE + 6], P[BASE + 7]);                              \
    auto r0 = __builtin_amdgcn_permlane32_swap(a0, b0, false, false); auto r1 = __builtin_amdgcn_permlane32_swap(a1, b1, false, false); \
    u32x4 w = {r0[0], r1[0], r0[1], r1[1]}; OUT = __builtin_bit_cast(bf16x8, w); } while (0)
    PK4(p0, 0, pa0); PK4(p0, 8, pa1); PK4(p1, 0, pa2); PK4(p1, 8, pa3);
#undef PK4
}
__device__ __forceinline__ float half_swap_max(float v) { auto rr = __builtin_amdgcn_permlane32_swap(__float_as_uint(v), __float_as_uint(v), false, false); return fmaxf(__uint_as_float(rr[0]), __uint_as_float(rr[1])); }
__device__ __forceinline__ float half_swap_add(float v) { auto rr = __builtin_amdgcn_permlane32_swap(__float_as_uint(v), __float_as_uint(v), false, false); return __uint_as_float(rr[0]) + __uint_as_float(rr[1]); }
__device__ __forceinline__ float half_sum32(float v) {
#ifdef HSUM_DPP
    v += dppf<0xB1>(v); v += dppf<0x4E>(v); v += dppf<0x141>(v); v += dppf<0x140>(v);
    auto rr = __builtin_amdgcn_permlane16_swap(__float_as_uint(v), __float_as_uint(v), false, false);
    return __uint_as_float(rr[0]) + __uint_as_float(rr[1]);
#else
#pragma unroll
    for (int o = 1; o < 32; o <<= 1) v += __shfl_xor(v, o);
    return v;
#endif
}

constexpr float THR2 = 10.f;
__device__ __forceinline__ void partialSM(f32x16& p0, f32x16& p1, float& m_reg, float& alpha, float Tj, bool domask, int key0, int qrow, int hi) {
    if (domask) {
#pragma unroll
        for (int r = 0; r < 16; ++r) { const int kv = key0 + crow(r, hi); if (kv > qrow) p0[r] = -INFINITY; if (kv + 32 > qrow) p1[r] = -INFINITY; }
    }
    float pmax = p0[0];
#pragma unroll
    for (int r = 1; r < 16; ++r) pmax = fmaxf(pmax, p0[r]);
#pragma unroll
    for (int r = 0; r < 16; ++r) pmax = fmaxf(pmax, p1[r]);
    pmax = half_swap_max(pmax) + Tj;
    float mn;
    if (__builtin_expect(__all(pmax - m_reg <= THR2), 1)) { mn = m_reg; alpha = 1.f; }
    else { mn = fmaxf(m_reg, pmax); alpha = __builtin_amdgcn_exp2f(m_reg - mn); m_reg = mn; }
    const float off = Tj - mn;
#pragma unroll
    for (int r = 0; r < 16; ++r) p0[r] += off;
#pragma unroll
    for (int r = 0; r < 16; ++r) p1[r] += off;
#pragma unroll
    for (int r = 0; r < 16; ++r) p0[r] = __builtin_amdgcn_exp2f(p0[r]);
}
__device__ __forceinline__ void finishSM(f32x16& p0, f32x16& p1, float alpha, float& l_reg, bf16x8& pa0, bf16x8& pa1, bf16x8& pa2, bf16x8& pa3) {
#pragma unroll
    for (int r = 0; r < 16; ++r) p1[r] = __builtin_amdgcn_exp2f(p1[r]);
    float ps = 0;
#pragma unroll
    for (int r = 0; r < 16; ++r) ps += p0[r];
#pragma unroll
    for (int r = 0; r < 16; ++r) ps += p1[r];
    ps = half_swap_add(ps);
    l_reg = l_reg * alpha + ps;
    pack_p(p0, p1, pa0, pa1, pa2, pa3);
}
__device__ __forceinline__ void qkt4(f32x16& p0, f32x16& p1, const LAS char* Ks, const LAS char* fs, int r32, int hi, int cbase) {
    const bf16x8 kx0 = *(const LAS bf16x8*)(fs + 4096), kx1 = *(const LAS bf16x8*)(fs + 5120), qx = *(const LAS bf16x8*)(fs + 6144);
    p0 = MFMA32(kx0, qx, f32x16{}); p1 = MFMA32(kx1, qx, f32x16{});
#pragma unroll
    for (int d0 = 0; d0 < 4; ++d0) { const int cb = cbase + (d0 * 16 + hi * 8) * 2; const bf16x8 qf = *(const LAS bf16x8*)(fs + d0 * 1024);
        const bf16x8 b0 = *(const LAS bf16x8*)(Ks + KSWZ(r32, cb)); const bf16x8 b1 = *(const LAS bf16x8*)(Ks + KSWZ(32 + r32, cb));
        p0 = MFMA32(b0, qf, p0); p1 = MFMA32(b1, qf, p1); }
}

__device__ __forceinline__ void store_rows(const f32x16 (&o)[4], const float (&rs)[16], const float* colscale, LAS float* stg, bf16* dst, int ldd, const bf16* gate, int ldg, int lane, const float* csp = nullptr) {
    const int r32 = lane & 31, hi = lane >> 5;
#ifdef GATE_PRELOAD
    bf16x8 gvp[8];
    if (gate) {
#pragma unroll
        for (int i = 0; i < 8; ++i) { const int p = i * 64 + lane, row = p >> 4, ch = p & 15; gvp[i] = *(const bf16x8*)(gate + (size_t)row * ldg + ch * 8); } }
#endif
#pragma unroll
    for (int d = 0; d < 4; ++d) { const float cs = csp ? csp[d] : colscale[d * 32 + r32];
#pragma unroll
        for (int r = 0; r < 16; ++r) stg[crow(r, hi) * 128 + d * 32 + r32] = o[d][r] * rs[r] * cs; }
    asm volatile("s_waitcnt lgkmcnt(0)" ::: "memory");
#ifdef GATE_PRELOAD
#pragma unroll
#else
#pragma unroll 2
#endif
    for (int i = 0; i < 8; ++i) { const int p = i * 64 + lane, row = p >> 4, ch = p & 15;
        f32x4 a = *(const LAS f32x4*)(stg + row * 128 + ch * 8), b = *(const LAS f32x4*)(stg + row * 128 + ch * 8 + 4);
#ifdef GATE_PRELOAD
        if (gate) { const bf16x8 gv = gvp[i];
#else
        if (gate) { const bf16x8 gv = *(const bf16x8*)(gate + (size_t)row * ldg + ch * 8);
#endif
#pragma unroll
#ifdef FAST_SIG
            for (int k = 0; k < 4; ++k) { a[k] *= __builtin_amdgcn_rcpf(1.0f + __expf(-bf2f((unsigned short)gv[k]))); b[k] *= __builtin_amdgcn_rcpf(1.0f + __expf(-bf2f((unsigned short)gv[4 + k]))); } }
#else
            for (int k = 0; k < 4; ++k) { a[k] = a[k] / (1.0f + __expf(-bf2f((unsigned short)gv[k]))); b[k] = b[k] / (1.0f + __expf(-bf2f((unsigned short)gv[4 + k]))); } }
#endif
        u32x4 w = {cvtpk(a[0], a[1]), cvtpk(a[2], a[3]), cvtpk(b[0], b[1]), cvtpk(b[2], b[3])};
        *(u32x4*)(dst + (size_t)row * ldd + ch * 8) = w; }
}

__device__ __forceinline__ void dattn_unit(Frame& F, int b, int h, int qb, float lam) {
    const int tid = F.tid, wid = F.wave, lane = F.lane, r32 = lane & 31, hi = lane >> 5, c = wid & 1, g = wid >> 1;
    LAS char* lds = (LAS char*)F.lds;
    LAS char* V_lds = lds; LAS char* K_lds = lds + 2 * SHM_T;
    LAS float* ws = (LAS float*)(lds + WSCR_OFF) + wid * 128; LAS float* li_l = ws; LAS float* al_l = ws + 32;
    const bf16* DAQ = WSP(bf16, WS_PROJ); const bf16* DAK = DAQ + PROJ_STRIDE; const bf16* DAV = DAQ + 2 * PROJ_STRIDE;
    const int q0 = qb * 128, rw = q0 + 32 * g + r32;
    const bf16* Qw = DAQ + ((size_t)b * SEQ + rw) * PW + h * 128 + c * 64 + hi * 8;
    bf16x8 qr[4];
#pragma unroll
    for (int d0 = 0; d0 < 4; ++d0) qr[d0] = *(const bf16x8*)(Qw + d0 * 16);
    const bf16* Kh = DAK + (size_t)b * SEQ * PW + h * 128; const bf16* Vh = DAV + (size_t)b * SEQ * PW + h * 128;
    const int NT = (q0 + 128) / 64;
    const float slope2 = __builtin_amdgcn_exp2f(-2.0f * (float)(h + 1)) * LOG2E;
    bf16x8 qx = {0, 0, 0, 0, 0, 0, 0, 0}, kx0 = qx, kx1 = qx;
    { const unsigned short shi = (unsigned short)f2bf(slope2); const unsigned short slo = (unsigned short)f2bf(slope2 - bf2f(shi));
      if (hi == 0) { qx[0] = (short)shi; qx[1] = (short)slo; const short k0 = (short)f2bf((float)r32), k1 = (short)f2bf((float)(32 + r32)); kx0[0] = k0; kx0[1] = k0; kx1[0] = k1; kx1[1] = k1; } }
    LAS char* fs = lds + 65536 + wid * 8192 + lane * 16;
    float m_reg = -1e30f, l_reg = 0; f32x16 o[4] = {};
    const int sr = tid >> 4, sc = (tid & 15) * 8, vst0 = v_st(sr, sc), vst1 = v_st(32 + sr, sc);
    const int vb0 = (int)(uintptr_t)V_lds + v_rd_base(lane);
    struct { bf16x8 vs0, vs1, ks0, ks1; } sr_[1];
#define SLOAD(i, k0) do { sr_[i].vs0 = *(const bf16x8*)(&Vh[(size_t)((k0) + sr) * PW + sc]); sr_[i].vs1 = *(const bf16x8*)(&Vh[(size_t)((k0) + 32 + sr) * PW + sc]); \
    sr_[i].ks0 = *(const bf16x8*)(&Kh[(size_t)((k0) + sr) * PW + sc]); sr_[i].ks1 = *(const bf16x8*)(&Kh[(size_t)((k0) + 32 + sr) * PW + sc]); } while (0)
#define SWRITE(bf, i) do { *(LAS bf16x8*)(V_lds + (bf) * SHM_T + vst0) = sr_[i].vs0; *(LAS bf16x8*)(V_lds + (bf) * SHM_T + vst1) = sr_[i].vs1; const int kc = sc * 2; \
    *(LAS bf16x8*)(K_lds + (bf) * SHM_T + KSWZ(sr, kc)) = sr_[i].ks0; *(LAS bf16x8*)(K_lds + (bf) * SHM_T + KSWZ(32 + sr, kc)) = sr_[i].ks1; } while (0)
#define SWAIT() asm volatile("s_waitcnt vmcnt(0)" ::: "memory")
#define RESC(a) do { if (__any((a) < 1.f)) { if (hi == 0) al_l[r32] = (a); asm volatile("s_waitcnt lgkmcnt(0)" ::: "memory"); \
    _Pragma("unroll") for (int d = 0; d < 4; ++d) _Pragma("unroll") for (int r = 0; r < 16; ++r) o[d][r] *= al_l[crow(r, hi)]; } } while (0)
#define TJ(j) (slope2 * 64.f * (float)((j) - NT))
    f32x16 pA0, pA1, pB0, pB1; float alA = 1.f, alB = 1.f; bf16x8 pa0, pa1, pa2, pa3; const int cbase = c * 128;
    LAS float* kmx = (LAS float*)(lds + XTRA_OFF);
    float qn_w;
    { float s = 0.f;
#pragma unroll
      for (int d0 = 0; d0 < 4; ++d0)
#pragma unroll
          for (int e = 0; e < 8; ++e) { const float v = bf2f((unsigned short)qr[d0][e]); s += v * v; }
      s = half_swap_add(s);
#pragma unroll
      for (int o = 1; o < 32; o <<= 1) s = fmaxf(s, __shfl_xor(s, o));
      qn_w = __int_as_float(__builtin_amdgcn_readfirstlane(__float_as_int(sqrtf(s)))); }
#pragma unroll
    for (int d0 = 0; d0 < 4; ++d0) *(LAS bf16x8*)(fs + d0 * 1024) = qr[d0];
    *(LAS bf16x8*)(fs + 4096) = kx0; *(LAS bf16x8*)(fs + 5120) = kx1; *(LAS bf16x8*)(fs + 6144) = qx;
    asm volatile("s_waitcnt lgkmcnt(0)" ::: "memory");
#define KNORM(bf, i) do { float n0 = 0.f, n1 = 0.f; \
    _Pragma("unroll") for (int e = 0; e < 8; ++e) { const float a = bf2f((unsigned short)sr_[i].ks0[e]), b2 = bf2f((unsigned short)sr_[i].ks1[e]); n0 += a * a; n1 += b2 * b2; } \
    n0 += __shfl_xor(n0, 1); n1 += __shfl_xor(n1, 1); n0 += __shfl_xor(n0, 2); n1 += __shfl_xor(n1, 2); n0 += __shfl_xor(n0, 4); n1 += __shfl_xor(n1, 4);     \
    n0 = fmaxf(n0, n1); n0 = fmaxf(n0, __shfl_xor(n0, 16)); n0 = fmaxf(n0, __shfl_xor(n0, 32));                                                                 \
    if ((lane & 7) == 0 && lane < 16) kmx[(bf) * 16 + (lane >> 3) * 8 + wid] = sqrtf(n0); } while (0)
#ifndef DATT_SKIP
#undef KNORM
#define KNORM(bf, i) do { } while (0)
#endif
#define DECIDE(j, bf) ({ const LAS f32x4* kp_ = (const LAS f32x4*)(kmx + (bf) * 16 + c * 8); const f32x4 ka_ = kp_[0], kb_ = kp_[1]; \
    const float km_ = fmaxf(fmaxf(fmaxf(ka_[0], ka_[1]), fmaxf(ka_[2], ka_[3])), fmaxf(fmaxf(kb_[0], kb_[1]), fmaxf(kb_[2], kb_[3]))); \
    float mm_ = m_reg; _Pragma("unroll") for (int o_ = 1; o_ < 32; o_ <<= 1) mm_ = fminf(mm_, __shfl_xor(mm_, o_)); \
    const float ub_ = qn_w * km_ + slope2 * 63.f + TJ(j); __builtin_amdgcn_readfirstlane((int)(ub_ < mm_ - 60.f)) != 0; })
#ifndef DATT_SKIP
#undef DECIDE
#define DECIDE(j, bf) false
#endif
#define TL(i) (NT - 1 - (i))
    constexpr int SE = 0, SO = 0;
    bool skA = false, skB = false;
#ifdef ATT_PRO2
    { struct { bf16x8 vs0, vs1, ks0, ks1; } sp2;
      SLOAD(SE, TL(0) * 64);
      sp2.vs0 = *(const bf16x8*)(&Vh[(size_t)(TL(1) * 64 + sr) * PW + sc]); sp2.vs1 = *(const bf16x8*)(&Vh[(size_t)(TL(1) * 64 + 32 + sr) * PW + sc]);
      sp2.ks0 = *(const bf16x8*)(&Kh[(size_t)(TL(1) * 64 + sr) * PW + sc]); sp2.ks1 = *(const bf16x8*)(&Kh[(size_t)(TL(1) * 64 + 32 + sr) * PW + sc]);
      SWRITE(0, SE); __syncthreads();
      qkt4(pA0, pA1, K_lds, fs, r32, hi, cbase); partialSM(pA0, pA1, m_reg, alA, TJ(TL(0)), true, 64 * TL(0), rw, hi);
      *(LAS bf16x8*)(V_lds + SHM_T + vst0) = sp2.vs0; *(LAS bf16x8*)(V_lds + SHM_T + vst1) = sp2.vs1; { const int kc = sc * 2;
      *(LAS bf16x8*)(K_lds + SHM_T + KSWZ(sr, kc)) = sp2.ks0; *(LAS bf16x8*)(K_lds + SHM_T + KSWZ(32 + sr, kc)) = sp2.ks1; }
      __syncthreads(); }
#else
    SLOAD(SE, TL(0) * 64); asm volatile("s_waitcnt vmcnt(0)" ::: "memory"); SWRITE(0, SE); KNORM(0, SE); __syncthreads();
    qkt4(pA0, pA1, K_lds, fs, r32, hi, cbase); partialSM(pA0, pA1, m_reg, alA, TJ(TL(0)), true, 64 * TL(0), rw, hi);
    SLOAD(SO, TL(1) * 64);
    SWAIT(); SWRITE(1, SO); KNORM(1, SO); __syncthreads();
#endif
    for (int i = 1; i + 1 < NT; i += 2) {
        skB = DECIDE(TL(i), 1);
        SBAR(); if (!skB) qkt4(pB0, pB1, K_lds + SHM_T, fs, r32, hi, cbase);
        if (!skA) finishSM(pA0, pA1, alA, l_reg, pa0, pa1, pa2, pa3); SBAR();
        SLOAD(SO, TL(i + 1) * 64); SBAR();
        if (!skA) pv_d0(o, vb0, pa0, pa1, pa2, pa3);
        alB = 1.f; if (!skB) partialSM(pB0, pB1, m_reg, alB, TJ(TL(i)), i < 2, 64 * TL(i), rw, hi);
        __syncthreads(); SWAIT(); SWRITE(0, SE); KNORM(0, SE);
        RESC(alB); __syncthreads();
        skA = DECIDE(TL(i + 1), 0);
        SBAR(); if (!skA) qkt4(pA0, pA1, K_lds, fs, r32, hi, cbase);
        if (!skB) finishSM(pB0, pB1, alB, l_reg, pa0, pa1, pa2, pa3); SBAR();
        SLOAD(SE, TL(i + 2) * 64); SBAR();
        if (!skB) pv_d0(o, vb0 + SHM_T, pa0, pa1, pa2, pa3);
        alA = 1.f; if (!skA) partialSM(pA0, pA1, m_reg, alA, TJ(TL(i + 1)), false, 64 * TL(i + 1), rw, hi);
        __syncthreads(); SWAIT(); SWRITE(1, SO); KNORM(1, SO);
        RESC(alA); __syncthreads();
    }
    skB = DECIDE(TL(NT - 1), 1);
    SBAR(); if (!skB) qkt4(pB0, pB1, K_lds + SHM_T, fs, r32, hi, cbase);
    if (!skA) finishSM(pA0, pA1, alA, l_reg, pa0, pa1, pa2, pa3); SBAR();
    if (!skA) pv_d0(o, vb0, pa0, pa1, pa2, pa3);
    alB = 1.f; if (!skB) partialSM(pB0, pB1, m_reg, alB, TJ(TL(NT - 1)), NT - 1 < 2, 64 * TL(NT - 1), rw, hi);
    __syncthreads(); RESC(alB);
    if (!skB) { finishSM(pB0, pB1, alB, l_reg, pa0, pa1, pa2, pa3); SBAR();
        pv_d0(o, vb0 + SHM_T, pa0, pa1, pa2, pa3); }
    asm volatile("s_waitcnt vmcnt(0)" ::: "memory");
#undef KNORM
#undef DECIDE
#undef TL
#undef SLOAD
#undef SWRITE
#undef SWAIT
#undef RESC
#undef TJ
#ifdef DATT_NO_EPI
    if (l_reg == 123.f) F.out[tid] = o[0][0] + o[1][1] + o[2][2] + o[3][3];
    return;
#endif
#ifdef DUP_PHASE
    if (F.flags & 4) { if (l_reg == 123.f) F.out[tid] = o[0][0] + o[1][1] + o[2][2] + o[3][3]; __syncthreads(); return; }
#endif
#ifdef EPI_SPLIT
    if (hi == 0) li_l[r32] = l_reg; asm volatile("s_waitcnt lgkmcnt(0)" ::: "memory");
    float rli[16];
#pragma unroll
    for (int r = 0; r < 16; ++r) rli[r] = __builtin_amdgcn_rcpf(li_l[crow(r, hi)]);
#ifdef EPI_STASH
    { LAS float* slot_w = (LAS float*)(lds + 65536 + wid * 8192);
      LAS float* slot_r = (LAS float*)(lds + 65536 + (wid ^ 1) * 8192);
#else
    __syncthreads();
    { LAS float* slot_w = (LAS float*)lds + g * 4096 + c * 2048;
      LAS float* slot_r = (LAS float*)lds + g * 4096 + (c ^ 1) * 2048;
#endif
#pragma unroll
      for (int dd = 0; dd < 2; ++dd) {
#define OTH(r_) (c ? o[dd][r_] : o[2 + dd][r_])
#pragma unroll
          for (int r4 = 0; r4 < 4; ++r4) { const f32x4 w = {OTH(4 * r4) * rli[4 * r4], OTH(4 * r4 + 1) * rli[4 * r4 + 1], OTH(4 * r4 + 2) * rli[4 * r4 + 2], OTH(4 * r4 + 3) * rli[4 * r4 + 3]};
              *(LAS f32x4*)(slot_w + ((dd * 4 + r4) * 64 + lane) * 4) = w; } }
      const float* gsub = F.in[11];
      float csv[2];
#pragma unroll
      for (int dd = 0; dd < 2; ++dd) csv[dd] = gsub[(2 * c + dd) * 32 + r32];
      __syncthreads();
      float v[2][16], ssq[16];
#pragma unroll
      for (int r = 0; r < 16; ++r) ssq[r] = 0.f;
#pragma unroll
      for (int dd = 0; dd < 2; ++dd) {
#pragma unroll
          for (int r4 = 0; r4 < 4; ++r4) { const f32x4 pw = *(const LAS f32x4*)(slot_r + ((dd * 4 + r4) * 64 + lane) * 4);
#pragma unroll
              for (int k = 0; k < 4; ++k) { const int r = 4 * r4 + k; const float own = (c ? o[2 + dd][r] : o[dd][r]) * rli[r];
                  const float val = c == 0 ? own - lam * pw[k] : pw[k] - lam * own;
                  v[dd][r] = val; ssq[r] += val * val; } } }
      LAS float* ws_p = (LAS float*)(lds + WSCR_OFF) + (wid ^ 1) * 128;
#pragma unroll
      for (int r = 0; r < 16; ++r) ssq[r] = half_sum32(ssq[r]);
      if (r32 == 0) {
#pragma unroll
          for (int r4 = 0; r4 < 4; ++r4) *(LAS f32x4*)(ws + 64 + hi * 16 + 4 * r4) = (f32x4){ssq[4 * r4], ssq[4 * r4 + 1], ssq[4 * r4 + 2], ssq[4 * r4 + 3]}; }
      __syncthreads();
#pragma unroll
      for (int r4 = 0; r4 < 4; ++r4) { const f32x4 ps = *(const LAS f32x4*)(ws_p + 64 + hi * 16 + 4 * r4);
#pragma unroll
          for (int k = 0; k < 4; ++k) ssq[4 * r4 + k] = (1.0f - LAM_INIT) * __builtin_amdgcn_rsqf((ssq[4 * r4 + k] + ps[k]) * (1.f / 128.f) + SUBLN_EPS); }
#ifdef EPI_STASH
      LAS float* stg = slot_w;
#else
      LAS float* stg = slot_r;
#endif
#pragma unroll
      for (int dd = 0; dd < 2; ++dd)
#pragma unroll
          for (int r = 0; r < 16; ++r) { const int row = crow(r, hi), col = dd * 32 + r32; stg[row * 64 + (((col >> 3) ^ (row & 7)) << 3) + (col & 7)] = v[dd][r] * ssq[r] * csv[dd]; }
      asm volatile("s_waitcnt lgkmcnt(0)" ::: "memory");
      bf16* MIX = WSP(bf16, WS_H1) + ((size_t)b * SEQ + q0 + 32 * g) * DM + h * 128 + 64 * c;
#pragma unroll
      for (int i = 0; i < 4; ++i) { const int p = i * 64 + lane, row = p >> 3, ch = p & 7;
          const LAS float* sp = stg + row * 64 + ((ch ^ (row & 7)) << 3);
          const f32x4 a4 = *(const LAS f32x4*)sp, b4 = *(const LAS f32x4*)(sp + 4);
          u32x4 w = {cvtpk(a4[0], a4[1]), cvtpk(a4[2], a4[3]), cvtpk(b4[0], b4[1]), cvtpk(b4[2], b4[3])};
          *(u32x4*)(MIX + (size_t)row * DM + ch * 8) = w; } }
#else
    if (hi == 0) li_l[r32] = l_reg; asm volatile("s_waitcnt lgkmcnt(0)" ::: "memory");
    float rli[16];
#pragma unroll
    for (int r = 0; r < 16; ++r) rli[r] = __builtin_amdgcn_rcpf(li_l[crow(r, hi)]);
    __syncthreads();
    LAS float* xb = (LAS float*)lds + g * 4096;
    if (c == 1) {
#pragma unroll
        for (int d = 0; d < 4; ++d)
#pragma unroll
            for (int r = 0; r < 16; ++r) xb[(d * 16 + r) * 64 + lane] = o[d][r] * rli[r];
    }
    __syncthreads();
    if (c == 0) {
        const float* gsub = F.in[11];
#ifdef CS_PRELOAD
        float csv[4];
#pragma unroll
        for (int d = 0; d < 4; ++d) csv[d] = gsub[d * 32 + r32];
#endif
        float ssq[16];
#pragma unroll
        for (int r = 0; r < 16; ++r) ssq[r] = 0.f;
#pragma unroll
        for (int d = 0; d < 4; ++d)
#pragma unroll
            for (int r = 0; r < 16; ++r) { const float v = o[d][r] * rli[r] - lam * xb[(d * 16 + r) * 64 + lane]; o[d][r] = v; ssq[r] += v * v; }
#pragma unroll
#ifdef FAST_SIG
        for (int r = 0; r < 16; ++r) ssq[r] = (1.0f - LAM_INIT) * __builtin_amdgcn_rsqf(half_sum32(ssq[r]) * (1.f / 128.f) + SUBLN_EPS);
#else
        for (int r = 0; r < 16; ++r) ssq[r] = (1.0f - LAM_INIT) / sqrtf(half_sum32(ssq[r]) * (1.f / 128.f) + SUBLN_EPS);
#endif
        bf16* MIX = WSP(bf16, WS_H1) + ((size_t)b * SEQ + q0 + 32 * g) * DM + h * 128;
#ifdef CS_PRELOAD
        store_rows(o, ssq, gsub, xb, MIX, DM, nullptr, 0, lane, csv);
#else
        store_rows(o, ssq, gsub, xb, MIX, DM, nullptr, 0, lane);
#endif
    }
#endif
    __syncthreads();
}

constexpr int MCH = 256, NCH = SEQ / MCH;

__device__ __forceinline__ void conv8(const bf16* raw, size_t rb, int t, int col0, const f32x4 (&w)[4][2], const f32x4 (&bias)[2], float scale, float (&y)[8]) {
    bf16x8 v[4];
#pragma unroll
    for (int j = 0; j < 4; ++j) { const int tt = t - 3 + j; v[j] = *(const bf16x8*)(raw + (rb + (tt < 0 ? 0 : tt)) * PW + col0); }
#pragma unroll
    for (int i = 0; i < 8; ++i) y[i] = bias[i >> 2][i & 3];
#pragma unroll
    for (int j = 0; j < 4; ++j) { const float mk = (t - 3 + j >= 0) ? 1.f : 0.f;
#pragma unroll
        for (int i = 0; i < 8; ++i) y[i] += (w[j][i >> 2][i & 3] * mk) * bf2f((unsigned short)v[j][i]); }
#pragma unroll
#ifdef FAST_SIG
    for (int i = 0; i < 8; ++i) y[i] = y[i] * __builtin_amdgcn_rcpf(1.0f + __expf(-y[i])) * scale;
#else
    for (int i = 0; i < 8; ++i) y[i] = y[i] / (1.0f + __expf(-y[i])) * scale;
#endif
}
template <int N> __device__ __forceinline__ void conv_load(const bf16* raw, size_t rb, int t, int col0, bf16x8 (&v)[N + 3]) {
#pragma unroll
    for (int j = 0; j < N + 3; ++j) { const int tt = t - 3 + j; v[j] = *(const bf16x8*)(raw + (rb + (tt < 0 ? 0 : tt)) * PW + col0); }
}
template <int N, class Out> __device__ __forceinline__ void conv_apply(bf16x8 (&v)[N + 3], int t, const f32x4 (&w)[4][2], const f32x4 (&bias)[2], float scale, Out out) {
    if (t < 3) {
#pragma unroll
        for (int j = 0; j < 3; ++j) if (t - 3 + j < 0) v[j] = (bf16x8){0, 0, 0, 0, 0, 0, 0, 0}; }
#pragma unroll
    for (int r = 0; r < N; ++r) { float y[8];
#pragma unroll
        for (int i = 0; i < 8; ++i) y[i] = bias[i >> 2][i & 3];
#pragma unroll
        for (int j = 0; j < 4; ++j)
#pragma unroll
            for (int i = 0; i < 8; ++i) y[i] += w[j][i >> 2][i & 3] * bf2f((unsigned short)v[r + j][i]);
#pragma unroll
        for (int i = 0; i < 8; ++i) y[i] = y[i] * __builtin_amdgcn_rcpf(1.0f + __expf(-y[i])) * scale;
        out(r, y); }
}
template <int N, class Out> __device__ __forceinline__ void conv8xN(const bf16* raw, size_t rb, int t, int col0, const f32x4 (&w)[4][2], const f32x4 (&bias)[2], float scale, Out out) {
    bf16x8 v[N + 3]; conv_load<N>(raw, rb, t, col0, v); conv_apply<N>(v, t, w, bias, scale, out);
}
template <class Out> __device__ __forceinline__ void conv8x8(const bf16* raw, size_t rb, int t, int col0, const f32x4 (&w)[4][2], const f32x4 (&bias)[2], float scale, Out out) { conv8xN<8>(raw, rb, t, col0, w, bias, scale, out); }
__device__ __forceinline__ bf16x8 pack8(const float (&y)[8]) { u32x4 w = {cvtpk(y[0], y[1]), cvtpk(y[2], y[3]), cvtpk(y[4], y[5]), cvtpk(y[6], y[7])}; return __builtin_bit_cast(bf16x8, w); }
__device__ __forceinline__ void load_convw(const float* conv_w, const float* conv_b, int ch0, f32x4 (&w)[4][2], f32x4 (&bias)[2]) {
#pragma unroll
    for (int j = 0; j < 4; ++j) { w[j][0] = *(const f32x4*)(conv_w + j * 1024 + ch0); w[j][1] = *(const f32x4*)(conv_w + j * 1024 + ch0 + 4); }
    bias[0] = *(const f32x4*)(conv_b + ch0); bias[1] = *(const f32x4*)(conv_b + ch0 + 4);
}
__device__ __forceinline__ void split3(float x, short& a, short& b, short& c) {
    const unsigned short h = (unsigned short)f2bf(x); const float r1 = x - bf2f(h); const unsigned short m = (unsigned short)f2bf(r1); const float r2 = r1 - bf2f(m); const unsigned short l = (unsigned short)f2bf(r2);
    a = (short)h; b = (short)m; c = (short)l;
}

__device__ __forceinline__ void mlstm_state_item(Frame& F, int bh, int c) {
    const int tid = F.tid, wid = F.wave, lane = F.lane, r32 = lane & 31, hi = lane >> 5;
    const int b = bh >> 2, hh = bh & 3, t0 = c * MCH;
    LAS char* lds = (LAS char*)F.lds; LAS char* Kimg = lds; LAS char* Vimg = lds + 4 * SHM_T;
    const bf16* MLK = WSP(bf16, WS_PROJ) + 4 * PROJ_STRIDE; const bf16* MLV = WSP(bf16, WS_PROJ) + 5 * PROJ_STRIDE;
    const float* A2 = WSP(float, WS_A2) + (size_t)bh * SEQ + t0;
#if defined(CONV_SLIDE_S) && defined(STATE_HOIST)
    const int cg = tid & 15; const size_t rb = (size_t)b * SEQ; const int row0 = (tid >> 4) * 8;
    f32x4 cw[4][2], cb[2]; load_convw(F.in[3], F.in[4], 512 + hh * 128 + cg * 8, cw, cb);
    bf16x8 kv[11]; conv_load<8>(MLK, rb, t0 + row0, hh * 128 + cg * 8, kv);
    bf16x8 vv[8];
#pragma unroll
    for (int r = 0; r < 8; ++r) vv[r] = *(const bf16x8*)(MLV + (rb + t0 + row0 + r) * PW + hh * 128 + cg * 8);
    const f32x4 a0 = *(const f32x4*)(A2 + row0), a1 = *(const f32x4*)(A2 + row0 + 4);
    float am = (tid < MCH) ? A2[tid] : -3.0e38f; am = wave_max(am);
    LAS float* red = (LAS float*)(lds + XTRA_OFF);
    if (lane == 0) red[wid] = am;
    __syncthreads();
    float mloc = red[0];
#pragma unroll
    for (int w = 1; w < 8; ++w) mloc = fmaxf(mloc, red[w]);
    if (tid == 0) WSP(float, WS_MLOC)[bh * NCH + c] = mloc;
    conv_apply<8>(kv, t0 + row0, cw, cb, MLK_SCALE, [&](int r, float (&y)[8]) { const int row = row0 + r;
        const float wgt = __builtin_amdgcn_exp2f((r < 4 ? a0[r & 3] : a1[r & 3]) - mloc);
#pragma unroll
        for (int e = 0; e < 8; ++e) y[e] *= wgt;
        *(LAS bf16x8*)(Kimg + (row >> 6) * SHM_T + v_st(row & 63, cg * 8)) = pack8(y); });
#pragma unroll
    for (int r = 0; r < 8; ++r) { const int row = row0 + r; *(LAS bf16x8*)(Vimg + (row >> 6) * SHM_T + v_st(row & 63, cg * 8)) = vv[r]; }
#else
    float am = (tid < MCH) ? A2[tid] : -3.0e38f; am = wave_max(am);
    LAS float* red = (LAS float*)(lds + XTRA_OFF);
    if (lane == 0) red[wid] = am;
    __syncthreads();
    float mloc = red[0];
#pragma unroll
    for (int w = 1; w < 8; ++w) mloc = fmaxf(mloc, red[w]);
    if (tid == 0) WSP(float, WS_MLOC)[bh * NCH + c] = mloc;
    const int cg = tid & 15; const size_t rb = (size_t)b * SEQ;
    f32x4 cw[4][2], cb[2]; load_convw(F.in[3], F.in[4], 512 + hh * 128 + cg * 8, cw, cb);
#ifdef CONV_SLIDE_S
    { const int row0 = (tid >> 4) * 8;
      bf16x8 vv[8];
#pragma unroll
      for (int r = 0; r < 8; ++r) vv[r] = *(const bf16x8*)(MLV + (rb + t0 + row0 + r) * PW + hh * 128 + cg * 8);
      const f32x4 a0 = *(const f32x4*)(A2 + row0), a1 = *(const f32x4*)(A2 + row0 + 4);
      conv8x8(MLK, rb, t0 + row0, hh * 128 + cg * 8, cw, cb, MLK_SCALE, [&](int r, float (&y)[8]) { const int row = row0 + r;
          const float wgt = __builtin_amdgcn_exp2f((r < 4 ? a0[r & 3] : a1[r & 3]) - mloc);
#pragma unroll
          for (int e = 0; e < 8; ++e) y[e] *= wgt;
          *(LAS bf16x8*)(Kimg + (row >> 6) * SHM_T + v_st(row & 63, cg * 8)) = pack8(y); });
#pragma unroll
      for (int r = 0; r < 8; ++r) { const int row = row0 + r; *(LAS bf16x8*)(Vimg + (row >> 6) * SHM_T + v_st(row & 63, cg * 8)) = vv[r]; } }
#else
#pragma unroll 2
    for (int i = 0; i < 8; ++i) { const int row = (tid >> 4) + 32 * i, t = t0 + row; float y[8];
        conv8(MLK, rb, t, hh * 128 + cg * 8, cw, cb, MLK_SCALE, y);
        const float wgt = __builtin_amdgcn_exp2f(A2[row] - mloc);
#pragma unroll
        for (int e = 0; e < 8; ++e) y[e] *= wgt;
        *(LAS bf16x8*)(Kimg + (row >> 6) * SHM_T + v_st(row & 63, cg * 8)) = pack8(y);
        *(LAS bf16x8*)(Vimg + (row >> 6) * SHM_T + v_st(row & 63, cg * 8)) = *(const bf16x8*)(MLV + (rb + t) * PW + hh * 128 + cg * 8); }
#endif
#endif
    __syncthreads();
    const int id0 = wid * 2, dvb = id0 >> 2, dkb0 = id0 & 3;
    f32x16 acc0 = {}, acc1 = {}, accn = {};
    const bf16x8 ones = {0x3F80, 0x3F80, 0x3F80, 0x3F80, 0x3F80, 0x3F80, 0x3F80, 0x3F80};
    const int vbK = (int)(uintptr_t)Kimg + v_rd_base(lane), vbV = (int)(uintptr_t)Vimg + v_rd_base(lane);
#define ST_STEP(KS) do { \
        bf16x8 af, b0f, b1f, bnf; \
        af = (dvb == 0) ? tr_frag<0, KS>(vbV + tt * SHM_T) : (dvb == 1) ? tr_frag<1, KS>(vbV + tt * SHM_T) : (dvb == 2) ? tr_frag<2, KS>(vbV + tt * SHM_T) : tr_frag<3, KS>(vbV + tt * SHM_T); \
        if (dkb0 == 0) { b0f = tr_frag<0, KS>(vbK + tt * SHM_T); b1f = tr_frag<1, KS>(vbK + tt * SHM_T); } else { b0f = tr_frag<2, KS>(vbK + tt * SHM_T); b1f = tr_frag<3, KS>(vbK + tt * SHM_T); } \
        acc0 = MFMA32(af, b0f, acc0); acc1 = MFMA32(af, b1f, acc1); \
        if (wid < 4) { bnf = (wid == 0) ? tr_frag<0, KS>(vbK + tt * SHM_T) : (wid == 1) ? tr_frag<1, KS>(vbK + tt * SHM_T) : (wid == 2) ? tr_frag<2, KS>(vbK + tt * SHM_T) : tr_frag<3, KS>(vbK + tt * SHM_T); \
            accn = MFMA32(ones, bnf, accn); } } while (0)
    for (int tt = 0; tt < 4; ++tt) { ST_STEP(0); ST_STEP(1); ST_STEP(2); ST_STEP(3); }
#undef ST_STEP
    bf16* DCT = WSP(bf16, WS_DCT) + ((size_t)(bh * NCH + c) << 14);
#pragma unroll
    for (int r = 0; r < 16; ++r) { const int dv = 32 * dvb + crow(r, hi);
        DCT[dv * 128 + 32 * dkb0 + r32] = (bf16)f2bf(acc0[r]); DCT[dv * 128 + 32 * (dkb0 + 1) + r32] = (bf16)f2bf(acc1[r]); }
    if (wid < 4 && hi == 0) WSP(float, WS_DN)[(size_t)(bh * NCH + c) * 128 + 32 * wid + r32] = accn[0];
    __syncthreads();
}

__device__ __forceinline__ void mlstm_out_unit(Frame& F, int bh, int c) {
    const int tid = F.tid, wid = F.wave, lane = F.lane, r32 = lane & 31, hi = lane >> 5;
    const int rg = wid < 4 ? wid : 11 - wid;
    const int b = bh >> 2, hh = bh & 3, t0 = c * MCH; const size_t rb = (size_t)b * SEQ;
    LAS char* lds = (LAS char*)F.lds; LAS char* Kimg = lds; LAS char* Vimg = lds + 4 * SHM_T; LAS char* Cimg = lds + 4 * SHM_T; LAS float* nref = (LAS float*)(lds + 6 * SHM_T);
    LAS float* ws = (LAS float*)(lds + WSCR_OFF) + wid * 128; LAS float* f_l = ws; LAS float* rn_l = ws + 32;
    const bf16* MLQ = WSP(bf16, WS_PROJ) + 3 * PROJ_STRIDE; const bf16* MLK = MLQ + PROJ_STRIDE; const bf16* MLV = MLQ + 2 * PROJ_STRIDE; const bf16* MLO = MLQ + 3 * PROJ_STRIDE;
    const float* A2 = WSP(float, WS_A2) + (size_t)bh * SEQ; const float* M2 = WSP(float, WS_M2) + (size_t)bh * SEQ; const float* NB2 = WSP(float, WS_NB2) + (size_t)bh * SEQ;
    const int trow = t0 + 32 * rg + r32;
    const float m2t = M2[trow], nb2t = NB2[trow];
    const float mref2 = (c > 0) ? M2[t0 - 1] : -1e30f;
#ifdef DUP_PHASE
    if (!(F.flags & 8))
#endif
    { const int cg = tid & 15; f32x4 cw[4][2], cb[2]; load_convw(F.in[3], F.in[4], hh * 128 + cg * 8, cw, cb);
#ifdef CONV_SLIDE_Q
      { const int row0 = (tid >> 4) * 8;
        conv8x8(MLQ, rb, t0 + row0, hh * 128 + cg * 8, cw, cb, 1.0f, [&](int r, float (&y)[8]) { const int row = row0 + r;
            *(LAS bf16x8*)(Kimg + (row >> 6) * SHM_T + KSWZ(row & 63, cg * 16)) = pack8(y); }); } }
#else
#pragma unroll 4
      for (int i = 0; i < 8; ++i) { const int row = (tid >> 4) + 32 * i; float y[8];
          conv8(MLQ, rb, t0 + row, hh * 128 + cg * 8, cw, cb, 1.0f, y);
          *(LAS bf16x8*)(Kimg + (row >> 6) * SHM_T + KSWZ(row & 63, cg * 16)) = pack8(y); } }
#endif
    __syncthreads();
    bf16x8 qr[8];
    { const int row = 32 * rg + r32;
#pragma unroll
      for (int d0 = 0; d0 < 8; ++d0) qr[d0] = *(const LAS bf16x8*)(Kimg + (row >> 6) * SHM_T + KSWZ(row & 63, (d0 * 16 + hi * 8) * 2)); }
    f32x16 o[4] = {}; float den = 0.f;
#ifdef DUP_PHASE
    if (c > 0 && !(F.flags & 1)) {
#else
    if (c > 0) {
#endif
        const float* ML = WSP(float, WS_MLOC) + bh * NCH; const bf16* DCT = WSP(bf16, WS_DCT) + ((size_t)(bh * NCH) << 14); const float* DN = WSP(float, WS_DN) + (size_t)(bh * NCH) * 128;
        { const int dv = tid >> 2, dk0 = (tid & 3) * 32; f32x4 a[8];
#pragma unroll
          for (int i = 0; i < 8; ++i) a[i] = (f32x4){0.f, 0.f, 0.f, 0.f};
#if defined(CREF6)
          for (int cp = 0; cp < c; cp += 6) {
              float cf[6]; const bf16x8* sp[6];
#pragma unroll
              for (int u = 0; u < 6; ++u) { const int cq = cp + u < c ? cp + u : cp; cf[u] = cp + u < c ? __builtin_amdgcn_exp2f(ML[cq] - mref2) : 0.f; sp[u] = (const bf16x8*)(DCT + ((size_t)cq << 14) + dv * 128 + dk0); }
              bf16x8 uu[6][4];
#pragma unroll
              for (int i = 0; i < 4; ++i)
#pragma unroll
                  for (int u = 0; u < 6; ++u) uu[u][i] = sp[u][i];
#pragma unroll
              for (int i = 0; i < 4; ++i)
#pragma unroll
                  for (int e = 0; e < 8; ++e) a[2 * i + (e >> 2)][e & 3] += ((bf2f((unsigned short)uu[0][i][e]) * cf[0] + bf2f((unsigned short)uu[1][i][e]) * cf[1]) + (bf2f((unsigned short)uu[2][i][e]) * cf[2] + bf2f((unsigned short)uu[3][i][e]) * cf[3]))
                                                                 + (bf2f((unsigned short)uu[4][i][e]) * cf[4] + bf2f((unsigned short)uu[5][i][e]) * cf[5]); }
#elif defined(CREF8)
          for (int cp = 0; cp < c; cp += 8) {
              float cf[8]; const bf16x8* sp[8];
#pragma unroll
              for (int u = 0; u < 8; ++u) { const int cq = cp + u < c ? cp + u : cp; cf[u] = cp + u < c ? __builtin_amdgcn_exp2f(ML[cq] - mref2) : 0.f; sp[u] = (const bf16x8*)(DCT + ((size_t)cq << 14) + dv * 128 + dk0); }
              bf16x8 uu[8][4];
#pragma unroll
              for (int i = 0; i < 4; ++i)
#pragma unroll
                  for (int u = 0; u < 8; ++u) uu[u][i] = sp[u][i];
#pragma unroll
              for (int i = 0; i < 4; ++i)
#pragma unroll
                  for (int e = 0; e < 8; ++e) a[2 * i + (e >> 2)][e & 3] += ((bf2f((unsigned short)uu[0][i][e]) * cf[0] + bf2f((unsigned short)uu[1][i][e]) * cf[1]) + (bf2f((unsigned short)uu[2][i][e]) * cf[2] + bf2f((unsigned short)uu[3][i][e]) * cf[3]))
                                                                 + ((bf2f((unsigned short)uu[4][i][e]) * cf[4] + bf2f((unsigned short)uu[5][i][e]) * cf[5]) + (bf2f((unsigned short)uu[6][i][e]) * cf[6] + bf2f((unsigned short)uu[7][i][e]) * cf[7])); }
#else
          for (int cp = 0; cp < c; cp += 4) {
              float cf[4]; const bf16x8* sp[4];
#pragma unroll
              for (int u = 0; u < 4; ++u) { const int cq = cp + u < c ? cp + u : cp; cf[u] = cp + u < c ? __builtin_amdgcn_exp2f(ML[cq] - mref2) : 0.f; sp[u] = (const bf16x8*)(DCT + ((size_t)cq << 14) + dv * 128 + dk0); }
              bf16x8 u0[4], u1[4], u2[4], u3[4];
#pragma unroll
              for (int i = 0; i < 4; ++i) { u0[i] = sp[0][i]; u1[i] = sp[1][i]; u2[i] = sp[2][i]; u3[i] = sp[3][i]; }
#pragma unroll
              for (int i = 0; i < 4; ++i)
#pragma unroll
                  for (int e = 0; e < 8; ++e) a[2 * i + (e >> 2)][e & 3] += (bf2f((unsigned short)u0[i][e]) * cf[0] + bf2f((unsigned short)u1[i][e]) * cf[1]) + (bf2f((unsigned short)u2[i][e]) * cf[2] + bf2f((unsigned short)u3[i][e]) * cf[3]); }
#endif
#pragma unroll
          for (int i = 0; i < 4; ++i) { u32x4 w = {cvtpk(a[2 * i][0], a[2 * i][1]), cvtpk(a[2 * i][2], a[2 * i][3]), cvtpk(a[2 * i + 1][0], a[2 * i + 1][1]), cvtpk(a[2 * i + 1][2], a[2 * i + 1][3])};
              *(LAS u32x4*)(Cimg + KSWZ(dv, (dk0 + 8 * i) * 2)) = w; }
          if (tid < 128) { float s = 0.f; for (int cp = 0; cp < c; ++cp) s += DN[cp * 128 + tid] * __builtin_amdgcn_exp2f(ML[cp] - mref2); nref[tid] = s; } }
        __syncthreads();
#pragma unroll
        for (int d = 0; d < 4; ++d)
#pragma unroll
            for (int ks = 0; ks < 8; ++ks) { const bf16x8 cf = *(const LAS bf16x8*)(Cimg + KSWZ(32 * d + r32, (16 * ks + 8 * hi) * 2)); o[d] = MFMA32(qr[ks], cf, o[d]); }
        float dn = 0.f;
#pragma unroll
        for (int ks = 0; ks < 8; ++ks) { const f32x4 n0 = *(const LAS f32x4*)(nref + 16 * ks + 8 * hi), n1 = *(const LAS f32x4*)(nref + 16 * ks + 8 * hi + 4);
#pragma unroll
            for (int j = 0; j < 4; ++j) { dn += bf2f((unsigned short)qr[ks][j]) * n0[j]; dn += bf2f((unsigned short)qr[ks][4 + j]) * n1[j]; } }
        dn = half_swap_add(dn);
        const float ft = __builtin_amdgcn_exp2f(mref2 - m2t);
        den = ft * dn;
        if (hi == 0) f_l[r32] = ft; asm volatile("s_waitcnt lgkmcnt(0)" ::: "memory");
#pragma unroll
        for (int d = 0; d < 4; ++d)
#pragma unroll
            for (int r = 0; r < 16; ++r) o[d][r] *= f_l[crow(r, hi)];
        __syncthreads();
    }
    __syncthreads();
#ifdef DUP_PHASE
    if (!(F.flags & 4))
#endif
    { const int cg = tid & 15; f32x4 cw[4][2], cb[2]; load_convw(F.in[3], F.in[4], 512 + hh * 128 + cg * 8, cw, cb);
#ifdef CONV_SLIDE_K
      { const int row0 = (tid >> 4) * 8;
#ifdef KHALF_UNROLL
#pragma unroll
#else
#pragma unroll 1
#endif
        for (int hf = 0; hf < 2; ++hf) { const int rowh = row0 + 4 * hf;
          conv8xN<4>(MLK, rb, t0 + rowh, hh * 128 + cg * 8, cw, cb, MLK_SCALE, [&](int r, float (&y)[8]) { const int row = rowh + r;
              *(LAS bf16x8*)(Kimg + (row >> 6) * SHM_T + KSWZ(row & 63, cg * 16)) = pack8(y); });
          bf16x8 vv[4];
#pragma unroll
          for (int r = 0; r < 4; ++r) vv[r] = *(const bf16x8*)(MLV + (rb + t0 + rowh + r) * PW + hh * 128 + cg * 8);
#pragma unroll
          for (int r = 0; r < 4; ++r) { const int row = rowh + r; *(LAS bf16x8*)(Vimg + (row >> 6) * SHM_T + v_st(row & 63, cg * 8)) = vv[r]; } } } }
#else
#ifdef KV_UNROLL4
#pragma unroll 4
#else
#pragma unroll 2
#endif
      for (int i = 0; i < 8; ++i) { const int row = (tid >> 4) + 32 * i, t = t0 + row; float y[8];
          conv8(MLK, rb, t, hh * 128 + cg * 8, cw, cb, MLK_SCALE, y);
          *(LAS bf16x8*)(Kimg + (row >> 6) * SHM_T + KSWZ(row & 63, cg * 16)) = pack8(y);
          *(LAS bf16x8*)(Vimg + (row >> 6) * SHM_T + v_st(row & 63, cg * 8)) = *(const bf16x8*)(MLV + (rb + t) * PW + hh * 128 + cg * 8); } }
#endif
    __syncthreads();
    bf16x8 qx = {0, 0, 0, 0, 0, 0, 0, 0};
    if (hi == 0) { short a, bq, cq; split3(-m2t, a, bq, cq); qx[0] = 0x3F80; qx[1] = 0x3F80; qx[2] = 0x3F80; qx[3] = a; qx[4] = bq; qx[5] = cq; }
#ifdef DUP_PHASE
    const int ntile = (F.flags & 2) ? 0 : (rg >> 1) + 1;
#else
    const int ntile = (rg >> 1) + 1;
#endif
    for (int jt = 0; jt < ntile; ++jt) {
        const LAS char* Ks = Kimg + jt * SHM_T;
        bf16x8 kx0 = {0, 0, 0, 0, 0, 0, 0, 0}, kx1 = kx0;
        if (hi == 0) { short a, bq, cq; split3(A2[t0 + 64 * jt + r32], a, bq, cq); kx0[0] = a; kx0[1] = bq; kx0[2] = cq; kx0[3] = 0x3F80; kx0[4] = 0x3F80; kx0[5] = 0x3F80;
                       split3(A2[t0 + 64 * jt + 32 + r32], a, bq, cq); kx1[0] = a; kx1[1] = bq; kx1[2] = cq; kx1[3] = 0x3F80; kx1[4] = 0x3F80; kx1[5] = 0x3F80; }
        f32x16 e0 = MFMA32(kx0, qx, f32x16{}), e1 = MFMA32(kx1, qx, f32x16{});
        f32x16 p0 = {}, p1 = {};
#pragma unroll
        for (int d0 = 0; d0 < 8; ++d0) { const int cbb = (d0 * 16 + hi * 8) * 2;
            const bf16x8 b0 = *(const LAS bf16x8*)(Ks + KSWZ(r32, cbb)); const bf16x8 b1 = *(const LAS bf16x8*)(Ks + KSWZ(32 + r32, cbb));
            p0 = MFMA32(b0, qr[d0], p0); p1 = MFMA32(b1, qr[d0], p1); }
        const bool diag = (jt == ntile - 1); const int qrel = 32 * rg + r32 - 64 * jt;
        float ps = 0.f;
#pragma unroll
        for (int r = 0; r < 16; ++r) { const int kv = crow(r, hi);
            float v0 = p0[r] * __builtin_amdgcn_exp2f(fminf(e0[r], 0.f)), v1 = p1[r] * __builtin_amdgcn_exp2f(fminf(e1[r], 0.f));
            if (diag) { if (kv > qrel) v0 = 0.f; if (kv + 32 > qrel) v1 = 0.f; }
            p0[r] = v0; p1[r] = v1; ps += v0 + v1; }
        den += half_swap_add(ps);
        bf16x8 pa0, pa1, pa2, pa3; pack_p(p0, p1, pa0, pa1, pa2, pa3);
        pv_d0(o, (int)(uintptr_t)(Vimg + jt * SHM_T) + v_rd_base(lane), pa0, pa1, pa2, pa3);
    }
    { const float nrm = fmaxf(fabsf(den), __builtin_amdgcn_exp2f(nb2t));
#ifdef FAST_SIG
      if (hi == 0) rn_l[r32] = __builtin_amdgcn_rcpf(nrm);
#else
      if (hi == 0) rn_l[r32] = 1.0f / nrm;
#endif
      asm volatile("s_waitcnt lgkmcnt(0)" ::: "memory"); }
    const float* gml = F.in[12] + hh * 128;
#ifdef CS_PRELOAD
    float csv[4];
#pragma unroll
    for (int d = 0; d < 4; ++d) csv[d] = gml[d * 32 + r32];
#endif
    float ssq[16];
#pragma unroll
    for (int r = 0; r < 16; ++r) { const float rn = rn_l[crow(r, hi)]; float s = 0.f;
#pragma unroll
        for (int d = 0; d < 4; ++d) { o[d][r] *= rn; s += o[d][r] * o[d][r]; }
        ssq[r] = s; }
#pragma unroll
#ifdef FAST_SIG
    for (int r = 0; r < 16; ++r) ssq[r] = __builtin_amdgcn_rsqf(half_sum32(ssq[r]) * (1.f / 128.f) + NORM_EPS);
#else
    for (int r = 0; r < 16; ++r) ssq[r] = 1.0f / sqrtf(half_sum32(ssq[r]) * (1.f / 128.f) + NORM_EPS);
#endif
    __syncthreads();
    bf16* MIX = WSP(bf16, WS_H1) + (rb + t0 + 32 * rg) * DM + 512 + hh * 128;
    const bf16* Og = MLO + (rb + t0 + 32 * rg) * PW + hh * 128;
#ifdef CS_PRELOAD
    store_rows(o, ssq, gml, (LAS float*)lds + wid * 4096, MIX, DM, Og, PW, lane, csv);
#else
    store_rows(o, ssq, gml, (LAS float*)lds + wid * 4096, MIX, DM, Og, PW, lane);
#endif
    __syncthreads();
}
}

namespace peer {
using att::f32x16; using att::crow;
__device__ __forceinline__ unsigned ordf(float f) { const unsigned u = __float_as_uint(f); return u ^ ((u >> 31) ? 0xFFFFFFFFu : 0x80000000u); }
__device__ __forceinline__ float unordf(unsigned k) { return __uint_as_float(k ^ ((k >> 31) ? 0x80000000u : 0xFFFFFFFFu)); }
#define CAS_D(a, b) do { const unsigned _x = (a) > (b) ? (a) : (b), _n = (a) > (b) ? (b) : (a); (a) = _x; (b) = _n; } while (0)
struct SortNet { unsigned char a[63], b[63]; };
constexpr SortNet make_sortnet() { SortNet s{}; const int p[63][2] = {{0,1},{2,3},{0,2},{1,3},{1,2},{4,5},{6,7},{4,6},{5,7},{5,6},{0,4},{2,6},{2,4},{1,5},{3,7},{3,5},{1,2},{3,4},{5,6},{8,9},{10,11},{8,10},{9,11},{9,10},{12,13},{14,15},{12,14},{13,15},{13,14},{8,12},{10,14},{10,12},{9,13},{11,15},{11,13},{9,10},{11,12},{13,14},{0,8},{4,12},{4,8},{2,10},{6,14},{6,10},{2,4},{6,8},{10,12},{1,9},{5,13},{5,9},{3,11},{7,15},{7,11},{3,5},{7,9},{11,13},{1,2},{3,4},{5,6},{7,8},{9,10},{11,12},{13,14}}; for (int i = 0; i < 63; ++i) { s.a[i] = (unsigned char)p[i][0]; s.b[i] = (unsigned char)p[i][1]; } return s; }
constexpr SortNet SORTNET = make_sortnet();
template <bool DESC> __device__ __forceinline__ void bsort16(unsigned (&v)[16]) {
#pragma unroll
    for (int c = 0; c < 63; ++c) { const int i = SORTNET.a[c], j = SORTNET.b[c]; if (DESC) CAS_D(v[i], v[j]); else CAS_D(v[j], v[i]); }
}
__device__ __forceinline__ void bmerge16_desc(unsigned (&v)[16]) {
#pragma unroll
    for (int j = 8; j > 0; j >>= 1)
#pragma unroll
        for (int i = 0; i < 16; ++i) { const int l = i ^ j; if (l > i) CAS_D(v[i], v[l]); }
}
__device__ __forceinline__ void merge_in(unsigned (&T)[16], unsigned (&N)[16]) {
    bsort16<false>(N);
#pragma unroll
    for (int i = 0; i < 16; ++i) T[i] = T[i] > N[i] ? T[i] : N[i];
    bmerge16_desc(T);
}
__device__ __forceinline__ void top16_of_tile(const f32x16 (&acc)[4], int hi, unsigned (&T)[16]) {
    unsigned N[16];
#pragma unroll
    for (int r = 0; r < 16; ++r) T[r] = (ordf(acc[0][r]) & ~0x7Fu) | (unsigned)(crow(r, hi));
    bsort16<true>(T);
#pragma unroll
    for (int mt = 1; mt < 4; ++mt) {
#pragma unroll
        for (int r = 0; r < 16; ++r) N[r] = (ordf(acc[mt][r]) & ~0x7Fu) | (unsigned)(32 * mt + crow(r, hi));
        merge_in(T, N); }
#pragma unroll
    for (int i = 0; i < 16; ++i) N[i] = (unsigned)__shfl_xor((int)T[15 - i], 32);
#pragma unroll
    for (int i = 0; i < 16; ++i) T[i] = T[i] > N[i] ? T[i] : N[i];
    bmerge16_desc(T);
}
struct CandTab { unsigned char ij[64]; };
constexpr CandTab make_cands() { CandTab t{}; int n = 0; for (int i = 0; i < 16; ++i) for (int j = i; j < 16; ++j) if ((i + 1) * (j + 1) <= 16) t.ij[n++] = (unsigned char)(i * 16 + j); for (; n < 64; ++n) t.ij[n] = 255; return t; }
constexpr CandTab CANDS = make_cands();

#ifdef QP_NT
#define PG_QPLD(p) __builtin_nontemporal_load(p)
#else
#define PG_QPLD(p) (*(p))
#endif
__device__ __forceinline__ void peer_topk_phase(Frame& F) {
    const int tid = F.tid, wid = F.wave, lane = F.lane, r32 = lane & 31, hi = lane >> 5;
    const int h = F.vcu & 7, bq = F.vcu >> 3, nbq = F.G >> 3;
    LAS char* lds = (LAS char*)F.lds;
    const bf16* SK = WSP(bf16, WS_SUBK) + (size_t)h * 2 * 128 * 128;
    { bf16x8 t[8];
#pragma unroll
      for (int u = 0; u < 8; ++u) { const int i = tid + u * NTHR; const int cc = i >> 11, r = (i >> 4) & 127, ch = i & 15; t[u] = *(const bf16x8*)(SK + (size_t)cc * 16384 + r * 128 + ch * 8); }
#pragma unroll
      for (int u = 0; u < 8; ++u) { const int i = tid + u * NTHR; const int cc = i >> 11, r = (i >> 4) & 127, ch = i & 15; *(LAS bf16x8*)(lds + cc * 32768 + KSWZ(r, ch * 16)) = t[u]; } }
    __syncthreads();
    const bf16* QP = (h < 4) ? WSP(bf16, WS_H1) + h * 256 : WSP(bf16, WS_QPB) + (h - 4) * 256;
    LAS unsigned char* ixs = (LAS unsigned char*)(lds + XTRA_OFF) + tid * 32;
    unsigned long long* PE = WSP(unsigned long long, WS_PE);
    for (int tg = bq * NWAVES + wid; tg < M / 32; tg += nbq * NWAVES) {
        const int tok = tg * 32 + r32;
        unsigned T1[16], T2[16];
#pragma unroll
        for (int cc = 0; cc < 2; ++cc) {
            bf16x8 qf[8];
#pragma unroll
            for (int ks = 0; ks < 8; ++ks) qf[ks] = PG_QPLD((const bf16x8*)(QP + (size_t)tok * DM + cc * 128 + 16 * ks + 8 * hi));
#ifdef QP_CLUSTER
            __builtin_amdgcn_sched_barrier(0);
#endif
            f32x16 acc[4];
#pragma unroll
            for (int mt = 0; mt < 4; ++mt) { acc[mt] = f32x16{};
#pragma unroll
                for (int ks = 0; ks < 8; ++ks) { const bf16x8 af = *(const LAS bf16x8*)(lds + cc * 32768 + KSWZ(32 * mt + r32, (16 * ks + 8 * hi) * 2)); acc[mt] = MFMA32(af, qf[ks], acc[mt]); } }
            if (cc == 0) top16_of_tile(acc, hi, T1); else top16_of_tile(acc, hi, T2);
        }
        { v4u w1, w2;
#pragma unroll
          for (int q = 0; q < 4; ++q) { w1[q] = (T1[4 * q] & 0x7F) | ((T1[4 * q + 1] & 0x7F) << 8) | ((T1[4 * q + 2] & 0x7F) << 16) | ((T1[4 * q + 3] & 0x7F) << 24);
                                        w2[q] = (T2[4 * q] & 0x7F) | ((T2[4 * q + 1] & 0x7F) << 8) | ((T2[4 * q + 2] & 0x7F) << 16) | ((T2[4 * q + 3] & 0x7F) << 24); }
          *(LAS v4u*)ixs = w1; *(LAS v4u*)(ixs + 16) = w2; }
        float s1[16], s2[16];
#pragma unroll
        for (int i = 0; i < 16; ++i) { s1[i] = unordf(T1[i] & ~0x7Fu); s2[i] = unordf(T2[i] & ~0x7Fu); }
        unsigned R[16], N[16];
        float sa[16], sb[16];
#pragma unroll
        for (int i = 0; i < 16; ++i) { sa[i] = hi ? s2[i] : s1[i]; sb[i] = hi ? s1[i] : s2[i]; }
#pragma unroll
        for (int ch = 0; ch < 2; ++ch) {
#pragma unroll
            for (int q = 0; q < 16; ++q) { const int ij = CANDS.ij[ch * 16 + q]; const int ii = (ij >> 4) & 15, jj = ij & 15;
                const unsigned code = hi ? (unsigned)(jj * 16 + ii) : (unsigned)ij;
                unsigned kk = (ij == 255 || (ii == jj && hi)) ? 0u : ((ordf(sa[ii] + sb[jj]) & ~0xFFu) | code);
                if (ch == 0) R[q] = kk; else N[q] = kk; }
            if (ch == 0) bsort16<true>(R); else merge_in(R, N); }
#pragma unroll
        for (int i = 0; i < 16; ++i) N[i] = (unsigned)__shfl_xor((int)R[15 - i], 32);
#pragma unroll
        for (int i = 0; i < 16; ++i) R[i] = R[i] > N[i] ? R[i] : N[i];
        bmerge16_desc(R);
        asm volatile("s_waitcnt lgkmcnt(0)" ::: "memory");
        const float mx = unordf(R[0] & ~0xFFu); float ev[16], es = 0.f;
#pragma unroll
        for (int k = 0; k < 16; ++k) { ev[k] = __expf(unordf(R[k] & ~0xFFu) - mx); es += ev[k]; }
        const float inv = 1.0f / es;
        if (hi == 0) {
#pragma unroll
            for (int k = 0; k < 16; k += 2) { v4u w;
                w[0] = (unsigned)ixs[(R[k] >> 4) & 15] * 128u + (unsigned)ixs[16 + (R[k] & 15)]; w[1] = __float_as_uint(ev[k] * inv);
                w[2] = (unsigned)ixs[(R[k + 1] >> 4) & 15] * 128u + (unsigned)ixs[16 + (R[k + 1] & 15)]; w[3] = __float_as_uint(ev[k + 1] * inv);
                *(v4u*)(PE + (size_t)tok * 128 + h * 16 + k) = w; }
        }
    }
#ifndef FEWER_SYNCS
    __syncthreads();
#endif
}
__device__ __forceinline__ void peer_topk_tile(Frame& F, int pm, int h) {
    const int tid = F.tid, wid = F.wave, lane = F.lane, r32 = lane & 31, hi = lane >> 5;
    LAS char* lds = (LAS char*)F.lds;
    const bf16* SK = WSP(bf16, WS_SUBK) + (size_t)h * 2 * 128 * 128;
    { bf16x8 t[8];
#pragma unroll
      for (int u = 0; u < 8; ++u) { const int i = tid + u * NTHR; const int cc = i >> 11, r = (i >> 4) & 127, ch = i & 15; t[u] = *(const bf16x8*)(SK + (size_t)cc * 16384 + r * 128 + ch * 8); }
#pragma unroll
      for (int u = 0; u < 8; ++u) { const int i = tid + u * NTHR; const int cc = i >> 11, r = (i >> 4) & 127, ch = i & 15; *(LAS bf16x8*)(lds + cc * 32768 + KSWZ(r, ch * 16)) = t[u]; } }
    __syncthreads();
    const bf16* QP = (h < 4) ? WSP(bf16, WS_H1) + h * 256 : WSP(bf16, WS_QPB) + (h - 4) * 256;
    LAS unsigned char* ixs = (LAS unsigned char*)(lds + XTRA_OFF) + tid * 32;
    unsigned long long* PE = WSP(unsigned long long, WS_PE);
    { const int tg = pm * NWAVES + wid;
        const int tok = tg * 32 + r32;
        unsigned T1[16], T2[16];
#pragma unroll
        for (int cc = 0; cc < 2; ++cc) {
            bf16x8 qf[8];
#pragma unroll
            for (int ks = 0; ks < 8; ++ks) qf[ks] = PG_QPLD((const bf16x8*)(QP + (size_t)tok * DM + cc * 128 + 16 * ks + 8 * hi));
#ifdef QP_CLUSTER
            __builtin_amdgcn_sched_barrier(0);
#endif
            f32x16 acc[4];
#pragma unroll
            for (int mt = 0; mt < 4; ++mt) { acc[mt] = f32x16{};
#pragma unroll
                for (int ks = 0; ks < 8; ++ks) { const bf16x8 af = *(const LAS bf16x8*)(lds + cc * 32768 + KSWZ(32 * mt + r32, (16 * ks + 8 * hi) * 2)); acc[mt] = MFMA32(af, qf[ks], acc[mt]); } }
            if (cc == 0) top16_of_tile(acc, hi, T1); else top16_of_tile(acc, hi, T2);
        }
        { v4u w1, w2;
#pragma unroll
          for (int q = 0; q < 4; ++q) { w1[q] = (T1[4 * q] & 0x7F) | ((T1[4 * q + 1] & 0x7F) << 8) | ((T1[4 * q + 2] & 0x7F) << 16) | ((T1[4 * q + 3] & 0x7F) << 24);
                                        w2[q] = (T2[4 * q] & 0x7F) | ((T2[4 * q + 1] & 0x7F) << 8) | ((T2[4 * q + 2] & 0x7F) << 16) | ((T2[4 * q + 3] & 0x7F) << 24); }
          *(LAS v4u*)ixs = w1; *(LAS v4u*)(ixs + 16) = w2; }
        float s1[16], s2[16];
#pragma unroll
        for (int i = 0; i < 16; ++i) { s1[i] = unordf(T1[i] & ~0x7Fu); s2[i] = unordf(T2[i] & ~0x7Fu); }
        unsigned R[16], N[16];
        float sa[16], sb[16];
#pragma unroll
        for (int i = 0; i < 16; ++i) { sa[i] = hi ? s2[i] : s1[i]; sb[i] = hi ? s1[i] : s2[i]; }
#pragma unroll
        for (int ch = 0; ch < 2; ++ch) {
#pragma unroll
            for (int q = 0; q < 16; ++q) { const int ij = CANDS.ij[ch * 16 + q]; const int ii = (ij >> 4) & 15, jj = ij & 15;
                const unsigned code = hi ? (unsigned)(jj * 16 + ii) : (unsigned)ij;
                unsigned kk = (ij == 255 || (ii == jj && hi)) ? 0u : ((ordf(sa[ii] + sb[jj]) & ~0xFFu) | code);
                if (ch == 0) R[q] = kk; else N[q] = kk; }
            if (ch == 0) bsort16<true>(R); else merge_in(R, N); }
#pragma unroll
        for (int i = 0; i < 16; ++i) N[i] = (unsigned)__shfl_xor((int)R[15 - i], 32);
#pragma unroll
        for (int i = 0; i < 16; ++i) R[i] = R[i] > N[i] ? R[i] : N[i];
        bmerge16_desc(R);
        asm volatile("s_waitcnt lgkmcnt(0)" ::: "memory");
        const float mx = unordf(R[0] & ~0xFFu); float ev[16], es = 0.f;
#pragma unroll
        for (int k = 0; k < 16; ++k) { ev[k] = __expf(unordf(R[k] & ~0xFFu) - mx); es += ev[k]; }
        const float inv = 1.0f / es;
        if (hi == 0) {
#pragma unroll
            for (int k = 0; k < 16; k += 2) { v4u w;
                w[0] = (unsigned)ixs[(R[k] >> 4) & 15] * 128u + (unsigned)ixs[16 + (R[k] & 15)]; w[1] = __float_as_uint(ev[k] * inv);
                w[2] = (unsigned)ixs[(R[k + 1] >> 4) & 15] * 128u + (unsigned)ixs[16 + (R[k + 1] & 15)]; w[3] = __float_as_uint(ev[k + 1] * inv);
                *(v4u*)(PE + (size_t)tok * 128 + h * 16 + k) = w; }
        }
    }
    __syncthreads();
}

__device__ __forceinline__ float gelu_erf(float a) { return 0.5f * a * (1.0f + erff(a * 0.70710678118654752f)); }
typedef float f32x2g __attribute__((ext_vector_type(2)));
typedef __bf16 bf16x2_t __attribute__((ext_vector_type(2)));
__device__ __forceinline__ bf16x2_t asbf2(unsigned v) { return __builtin_bit_cast(bf16x2_t, v); }
__device__ __forceinline__ float reduce4(const float (&d)[4]) {
    float s[2];
#pragma unroll
    for (int k = 0; k < 2; ++k) { auto r = __builtin_amdgcn_permlane32_swap(__float_as_uint(d[k]), __float_as_uint(d[k + 2]), false, false); s[k] = __uint_as_float(r[0]) + __uint_as_float(r[1]); }
    auto r2 = __builtin_amdgcn_permlane16_swap(__float_as_uint(s[0]), __float_as_uint(s[1]), false, false);
    float r = __uint_as_float(r2[0]) + __uint_as_float(r2[1]);
    r += dppf<0xB1>(r); r += dppf<0x4E>(r); r += dppf<0x141>(r); r += dppf<0x128>(r);
    return r;
}
#ifndef PG_GSH
#define PG_GSH 11
#endif
#define PG_NGRP (16384 >> PG_GSH)
#ifdef P7_NT
#define P7LD(p) __builtin_nontemporal_load(p)
#else
#define P7LD(p) (*(p))
#endif
__device__ __forceinline__ void peer_gather_phase(Frame& F) {
    const int lane = F.lane, wid = F.wave; const int gw = F.vcu * NWAVES + wid;
    LAS char* lds = (LAS char*)F.lds;
    const float* X1 = WSP(float, WS_X1); const bf16* X1B = WSP(bf16, WS_X1B); const float* SSP = WSP(float, WS_SSP);
    const unsigned char* U8 = WSP(unsigned char, WS_UB); const unsigned char* V8 = WSP(unsigned char, WS_VB);
    const unsigned long long* PE = WSP(unsigned long long, WS_PE); const float* fg = F.in[19];
    LAS unsigned long long* LIST = (LAS unsigned long long*)(lds + 65536) + wid * 1024;
    float* WL = WSP(float, WS_WL) + (size_t)gw * 1024;
    const int tok0 = gw * 8;
    LAS float* rstd_l = (LAS float*)(lds + XTRA_OFF) + wid * 8;
    LAS unsigned* wmax_l = (LAS unsigned*)(lds + XTRA_OFF + 512) + wid * 8;
    if (lane < 8) wmax_l[lane] = 0u;
#ifdef PG_U4
    LAS float* sxs_l = (LAS float*)(lds + XTRA_OFF + 256) + wid * 8;
#endif
    LAS unsigned* bstart = (LAS unsigned*)(lds + XTRA_OFF + 1024) + wid * 256; LAS unsigned* bend = bstart + 128;
#ifdef PE_EARLY
    v4u ent_e[8];
#endif
#ifdef XT_PRELOAD
    { bf16x8 xa_[8], xb_[8];
#pragma unroll
      for (int j = 0; j < 8; ++j) { const bf16x8* src = (const bf16x8*)(X1B + (size_t)(tok0 + j) * DM); xa_[j] = P7LD(src + 2 * lane); xb_[j] = P7LD(src + 2 * lane + 1); }
      f32x4 sq_[4];
      { const f32x4* sp = (const f32x4*)(SSP + (size_t)(tok0 + (lane & 7)) * 16);
#pragma unroll
        for (int q = 0; q < 4; ++q) sq_[q] = sp[q]; }
#ifdef PE_EARLY
#pragma unroll
      for (int i = 0; i < 8; ++i) ent_e[i] = ((const v4u*)(PE + (size_t)(tok0 + (lane >> 3)) * 128 + (lane & 7) * 16))[i];
#endif
      __builtin_amdgcn_sched_barrier(0);
      float mysx = 1.0f;
#pragma unroll
      for (int j = 0; j < 8; ++j) { const bf16x8 a = xa_[j], b = xb_[j];
        float xf[16]; float mx = 0.f;
#pragma unroll
        for (int e = 0; e < 8; ++e) { xf[e] = bf2f((unsigned short)a[e]); xf[8 + e] = bf2f((unsigned short)b[e]); mx = fmaxf(mx, fmaxf(fabsf(xf[e]), fabsf(xf[8 + e]))); }
        mx = wave_max(mx); const float sx = mx > 0.f ? mx * (1.0f / 127.0f) : 1.0f, inv = 1.0f / sx;
        v4u o;
#pragma unroll
        for (int q = 0; q < 4; ++q) { const int q0 = (int)rintf(xf[4 * q] * inv), q1 = (int)rintf(xf[4 * q + 1] * inv), q2 = (int)rintf(xf[4 * q + 2] * inv), q3 = (int)rintf(xf[4 * q + 3] * inv);
            o[q] = (unsigned)(q0 & 255) | ((unsigned)(q1 & 255) << 8) | ((unsigned)(q2 & 255) << 16) | ((unsigned)q3 << 24); }
        *(LAS v4u*)(lds + (wid * 8 + j) * 1024 + lane * 16) = o;
#ifdef PG_U4
        { const int one4 = 0x01010101; int sq = __builtin_amdgcn_sdot4((int)o[0], one4, 0, false); sq = __builtin_amdgcn_sdot4((int)o[1], one4, sq, false); sq = __builtin_amdgcn_sdot4((int)o[2], one4, sq, false); sq = __builtin_amdgcn_sdot4((int)o[3], one4, sq, false);
          const float sxs = wave_sum((float)sq); if (lane == 0) sxs_l[j] = sxs; }
#endif
        mysx = ((lane & 7) == j) ? sx : mysx; }
      { const f32x4 sa = sq_[0], sb = sq_[1], sc = sq_[2], sd = sq_[3];
        const float s = ((sa[0] + sa[1]) + (sa[2] + sa[3])) + ((sb[0] + sb[1]) + (sb[2] + sb[3])) + ((sc[0] + sc[1]) + (sc[2] + sc[3])) + ((sd[0] + sd[1]) + (sd[2] + sd[3]));
        if (lane < 8) rstd_l[lane] = mysx / sqrtf(s * (1.0f / 1024.0f) + NORM_EPS); } }
#else
#pragma unroll
    for (int j = 0; j < 8; ++j) { const bf16x8* src = (const bf16x8*)(X1B + (size_t)(tok0 + j) * DM); const bf16x8 a = src[2 * lane], b = src[2 * lane + 1];
        float xf[16]; float mx = 0.f;
#pragma unroll
        for (int e = 0; e < 8; ++e) { xf[e] = bf2f((unsigned short)a[e]); xf[8 + e] = bf2f((unsigned short)b[e]); mx = fmaxf(mx, fmaxf(fabsf(xf[e]), fabsf(xf[8 + e]))); }
        mx = wave_max(mx); const float sx = mx > 0.f ? mx * (1.0f / 127.0f) : 1.0f, inv = 1.0f / sx;
        v4u o;
#pragma unroll
        for (int q = 0; q < 4; ++q) { const int q0 = (int)rintf(xf[4 * q] * inv), q1 = (int)rintf(xf[4 * q + 1] * inv), q2 = (int)rintf(xf[4 * q + 2] * inv), q3 = (int)rintf(xf[4 * q + 3] * inv);
            o[q] = (unsigned)(q0 & 255) | ((unsigned)(q1 & 255) << 8) | ((unsigned)(q2 & 255) << 16) | ((unsigned)q3 << 24); }
        *(LAS v4u*)(lds + (wid * 8 + j) * 1024 + lane * 16) = o;
#ifdef PG_U4
        { const int one4 = 0x01010101; int sq = __builtin_amdgcn_sdot4((int)o[0], one4, 0, false); sq = __builtin_amdgcn_sdot4((int)o[1], one4, sq, false); sq = __builtin_amdgcn_sdot4((int)o[2], one4, sq, false); sq = __builtin_amdgcn_sdot4((int)o[3], one4, sq, false);
          const float sxs = wave_sum((float)sq); if (lane == 0) sxs_l[j] = sxs; }
#endif
        if (lane == 0) { const f32x4* sp = (const f32x4*)(SSP + (size_t)(tok0 + j) * 16); const f32x4 sa = sp[0], sb = sp[1], sc = sp[2], sd = sp[3];
            const float s = ((sa[0] + sa[1]) + (sa[2] + sa[3])) + ((sb[0] + sb[1]) + (sb[2] + sb[3])) + ((sc[0] + sc[1]) + (sc[2] + sc[3])) + ((sd[0] + sd[1]) + (sd[2] + sd[3]));
            rstd_l[j] = sx / sqrtf(s * (1.0f / 1024.0f) + NORM_EPS); } }
#endif
#if defined(PG_SORTX) && (PG_NGRP * 8 == 64)
    { LAS unsigned* cnt = (LAS unsigned*)(lds + XTRA_OFF + 9216) + wid * 512;
      *(LAS v4u*)(cnt + lane * 8) = (v4u){0u, 0u, 0u, 0u}; *(LAS v4u*)(cnt + lane * 8 + 4) = (v4u){0u, 0u, 0u, 0u};
      v4u ent[8]; const unsigned ts = (unsigned)(lane >> 3), pp = (unsigned)(lane & 7);
#ifdef PE_EARLY
#pragma unroll
      for (int i = 0; i < 8; ++i) ent[i] = ent_e[i];
#else
      { const v4u* pe = (const v4u*)(PE + (size_t)(tok0 + (lane >> 3)) * 128 + (lane & 7) * 16);
#pragma unroll
        for (int i = 0; i < 8; ++i) ent[i] = P7LD(pe + i); }
#endif
#pragma unroll
      for (int i = 0; i < 8; ++i) { __hip_atomic_fetch_add(cnt + (((ent[i][0] >> PG_GSH) * 8 + ts) * 8 + pp), 1u, __ATOMIC_RELAXED, __HIP_MEMORY_SCOPE_WORKGROUP);
                                    __hip_atomic_fetch_add(cnt + (((ent[i][2] >> PG_GSH) * 8 + ts) * 8 + pp), 1u, __ATOMIC_RELAXED, __HIP_MEMORY_SCOPE_WORKGROUP); }
      { v4u ca = *(LAS v4u*)(cnt + lane * 8), cb = *(LAS v4u*)(cnt + lane * 8 + 4);
        const unsigned e1 = ca[0], e2 = e1 + ca[1], e3 = e2 + ca[2], e4 = e3 + ca[3], e5 = e4 + cb[0], e6 = e5 + cb[1], e7 = e6 + cb[2], tot = e7 + cb[3];
        unsigned inc = tot;
#pragma unroll
        for (int o = 1; o < 64; o <<= 1) { const unsigned u = (unsigned)__shfl_up((int)inc, o); if (lane >= o) inc += u; }
        const unsigned b0 = inc - tot;
        *(LAS v4u*)(cnt + lane * 8) = (v4u){b0, b0 + e1, b0 + e2, b0 + e3}; *(LAS v4u*)(cnt + lane * 8 + 4) = (v4u){b0 + e4, b0 + e5, b0 + e6, b0 + e7};
        bstart[lane] = b0; bend[lane] = b0 + tot; }
#pragma unroll
      for (int i = 0; i < 8; ++i) {
          const unsigned p0 = __hip_atomic_fetch_add(cnt + (((ent[i][0] >> PG_GSH) * 8 + ts) * 8 + pp), 1u, __ATOMIC_RELAXED, __HIP_MEMORY_SCOPE_WORKGROUP);
          LIST[p0] = (unsigned long long)(ent[i][0] | (ts << 16)) | ((unsigned long long)ent[i][1] << 32);
          const unsigned p1 = __hip_atomic_fetch_add(cnt + (((ent[i][2] >> PG_GSH) * 8 + ts) * 8 + pp), 1u, __ATOMIC_RELAXED, __HIP_MEMORY_SCOPE_WORKGROUP);
          LIST[p1] = (unsigned long long)(ent[i][2] | (ts << 16)) | ((unsigned long long)ent[i][3] << 32); } }
#else
    bstart[lane] = 0u; bstart[64 + lane] = 0u;
    { v4u ent[8]; const unsigned ts = (unsigned)(lane >> 3);
      { const v4u* pe = (const v4u*)(PE + (size_t)(tok0 + (lane >> 3)) * 128 + (lane & 7) * 16);
#pragma unroll
        for (int i = 0; i < 8; ++i) ent[i] = pe[i]; }
#pragma unroll
      for (int i = 0; i < 8; ++i) { __hip_atomic_fetch_add(bstart + ((ent[i][0] >> PG_GSH) * 8 + ts), 1u, __ATOMIC_RELAXED, __HIP_MEMORY_SCOPE_WORKGROUP); __hip_atomic_fetch_add(bstart + ((ent[i][2] >> PG_GSH) * 8 + ts), 1u, __ATOMIC_RELAXED, __HIP_MEMORY_SCOPE_WORKGROUP); }
      { const unsigned c0 = bstart[2 * lane], c1 = bstart[2 * lane + 1]; unsigned inc = c0 + c1;
#pragma unroll
        for (int o = 1; o < 64; o <<= 1) { const unsigned u = (unsigned)__shfl_up((int)inc, o); if (lane >= o) inc += u; }
        const unsigned b0 = inc - (c0 + c1); bstart[2 * lane] = b0; bstart[2 * lane + 1] = b0 + c0; bend[2 * lane] = b0; bend[2 * lane + 1] = b0 + c0; }
#pragma unroll
      for (int i = 0; i < 8; ++i) {
          const unsigned p0 = __hip_atomic_fetch_add(bend + ((ent[i][0] >> PG_GSH) * 8 + ts), 1u, __ATOMIC_RELAXED, __HIP_MEMORY_SCOPE_WORKGROUP);
          LIST[p0] = (unsigned long long)(ent[i][0] | (ts << 16)) | ((unsigned long long)ent[i][1] << 32);
          const unsigned p1 = __hip_atomic_fetch_add(bend + ((ent[i][2] >> PG_GSH) * 8 + ts), 1u, __ATOMIC_RELAXED, __HIP_MEMORY_SCOPE_WORKGROUP);
          LIST[p1] = (unsigned long long)(ent[i][2] | (ts << 16)) | ((unsigned long long)ent[i][3] << 32); } }
#endif
    asm volatile("s_waitcnt vmcnt(0)" ::: "memory");
#ifdef P7_NOSYNC
    asm volatile("s_waitcnt lgkmcnt(0)" ::: "memory");
#else
    __syncthreads();
#endif
#ifdef PG_WMAXX
    LAS unsigned* wmx = (LAS unsigned*)(lds + XTRA_OFF + 9216) + wid * 512;
    *(LAS v4u*)(wmx + lane * 8) = (v4u){0u, 0u, 0u, 0u}; *(LAS v4u*)(wmx + lane * 8 + 4) = (v4u){0u, 0u, 0u, 0u};
#define PG_WMAX(t_, w_) __hip_atomic_fetch_max(wmx + (t_) * 64 + lane, __float_as_uint(fabsf(w_)), __ATOMIC_RELAXED, __HIP_MEMORY_SCOPE_WORKGROUP)
#else
#define PG_WMAX(t_, w_) __hip_atomic_fetch_max(wmax_l + (t_), __float_as_uint(fabsf(w_)), __ATOMIC_RELAXED, __HIP_MEMORY_SCOPE_WORKGROUP)
#endif
#ifdef DUP_PHASE
    const unsigned eimask = (F.flags & 8) ? 0xFFu : 0xFFFFu;
#else
    constexpr unsigned eimask = 0xFFFFu;
#endif
#define PG_ISSUE(dst, TAB, r) do { _Pragma("unroll") for (int k = 0; k < 8; ++k) { const unsigned ei = (unsigned)__builtin_amdgcn_readlane((int)(unsigned)(r), k) & eimask; dst[k] = *(const v4u*)(TAB + (size_t)ei * DM + 16 * lane); } } while (0)
#if defined(PG_U4) && defined(PG_U64)
#ifdef DUP_PHASE
    if (!(F.flags & 1))
#endif
    {
        const float* SU = WSP(float, WS_SU);
        const int hl = lane & 31; const bool hf = lane >= 32;
        const LAS char* xw = lds + wid * 8 * 1024 + hl * 32;
        const unsigned char* ub = U8 + 16 * hl;
        const LAS unsigned* LIST32 = (const LAS unsigned*)LIST;
        const int ridx = ((lane >> 1) & 2) + ((lane >> 3) & 1) + ((lane >> 2) & 4) + ((lane >> 2) & 8), i4 = lane & 3;
        const bool b2 = (lane & 4) != 0, b3 = (lane & 8) != 0;
        unsigned rA = LIST32[2 * (lane & 15)];
        v4u ur[8];
#pragma unroll
        for (int k = 0; k < 8; ++k) { const unsigned e0 = (unsigned)__builtin_amdgcn_readlane((int)rA, k), e1 = (unsigned)__builtin_amdgcn_readlane((int)rA, k + 8);
            ur[k] = *(const v4u*)(ub + (size_t)((hf ? e1 : e0) & 0xFFFFu) * (DM / 2)); }
        for (int sb = 0; sb < 16; ++sb) {
            const int mypos = sb * 64 + 16 * i4 + ridx;
            const unsigned long long mine = LIST[mypos];
            const float sum = SU[(unsigned)mine & 0xFFFFu], svm = SU[NEXP + ((unsigned)mine & 0xFFFFu)];
            int sel = 0;
#pragma unroll
            for (int i = 0; i < 4; ++i) {
                const int nb = sb * 4 + i + 1 < 64 ? sb * 4 + i + 1 : 63;
                const unsigned nA = LIST32[2 * (nb * 16 + (lane & 15))];
                int d[8];
#pragma unroll
                for (int k = 0; k < 8; ++k) { const unsigned e0 = (unsigned)__builtin_amdgcn_readlane((int)rA, k), e1 = (unsigned)__builtin_amdgcn_readlane((int)rA, k + 8);
                    const int tk = (int)(((hf ? e1 : e0) >> 16) & 7u);
                    const v4u x0 = *(const LAS v4u*)(xw + tk * 1024), x1 = *(const LAS v4u*)(xw + tk * 1024 + 16);
                    int s0_ = 0, s1_ = 0;
                    s0_ = __builtin_amdgcn_sdot4((int)(ur[k][0] & 0x0F0F0F0Fu), (int)x0[0], s0_, false); s1_ = __builtin_amdgcn_sdot4((int)((ur[k][0] >> 4) & 0x0F0F0F0Fu), (int)x0[1], s1_, false);
                    s0_ = __builtin_amdgcn_sdot4((int)(ur[k][1] & 0x0F0F0F0Fu), (int)x0[2], s0_, false); s1_ = __builtin_amdgcn_sdot4((int)((ur[k][1] >> 4) & 0x0F0F0F0Fu), (int)x0[3], s1_, false);
                    s0_ = __builtin_amdgcn_sdot4((int)(ur[k][2] & 0x0F0F0F0Fu), (int)x1[0], s0_, false); s1_ = __builtin_amdgcn_sdot4((int)((ur[k][2] >> 4) & 0x0F0F0F0Fu), (int)x1[1], s1_, false);
                    s0_ = __builtin_amdgcn_sdot4((int)(ur[k][3] & 0x0F0F0F0Fu), (int)x1[2], s0_, false); s1_ = __builtin_amdgcn_sdot4((int)((ur[k][3] >> 4) & 0x0F0F0F0Fu), (int)x1[3], s1_, false);
                    d[k] = s0_ + s1_;
                    { const unsigned n0 = (unsigned)__builtin_amdgcn_readlane((int)nA, k), n1 = (unsigned)__builtin_amdgcn_readlane((int)nA, k + 8);
                      ur[k] = *(const v4u*)(ub + (size_t)((hf ? n1 : n0) & 0xFFFFu) * (DM / 2)); } }
                int s4[4];
#pragma unroll
                for (int k = 0; k < 4; ++k) { auto r = __builtin_amdgcn_permlane16_swap((unsigned)d[k], (unsigned)d[k + 4], false, false); s4[k] = (int)(r[0] + r[1]); }
                const int r0 = (b3 ? s4[1] : s4[0]) + dppi<0x128>(b3 ? s4[0] : s4[1]);
                const int r1 = (b3 ? s4[3] : s4[2]) + dppi<0x128>(b3 ? s4[2] : s4[3]);
                int tot = (b2 ? r1 : r0) + dppi<0x141>(b2 ? r0 : r1);
                tot += dppi<0xB1>(tot); tot += dppi<0x4E>(tot);
                sel = (i4 == i) ? tot : sel;
                rA = nA;
            }
            const unsigned tsl = ((unsigned)mine >> 16) & 7u;
            const float w = __uint_as_float((unsigned)(mine >> 32)) * gelu_erf(((float)sel - 7.5f * sxs_l[tsl]) * sum * rstd_l[tsl]) * svm;
            WL[mypos] = w; __hip_atomic_fetch_max(wmax_l + tsl, __float_as_uint(fabsf(w)), __ATOMIC_RELAXED, __HIP_MEMORY_SCOPE_WORKGROUP);
        }
    }
#elif defined(PG_U4)
#ifdef DUP_PHASE
    if (!(F.flags & 1))
#endif
    {
        const float* SU = WSP(float, WS_SU);
        const int hl = lane & 31; const bool hf = lane >= 32;
        const LAS char* xw = lds + wid * 8 * 1024 + hl * 32;
        const unsigned char* ub = U8 + 16 * hl;
#define PG_ISSUE4(dst, r) do { _Pragma("unroll") for (int k = 0; k < 8; ++k) { const unsigned e0 = (unsigned)__builtin_amdgcn_readlane((int)(unsigned)(r), k), e1 = (unsigned)__builtin_amdgcn_readlane((int)(unsigned)(r), k + 8); \
            const unsigned ei = (hf ? e1 : e0) & 0xFFFFu; dst[k] = *(const v4u*)(ub + (size_t)ei * (DM / 2)); } } while (0)
        unsigned long long rA = LIST[lane & 15]; float sA = SU[(unsigned)rA & 0xFFFFu], vA = SU[NEXP + ((unsigned)rA & 0xFFFFu)];
        v4u ur[8];
        PG_ISSUE4(ur, rA);
        const int ridx = ((lane >> 1) & 2) + ((lane >> 3) & 1) + ((lane >> 2) & 4) + ((lane >> 2) & 8);
        const bool b2 = (lane & 4) != 0, b3 = (lane & 8) != 0;
        for (int b = 0; b < 64; ++b) {
            unsigned long long nA = rA; float nS = sA, nV = vA; if (b + 1 < 64) { nA = LIST[(b + 1) * 16 + (lane & 15)]; nS = SU[(unsigned)nA & 0xFFFFu]; nV = SU[NEXP + ((unsigned)nA & 0xFFFFu)]; }
            float d[8];
#pragma unroll
            for (int k = 0; k < 8; ++k) { const unsigned e0 = (unsigned)__builtin_amdgcn_readlane((int)(unsigned)rA, k), e1 = (unsigned)__builtin_amdgcn_readlane((int)(unsigned)rA, k + 8);
                const int tk = (int)(((hf ? e1 : e0) >> 16) & 7u);
                const v4u x0 = *(const LAS v4u*)(xw + tk * 1024), x1 = *(const LAS v4u*)(xw + tk * 1024 + 16);
                int s0_ = 0, s1_ = 0;
                s0_ = __builtin_amdgcn_sdot4((int)(ur[k][0] & 0x0F0F0F0Fu), (int)x0[0], s0_, false); s1_ = __builtin_amdgcn_sdot4((int)((ur[k][0] >> 4) & 0x0F0F0F0Fu), (int)x0[1], s1_, false);
                s0_ = __builtin_amdgcn_sdot4((int)(ur[k][1] & 0x0F0F0F0Fu), (int)x0[2], s0_, false); s1_ = __builtin_amdgcn_sdot4((int)((ur[k][1] >> 4) & 0x0F0F0F0Fu), (int)x0[3], s1_, false);
                s0_ = __builtin_amdgcn_sdot4((int)(ur[k][2] & 0x0F0F0F0Fu), (int)x1[0], s0_, false); s1_ = __builtin_amdgcn_sdot4((int)((ur[k][2] >> 4) & 0x0F0F0F0Fu), (int)x1[1], s1_, false);
                s0_ = __builtin_amdgcn_sdot4((int)(ur[k][3] & 0x0F0F0F0Fu), (int)x1[2], s0_, false); s1_ = __builtin_amdgcn_sdot4((int)((ur[k][3] >> 4) & 0x0F0F0F0Fu), (int)x1[3], s1_, false);
                d[k] = (float)(s0_ + s1_); }
            if (b + 1 < 64) PG_ISSUE4(ur, nA);
            float s4[4];
#pragma unroll
            for (int k = 0; k < 4; ++k) { auto r = __builtin_amdgcn_permlane16_swap(__float_as_uint(d[k]), __float_as_uint(d[k + 4]), false, false); s4[k] = __uint_as_float(r[0]) + __uint_as_float(r[1]); }
            const float r0 = (b3 ? s4[1] : s4[0]) + dppf<0x128>(b3 ? s4[0] : s4[1]);
            const float r1 = (b3 ? s4[3] : s4[2]) + dppf<0x128>(b3 ? s4[2] : s4[3]);
            float tot = (b2 ? r1 : r0) + dppf<0x141>(b2 ? r0 : r1);
            tot += dppf<0xB1>(tot); tot += dppf<0x4E>(tot);
            const unsigned long long mine = __shfl((long long)rA, ridx);
            const float sum = __shfl(sA, ridx), svm = __shfl(vA, ridx); const unsigned tsl = ((unsigned)mine >> 16) & 7u;
            const float w = __uint_as_float((unsigned)(mine >> 32)) * gelu_erf((tot - 7.5f * sxs_l[tsl]) * sum * rstd_l[tsl]) * svm;
            if ((lane & 3) == 0) { WL[b * 16 + ridx] = w; __hip_atomic_fetch_max(wmax_l + tsl, __float_as_uint(fabsf(w)), __ATOMIC_RELAXED, __HIP_MEMORY_SCOPE_WORKGROUP); }
            rA = nA; sA = nS; vA = nV;
        }
#undef PG_ISSUE4
    }
#elif defined(PG_UMFMA)
#ifdef DUP_PHASE
    if (!(F.flags & 1))
#endif
    {
        typedef int v4i_t __attribute__((ext_vector_type(4)));
        const float* SU = WSP(float, WS_SU);
        const int n16 = lane & 15, kq = lane >> 4;
        v4i_t ax[16];
        { const LAS char* xr = lds + (wid * 8 + (n16 & 7)) * 1024 + 32 * kq;
#pragma unroll
          for (int s = 0; s < 16; ++s) ax[s] = *(const LAS v4i_t*)(xr + 128 * (s >> 1) + 16 * (s & 1)); }
        const unsigned char* ub = U8 + 32 * kq;
        unsigned long long rec = LIST[n16];
        float su = SU[(unsigned)rec & 0xFFFFu], sv = SU[NEXP + ((unsigned)rec & 0xFFFFu)];
        v4i_t bx[16];
        { const unsigned char* rp = ub + (size_t)((unsigned)rec & 0xFFFFu) * DM;
#pragma unroll
          for (int s = 0; s < 16; ++s) bx[s] = *(const v4i_t*)(rp + 128 * (s >> 1) + 16 * (s & 1)); }
        for (int b = 0; b < 64; ++b) {
            const int nb = b + 1 < 64 ? b + 1 : 63;
            const unsigned long long nrec = LIST[nb * 16 + n16];
            const float nsu = SU[(unsigned)nrec & 0xFFFFu], nsv = SU[NEXP + ((unsigned)nrec & 0xFFFFu)];
            const unsigned char* rp = ub + (size_t)((unsigned)nrec & 0xFFFFu) * DM;
            v4i_t acc0 = (v4i_t){0, 0, 0, 0}, acc1 = (v4i_t){0, 0, 0, 0};
#pragma unroll
            for (int s = 0; s < 16; s += 2) {
                acc0 = __builtin_amdgcn_mfma_i32_16x16x64_i8(ax[s], bx[s], acc0, 0, 0, 0);         bx[s] = *(const v4i_t*)(rp + 128 * (s >> 1));
                acc1 = __builtin_amdgcn_mfma_i32_16x16x64_i8(ax[s + 1], bx[s + 1], acc1, 0, 0, 0); bx[s + 1] = *(const v4i_t*)(rp + 128 * (s >> 1) + 16); }
            const unsigned tsl = ((unsigned)rec >> 16) & 7u, r4 = tsl & 3u;
            const int t01 = (r4 & 1u) ? acc0[1] + acc1[1] : acc0[0] + acc1[0], t23 = (r4 & 1u) ? acc0[3] + acc1[3] : acc0[2] + acc1[2];
            const float tot = (float)((r4 & 2u) ? t23 : t01);
            const float w = __uint_as_float((unsigned)(rec >> 32)) * gelu_erf(tot * su * rstd_l[tsl]) * sv;
            if ((unsigned)kq == (tsl >> 2)) { WL[b * 16 + n16] = w; __hip_atomic_fetch_max(wmax_l + tsl, __float_as_uint(fabsf(w)), __ATOMIC_RELAXED, __HIP_MEMORY_SCOPE_WORKGROUP); }
            rec = nrec; su = nsu; sv = nsv;
        }
    }
#elif defined(PG_U64)
#ifdef DUP_PHASE
    if (F.flags & 128)
    {
        const float* SU = WSP(float, WS_SU);
        const LAS char* xw = lds + wid * 8 * 1024 + lane * 16;
        const LAS unsigned* LIST32 = (const LAS unsigned*)LIST; const v4u xfix = *(const LAS v4u*)(xw);
        const int g8 = lane >> 3, i8 = lane & 7; const unsigned voff = 16u * (unsigned)lane;
        unsigned rA = LIST32[2 * (lane & 7)];
        v4u ur[8];
        PG_ISSUE(ur, U8, rA);
        for (int sb = 0; sb < 16; ++sb) {
            const int mypos = sb * 64 + 8 * i8 + g8;
            const unsigned long long mine = LIST[mypos];
            const float sum = SU[(unsigned)mine & 0xFFFFu], svm = SU[NEXP + ((unsigned)mine & 0xFFFFu)];
            int sel = 0;
#pragma unroll
            for (int i = 0; i < 8; ++i) {
                const int nb = sb * 8 + i + 1 < 128 ? sb * 8 + i + 1 : 127;
                const unsigned nA = LIST32[2 * (nb * 8 + (lane & 7))];
                int d[8];
#pragma unroll
                for (int k = 0; k < 8; ++k) { const int tk = (int)(((unsigned)__builtin_amdgcn_readlane((int)rA, k) >> 16) & 7u);
                    v4u x = xfix; x[0] ^= (unsigned)tk;
#ifdef PG_UTRIM
                    int sd_ = dot4_0(ur[k][0], x[0]);
#else
                    int sd_ = __builtin_amdgcn_sdot4((int)ur[k][0], (int)x[0], 0, false);
#endif
                    sd_ = __builtin_amdgcn_sdot4((int)ur[k][1], (int)x[1], sd_, false);
                    sd_ = __builtin_amdgcn_sdot4((int)ur[k][2], (int)x[2], sd_, false); sd_ = __builtin_amdgcn_sdot4((int)ur[k][3], (int)x[3], sd_, false);
                    d[k] = sd_;
                    { const unsigned ei = (unsigned)__builtin_amdgcn_readlane((int)nA, k) & 0xFFFFu;
#ifdef PG_USADDR
                      const __attribute__((address_space(1))) unsigned char* rowp = (const __attribute__((address_space(1))) unsigned char*)(U8 + (size_t)ei * DM); asm volatile("" : "+s"(rowp));
                      unsigned vo_ = voff; asm volatile("" : "+v"(vo_));
                      ur[k] = *(const __attribute__((address_space(1))) v4u*)(rowp + vo_);
#else
                      ur[k] = *(const v4u*)(U8 + (size_t)ei * DM + 16 * lane);
#endif
                    } }
                const int tot = reduce8i(d, lane);
                sel = (i8 == i) ? tot : sel;
                rA = nA;
            }
            const unsigned tsl = ((unsigned)mine >> 16) & 7u;
            const float w = __uint_as_float((unsigned)(mine >> 32)) * gelu_erf((float)sel * sum * rstd_l[tsl]) * svm;
            WL[mypos] = w; PG_WMAX(tsl, w);
        }
    }
    else
#endif
#ifdef DUP_PHASE
    if (!(F.flags & 1))
#endif
    {
        const float* SU = WSP(float, WS_SU);
        const LAS char* xw = lds + wid * 8 * 1024 + lane * 16;
        const LAS unsigned* LIST32 = (const LAS unsigned*)LIST;
        const int g8 = lane >> 3, i8 = lane & 7; const unsigned voff = 16u * (unsigned)lane;
        unsigned rA = LIST32[2 * (lane & 7)];
        v4u ur[8];
        PG_ISSUE(ur, U8, rA);
        for (int sb = 0; sb < 16; ++sb) {
            const int mypos = sb * 64 + 8 * i8 + g8;
            const unsigned long long mine = LIST[mypos];
            const float sum = SU[(unsigned)mine & 0xFFFFu], svm = SU[NEXP + ((unsigned)mine & 0xFFFFu)];
            int sel = 0;
#pragma unroll
            for (int i = 0; i < 8; ++i) {
                const int nb = sb * 8 + i + 1 < 128 ? sb * 8 + i + 1 : 127;
                const unsigned nA = LIST32[2 * (nb * 8 + (lane & 7))];
                int d[8];
#pragma unroll
                for (int k = 0; k < 8; ++k) { const int tk = (int)(((unsigned)__builtin_amdgcn_readlane((int)rA, k) >> 16) & 7u);
                    const v4u x = *(const LAS v4u*)(xw + tk * 1024);
#ifdef PG_UTRIM
                    int sd_ = dot4_0(ur[k][0], x[0]);
#else
                    int sd_ = __builtin_amdgcn_sdot4((int)ur[k][0], (int)x[0], 0, false);
#endif
                    sd_ = __builtin_amdgcn_sdot4((int)ur[k][1], (int)x[1], sd_, false);
                    sd_ = __builtin_amdgcn_sdot4((int)ur[k][2], (int)x[2], sd_, false); sd_ = __builtin_amdgcn_sdot4((int)ur[k][3], (int)x[3], sd_, false);
                    d[k] = sd_;
                    { const unsigned ei = (unsigned)__builtin_amdgcn_readlane((int)nA, k) & 0xFFFFu;
#ifdef PG_USADDR
                      const __attribute__((address_space(1))) unsigned char* rowp = (const __attribute__((address_space(1))) unsigned char*)(U8 + (size_t)ei * DM); asm volatile("" : "+s"(rowp));
                      unsigned vo_ = voff; asm volatile("" : "+v"(vo_));
                      ur[k] = *(const __attribute__((address_space(1))) v4u*)(rowp + vo_);
#else
                      ur[k] = *(const v4u*)(U8 + (size_t)ei * DM + 16 * lane);
#endif
                    } }
                const int tot = reduce8i(d, lane);
                sel = (i8 == i) ? tot : sel;
                rA = nA;
            }
            const unsigned tsl = ((unsigned)mine >> 16) & 7u;
            const float w = __uint_as_float((unsigned)(mine >> 32)) * gelu_erf((float)sel * sum * rstd_l[tsl]) * svm;
            WL[mypos] = w; PG_WMAX(tsl, w);
        }
    }
#elif defined(PG_U64D)
#ifdef DUP_PHASE
    if (!(F.flags & 1))
#endif
    {
        const float* SU = WSP(float, WS_SU);
        const LAS char* xw = lds + wid * 8 * 1024 + lane * 16;
        const LAS unsigned* LIST32 = (const LAS unsigned*)LIST;
        const int g8 = lane >> 3, i8 = lane & 7;
        unsigned rA0 = LIST32[2 * (lane & 7)], rA1 = LIST32[2 * (8 + (lane & 7))];
        v4u ur0[8], ur1[8];
        PG_ISSUE(ur0, U8, rA0); PG_ISSUE(ur1, U8, rA1);
        for (int sb = 0; sb < 16; ++sb) {
            const int mypos = sb * 64 + 8 * i8 + g8;
            const unsigned long long mine = LIST[mypos];
            const float sum = SU[(unsigned)mine & 0xFFFFu], svm = SU[NEXP + ((unsigned)mine & 0xFFFFu)];
            float sel = 0.f;
#define PG_UB(UR, RA, i) { \
                const int nb = sb * 8 + (i) + 2 < 128 ? sb * 8 + (i) + 2 : 127;       \
                const unsigned nA = LIST32[2 * (nb * 8 + (lane & 7))]; \
                float d[8]; \
                _Pragma("unroll") for (int k = 0; k < 8; ++k) { const int tk = (int)(((unsigned)__builtin_amdgcn_readlane((int)RA, k) >> 16) & 7u); \
                    const v4u x = *(const LAS v4u*)(xw + tk * 1024); \
                    int sd_ = __builtin_amdgcn_sdot4((int)UR[k][0], (int)x[0], 0, false); sd_ = __builtin_amdgcn_sdot4((int)UR[k][1], (int)x[1], sd_, false); \
                    sd_ = __builtin_amdgcn_sdot4((int)UR[k][2], (int)x[2], sd_, false); sd_ = __builtin_amdgcn_sdot4((int)UR[k][3], (int)x[3], sd_, false); \
                    d[k] = (float)sd_; \
                    { const unsigned ei = (unsigned)__builtin_amdgcn_readlane((int)nA, k) & 0xFFFFu; UR[k] = *(const v4u*)(U8 + (size_t)ei * DM + 16 * lane); } } \
                const float tot = reduce8(d, lane); \
                sel = (i8 == (i)) ? tot : sel; \
                RA = nA; }
            PG_UB(ur0, rA0, 0) PG_UB(ur1, rA1, 1) PG_UB(ur0, rA0, 2) PG_UB(ur1, rA1, 3) PG_UB(ur0, rA0, 4) PG_UB(ur1, rA1, 5) PG_UB(ur0, rA0, 6) PG_UB(ur1, rA1, 7)
#undef PG_UB
            const unsigned tsl = ((unsigned)mine >> 16) & 7u;
            const float w = __uint_as_float((unsigned)(mine >> 32)) * gelu_erf(sel * sum * rstd_l[tsl]) * svm;
            WL[mypos] = w; __hip_atomic_fetch_max(wmax_l + tsl, __float_as_uint(fabsf(w)), __ATOMIC_RELAXED, __HIP_MEMORY_SCOPE_WORKGROUP);
        }
    }
#elif defined(PG_U2BUF)
#ifdef DUP_PHASE
    if (!(F.flags & 1))
#endif
    {
        const float* SU = WSP(float, WS_SU);
        const LAS char* xw = lds + wid * 8 * 1024 + lane * 16;
        unsigned long long r0 = LIST[lane & 7], r1 = LIST[8 + (lane & 7)];
        float s0 = SU[(unsigned)r0 & 0xFFFFu], v0 = SU[NEXP + ((unsigned)r0 & 0xFFFFu)], s1 = SU[(unsigned)r1 & 0xFFFFu], v1 = SU[NEXP + ((unsigned)r1 & 0xFFFFu)];
        v4u ur0[8], ur1[8];
        PG_ISSUE(ur0, U8, r0); PG_ISSUE(ur1, U8, r1);
#ifdef DUP_PHASE
#define PG_ULOADONLY(UR, R, S, V, bb) if (F.flags & 4) { unsigned o_ = 0; _Pragma("unroll") for (int k = 0; k < 8; ++k) o_ |= UR[k][0] ^ UR[k][1] ^ UR[k][2] ^ UR[k][3]; \
            PG_ISSUE(UR, U8, nR); if (o_ == 0x12345u) WL[(bb) * 8] = 1.0f; R = nR; S = nS; V = nV; } else
#else
#define PG_ULOADONLY(UR, R, S, V, bb)
#endif
#define PG_USTEP(UR, R, S, V, bb) { \
            const int nb_ = (bb) + 2 < 128 ? (bb) + 2 : 127;        \
            const unsigned long long nR = LIST[nb_ * 8 + (lane & 7)]; const float nS = SU[(unsigned)nR & 0xFFFFu], nV = SU[NEXP + ((unsigned)nR & 0xFFFFu)]; \
            PG_ULOADONLY(UR, R, S, V, bb) { \
            float d[8]; \
            _Pragma("unroll") for (int k = 0; k < 8; ++k) { const int tk = (int)(((unsigned)__builtin_amdgcn_readlane((int)(unsigned)R, k) >> 16) & 7u); \
                const v4u x = *(const LAS v4u*)(xw + tk * 1024); \
                int sd_ = __builtin_amdgcn_sdot4((int)UR[k][0], (int)x[0], 0, false); sd_ = __builtin_amdgcn_sdot4((int)UR[k][1], (int)x[1], sd_, false); \
                sd_ = __builtin_amdgcn_sdot4((int)UR[k][2], (int)x[2], sd_, false); sd_ = __builtin_amdgcn_sdot4((int)UR[k][3], (int)x[3], sd_, false); \
                d[k] = (float)sd_; } \
            PG_ISSUE(UR, U8, nR); \
            const float tot = reduce8(d, lane); \
            const unsigned long long mine = __shfl((long long)R, lane >> 3); \
            const float sum = __shfl(S, lane >> 3), svm = __shfl(V, lane >> 3); const unsigned tsl = ((unsigned)mine >> 16) & 7u; \
            const float w = __uint_as_float((unsigned)(mine >> 32)) * gelu_erf(tot * sum * rstd_l[tsl]) * svm; \
            if ((lane & 7) == 0) { WL[(bb) * 8 + (lane >> 3)] = w; __hip_atomic_fetch_max(wmax_l + tsl, __float_as_uint(fabsf(w)), __ATOMIC_RELAXED, __HIP_MEMORY_SCOPE_WORKGROUP); } \
            R = nR; S = nS; V = nV; } }
        for (int b = 0; b < 128; b += 2) { PG_USTEP(ur0, r0, s0, v0, b) PG_USTEP(ur1, r1, s1, v1, b + 1) }
#undef PG_USTEP
#undef PG_ULOADONLY
    }
#elif !defined(PG_NO_U)
#ifdef DUP_PHASE
    if (!(F.flags & 1))
#endif
    {
        const float* SU = WSP(float, WS_SU);
        const LAS char* xw = lds + wid * 8 * 1024 + lane * 16;
        unsigned long long rA = LIST[lane & 7]; float sA = SU[(unsigned)rA & 0xFFFFu], vA = SU[NEXP + ((unsigned)rA & 0xFFFFu)];
        v4u ur[8];
        PG_ISSUE(ur, U8, rA);
        for (int b = 0; b < 128; ++b) {
            unsigned long long nA = rA; float nS = sA, nV = vA; if (b + 1 < 128) { nA = LIST[(b + 1) * 8 + (lane & 7)]; nS = SU[(unsigned)nA & 0xFFFFu]; nV = SU[NEXP + ((unsigned)nA & 0xFFFFu)]; }
            float d[8];
#ifdef DUP_PHASE
            if (F.flags & 4) { unsigned o_ = 0;
#pragma unroll
                for (int k = 0; k < 8; ++k) o_ |= ur[k][0] ^ ur[k][1] ^ ur[k][2] ^ ur[k][3];
                if (b + 1 < 128) PG_ISSUE(ur, U8, nA);
                if (o_ == 0x12345u) WL[b * 8] = 1.0f;
                rA = nA; sA = nS; vA = nV; continue; }
#endif
#pragma unroll
            for (int k = 0; k < 8; ++k) { const int tk = (int)(((unsigned)__builtin_amdgcn_readlane((int)(unsigned)rA, k) >> 16) & 7u);
                const v4u x = *(const LAS v4u*)(xw + tk * 1024);
                const int s0_ = __builtin_amdgcn_sdot4((int)ur[k][1], (int)x[1], __builtin_amdgcn_sdot4((int)ur[k][0], (int)x[0], 0, false), false);
                const int s1_ = __builtin_amdgcn_sdot4((int)ur[k][3], (int)x[3], __builtin_amdgcn_sdot4((int)ur[k][2], (int)x[2], 0, false), false);
                d[k] = (float)(s0_ + s1_); }
            if (b + 1 < 128) PG_ISSUE(ur, U8, nA);
            const float tot = reduce8(d, lane);
            const unsigned long long mine = __shfl((long long)rA, lane >> 3);
            const float sum = __shfl(sA, lane >> 3), svm = __shfl(vA, lane >> 3); const unsigned tsl = ((unsigned)mine >> 16) & 7u;
            const float w = __uint_as_float((unsigned)(mine >> 32)) * gelu_erf(tot * sum * rstd_l[tsl]) * svm;
            if ((lane & 7) == 0) { WL[b * 8 + (lane >> 3)] = w; __hip_atomic_fetch_max(wmax_l + tsl, __float_as_uint(fabsf(w)), __ATOMIC_RELAXED, __HIP_MEMORY_SCOPE_WORKGROUP); }
            rA = nA; sA = nS; vA = nV;
        }
    }
#endif
    asm volatile("s_waitcnt vmcnt(0)" ::: "memory");
    int acc[8][16];
#pragma unroll
    for (int j = 0; j < 8; ++j)
#pragma unroll
        for (int q = 0; q < 16; ++q) acc[j][q] = 0;
#ifdef PG_WMAXX
#pragma unroll
    for (int t = 0; t < 8; ++t) { const float m_ = wave_max(__uint_as_float(wmx[t * 64 + lane])); if (lane == 0) wmax_l[t] = __float_as_uint(m_); }
#endif
#ifdef PG_QSONCE
    LAS float* qs_l = (LAS float*)(lds + XTRA_OFF + 768) + wid * 8;
    if (lane < 8) { const float wm_ = __uint_as_float(wmax_l[lane]); qs_l[lane] = wm_ > 0.f ? 127.0f * __builtin_amdgcn_rcpf(wm_) : 0.f; }
#define PG_QS(j) qs_l[j]
#ifdef PG_GHEAD
    const float qs_v = qs_l[lane & 7];
#define PG_GROUP_HEAD const int bs_v = (int)bstart[g * 8 + (lane & 7)], be_v = (int)bend[g * 8 + (lane & 7)];
#define PG_BS(j) __builtin_amdgcn_readlane(bs_v, j)
#define PG_BE(j) __builtin_amdgcn_readlane(be_v, j)
#define PG_QSV(j) __int_as_float(__builtin_amdgcn_readlane(__float_as_int(qs_v), j))
#endif
#else
#define PG_QS(j) (__uint_as_float(wmax_l[j]) > 0.f ? 127.0f / __uint_as_float(wmax_l[j]) : 0.f)
#endif
#ifndef PG_GROUP_HEAD
#define PG_GROUP_HEAD
#define PG_BS(j) ((int)bstart[g * 8 + j])
#define PG_BE(j) ((int)bend[g * 8 + j])
#define PG_QSV(j) PG_QS(j)
#endif
    asm volatile("s_waitcnt lgkmcnt(0)" ::: "memory");
#ifdef PG_VSTAGGER
    if (wid & 4) { __builtin_amdgcn_s_sleep(PG_VSTAGGER); }
#endif
#ifdef PG_VDMA
#define PG_DMA16(gsrc, ldsdst) asm volatile("s_mov_b32 m0, %0\n\ts_nop 0\n\tglobal_load_lds_dwordx4 %1, off" :: "s"((unsigned)(size_t)(ldsdst)), "v"((const void*)(gsrc)) : "memory", "m0")
    const LAS unsigned* LIST32v = (const LAS unsigned*)LIST;
    LAS char* ring = lds + wid * 8 * 1024;
    float mww = WL[lane & 15];
    { const unsigned m0 = LIST32v[2 * (lane & 15)]; const int n0 = (int)bend[0] < 8 ? (int)bend[0] : 8;
#pragma unroll
      for (int k = 0; k < 8; ++k) { const unsigned e0_ = (unsigned)__builtin_amdgcn_readlane((int)m0, 0), ek_ = (unsigned)__builtin_amdgcn_readlane((int)m0, k);
          const unsigned ei = (k < n0 ? ek_ : e0_) & 0xFFFFu; PG_DMA16(V8 + (size_t)ei * DM + 16 * lane, ring + k * 1024); } }
#define PG_RUN(j) { const int rs_ = (int)bstart[g * 8 + j], re_ = (int)bend[g * 8 + j]; const float qs_ = PG_QS(j); \
        for (int pos = rs_; pos < re_; ) { const int nv = re_ - pos < 8 ? re_ - pos : 8; const int np_ = pos + nv; \
            int ne_ = re_; if (np_ >= re_) { int bi_ = g * 8 + j + 1; while (bi_ < 8 * PG_NGRP && (int)bend[bi_] <= np_) ++bi_; ne_ = bi_ < 8 * PG_NGRP ? (int)bend[bi_] : np_; }     \
            const int nn_ = ne_ - np_ < 8 ? ne_ - np_ : 8;                                                   \
            const int ix_ = np_ + (lane & 15) < 1024 ? np_ + (lane & 15) : 1023; const unsigned nmrr = LIST32v[2 * ix_]; \
            asm volatile("s_waitcnt vmcnt(0)" ::: "memory");                                                 \
            int wq_ = ((lane & 15) < nv ? (int)rintf(mww * qs_) : 0) & 255; asm volatile("" : "+v"(wq_));      \
            v4u vr[8]; \
            _Pragma("unroll") for (int k = 0; k < 8; ++k) vr[k] = *(const LAS v4u*)(ring + k * 1024 + lane * 16); \
            asm volatile("s_waitcnt lgkmcnt(0)" ::: "memory");                                               \
            const unsigned ne0_ = (unsigned)__builtin_amdgcn_readlane((int)nmrr, 0); \
            _Pragma("unroll") for (int k = 0; k < 8; ++k) { const unsigned ek_ = (unsigned)__builtin_amdgcn_readlane((int)nmrr, k); const unsigned ei = (k < nn_ ? ek_ : ne0_) & 0xFFFFu; \
                PG_DMA16(V8 + (size_t)ei * DM + 16 * lane, ring + k * 1024); }     \
            const float nmww = WL[ix_]; \
            _Pragma("unroll") for (int gq = 0; gq < 2; ++gq) { \
                const int w4_ = __builtin_amdgcn_readlane(wq_, 4 * gq) | (__builtin_amdgcn_readlane(wq_, 4 * gq + 1) << 8) | (__builtin_amdgcn_readlane(wq_, 4 * gq + 2) << 16) | (__builtin_amdgcn_readlane(wq_, 4 * gq + 3) << 24); \
                _Pragma("unroll") for (int q = 0; q < 4; ++q) { const unsigned r0 = vr[4 * gq][q], r1 = vr[4 * gq + 1][q], r2 = vr[4 * gq + 2][q], r3 = vr[4 * gq + 3][q]; \
                    const unsigned t0 = __builtin_amdgcn_perm(r1, r0, 0x05010400u), t1 = __builtin_amdgcn_perm(r1, r0, 0x07030602u), t2 = __builtin_amdgcn_perm(r3, r2, 0x05010400u), t3 = __builtin_amdgcn_perm(r3, r2, 0x07030602u); \
                    acc[j][4 * q + 0] = __builtin_amdgcn_sdot4((int)__builtin_amdgcn_perm(t2, t0, 0x05040100u), w4_, acc[j][4 * q + 0], false); \
                    acc[j][4 * q + 1] = __builtin_amdgcn_sdot4((int)__builtin_amdgcn_perm(t2, t0, 0x07060302u), w4_, acc[j][4 * q + 1], false); \
                    acc[j][4 * q + 2] = __builtin_amdgcn_sdot4((int)__builtin_amdgcn_perm(t3, t1, 0x05040100u), w4_, acc[j][4 * q + 2], false); \
                    acc[j][4 * q + 3] = __builtin_amdgcn_sdot4((int)__builtin_amdgcn_perm(t3, t1, 0x07060302u), w4_, acc[j][4 * q + 3], false); } } \
            mww = nmww; pos = np_; } }
#elif defined(PG_VROLL)
    const LAS unsigned* LIST32v = (const LAS unsigned*)LIST;
    float mww = WL[lane & 15];
    v4u vr[8];
    { const unsigned m0 = LIST32v[2 * (lane & 15)]; const int n0 = (int)bend[0] < 8 ? (int)bend[0] : 8;
#pragma unroll
      for (int k = 0; k < 8; ++k) { const unsigned e0_ = (unsigned)__builtin_amdgcn_readlane((int)m0, 0), ek_ = (unsigned)__builtin_amdgcn_readlane((int)m0, k);
          const unsigned ei = (k < n0 ? ek_ : e0_) & 0xFFFFu; vr[k] = *(const v4u*)(V8 + (size_t)ei * DM + 16 * lane); } }
#define PG_RUNR(j, DOLOAD, DOCOMP) { const int rs_ = (int)bstart[g * 8 + j], re_ = (int)bend[g * 8 + j]; const float qs_ = PG_QS(j); \
        for (int pos = rs_; pos < re_; ) { const int nv = re_ - pos < 8 ? re_ - pos : 8; const int np_ = pos + nv; \
            int ne_ = re_; if (np_ >= re_) { int bi_ = g * 8 + j + 1; while (bi_ < 8 * PG_NGRP && (int)bend[bi_] <= np_) ++bi_; ne_ = bi_ < 8 * PG_NGRP ? (int)bend[bi_] : np_; }     \
            const int nn_ = ne_ - np_ < 8 ? ne_ - np_ : 8;                                                   \
            const int ix_ = np_ + (lane & 15) < 1024 ? np_ + (lane & 15) : 1023; const unsigned nmrr = LIST32v[2 * ix_]; const float nmww = WL[ix_]; \
            const int wq_ = ((lane & 15) < nv ? (int)rintf(mww * qs_) : 0) & 255;                            \
            const unsigned ne0_ = (unsigned)__builtin_amdgcn_readlane((int)nmrr, 0); \
            unsigned en_[8]; \
            _Pragma("unroll") for (int k = 0; k < 8; ++k) { const unsigned ek_ = (unsigned)__builtin_amdgcn_readlane((int)nmrr, k); en_[k] = (k < nn_ ? ek_ : ne0_) & 0xFFFFu; } \
            _Pragma("unroll") for (int gq = 0; gq < 2; ++gq) { \
                unsigned t_[4][4]; \
                _Pragma("unroll") for (int q = 0; q < 4; ++q) { const unsigned r0 = vr[4 * gq][q], r1 = vr[4 * gq + 1][q], r2 = vr[4 * gq + 2][q], r3 = vr[4 * gq + 3][q]; \
                    if (!(DOCOMP)) { t_[q][0] = r0; t_[q][1] = r1; t_[q][2] = r2; t_[q][3] = r3; } else \
                    t_[q][0] = __builtin_amdgcn_perm(r1, r0, 0x05010400u); t_[q][1] = __builtin_amdgcn_perm(r1, r0, 0x07030602u); t_[q][2] = __builtin_amdgcn_perm(r3, r2, 0x05010400u); t_[q][3] = __builtin_amdgcn_perm(r3, r2, 0x07030602u); } \
                const int w4_ = __builtin_amdgcn_readlane(wq_, 4 * gq) | (__builtin_amdgcn_readlane(wq_, 4 * gq + 1) << 8) | (__builtin_amdgcn_readlane(wq_, 4 * gq + 2) << 16) | (__builtin_amdgcn_readlane(wq_, 4 * gq + 3) << 24); \
                _Pragma("unroll") for (int q = 0; q < 4; ++q) { \
                    __builtin_amdgcn_sched_barrier(0); \
                    if (DOLOAD) vr[4 * gq + q] = *(const v4u*)(V8 + (size_t)en_[4 * gq + q] * DM + 16 * lane);        \
                    __builtin_amdgcn_sched_barrier(0); \
                    const unsigned t0 = t_[q][0], t1 = t_[q][1], t2 = t_[q][2], t3 = t_[q][3]; \
                    if (!(DOCOMP)) { acc[j][4 * q] ^= (int)(t0 ^ t1 ^ t2 ^ t3); } else { \
                    acc[j][4 * q + 0] = __builtin_amdgcn_sdot4((int)__builtin_amdgcn_perm(t2, t0, 0x05040100u), w4_, acc[j][4 * q + 0], false); \
                    acc[j][4 * q + 1] = __builtin_amdgcn_sdot4((int)__builtin_amdgcn_perm(t2, t0, 0x07060302u), w4_, acc[j][4 * q + 1], false); \
                    acc[j][4 * q + 2] = __builtin_amdgcn_sdot4((int)__builtin_amdgcn_perm(t3, t1, 0x05040100u), w4_, acc[j][4 * q + 2], false); \
                    acc[j][4 * q + 3] = __builtin_amdgcn_sdot4((int)__builtin_amdgcn_perm(t3, t1, 0x07060302u), w4_, acc[j][4 * q + 3], false); } } } \
            mww = nmww; pos = np_; } }
#define PG_RUN(j) PG_RUNR(j, 1, 1)
#else
#define PVB 8
#ifdef PG_VNODUMMY
#define PG_VLOADIF(k) ((k) < nv)
#elif defined(PG_VMASKDUMMY)
#define PG_VLOADIF(k) ((k) < nvv_)
#else
#define PG_VLOADIF(k) true
#endif
#ifdef PG_VTAIL
#define PG_VSKIP(gq) if (4 * (gq) >= nv) continue;
#else
#define PG_VSKIP(gq)
#endif
    unsigned mrr = (unsigned)LIST[lane & 15]; float mww = WL[lane & 15]; int mpos = 0; v4u vr[PVB];
#pragma unroll
    for (int k = 0; k < PVB; ++k) vr[k] = (v4u){0u, 0u, 0u, 0u};
#ifdef PG_VEXEC
#define PG_VISSUE(DOLOAD) \
            const unsigned char* ad_[8]; \
            _Pragma("unroll") for (int k = 0; k < 8; ++k) { const unsigned ek_ = (unsigned)__builtin_amdgcn_readlane((int)mrr, k) & 0xFFFFu; ad_[k] = V8 + (size_t)ek_ * DM + 16 * lane; } \
            const int wq_ = ((lane & 15) < nv ? (int)rintf(mww * qs_) : 0) & 255;                         \
            { const int np_ = pos + nv; const int ix_ = np_ + (lane & 15) < 1024 ? np_ + (lane & 15) : 1023; mrr = (unsigned)LIST[ix_]; mww = WL[ix_]; mpos = np_; } \
            if (DOLOAD) asm volatile("global_load_dwordx4 %0, %9, off\n\t" \
                         "s_cmp_gt_i32 %8, 1\n\ts_cselect_b64 exec, -1, 0\n\tglobal_load_dwordx4 %1, %10, off\n\t" \
                         "s_cmp_gt_i32 %8, 2\n\ts_cselect_b64 exec, -1, 0\n\tglobal_load_dwordx4 %2, %11, off\n\t" \
                         "s_cmp_gt_i32 %8, 3\n\ts_cselect_b64 exec, -1, 0\n\tglobal_load_dwordx4 %3, %12, off\n\t" \
                         "s_cmp_gt_i32 %8, 4\n\ts_cselect_b64 exec, -1, 0\n\tglobal_load_dwordx4 %4, %13, off\n\t" \
                         "s_cmp_gt_i32 %8, 5\n\ts_cselect_b64 exec, -1, 0\n\tglobal_load_dwordx4 %5, %14, off\n\t" \
                         "s_cmp_gt_i32 %8, 6\n\ts_cselect_b64 exec, -1, 0\n\tglobal_load_dwordx4 %6, %15, off\n\t" \
                         "s_cmp_gt_i32 %8, 7\n\ts_cselect_b64 exec, -1, 0\n\tglobal_load_dwordx4 %7, %16, off\n\t" \
                         "s_mov_b64 exec, -1\n\ts_waitcnt vmcnt(0)" \
                : "=&v"(vr[0]), "=&v"(vr[1]), "=&v"(vr[2]), "=&v"(vr[3]), "=&v"(vr[4]), "=&v"(vr[5]), "=&v"(vr[6]), "=&v"(vr[7]) \
                : "s"(nv), "v"(ad_[0]), "v"(ad_[1]), "v"(ad_[2]), "v"(ad_[3]), "v"(ad_[4]), "v"(ad_[5]), "v"(ad_[6]), "v"(ad_[7]) : "memory", "scc");
#else
#define PG_VISSUE(DOLOAD) \
            int nvv_ = nv; asm volatile("" : "+v"(nvv_)); \
            _Pragma("unroll") for (int k = 0; k < PVB; ++k) { const unsigned e0_ = (unsigned)__builtin_amdgcn_readlane((int)mrr, 0), ek_ = (unsigned)__builtin_amdgcn_readlane((int)mrr, k); \
                const unsigned ei = (k < nv ? ek_ : e0_) & 0xFFFFu; if (DOLOAD && PG_VLOADIF(k)) vr[k] = *(const v4u*)(V8 + (size_t)ei * DM + 16 * lane); }     \
            const int wq_ = ((lane & 15) < nv ? (int)rintf(mww * qs_) : 0) & 255;                         \
            { const int np_ = pos + nv; const int ix_ = np_ + (lane & 15) < 1024 ? np_ + (lane & 15) : 1023; mrr = (unsigned)LIST[ix_]; mww = WL[ix_]; mpos = np_; }
#endif
#define PG_RUNX(j, DOLOAD, DOCOMP) { const int rs_ = PG_BS(j), re_ = PG_BE(j); const float qs_ = PG_QSV(j); \
        for (int pos = rs_; pos < re_; ) { const int nv = re_ - pos < PVB ? re_ - pos : PVB; \
            if (mpos != pos) { const int ix_ = pos + (lane & 15) < 1024 ? pos + (lane & 15) : 1023; mrr = (unsigned)LIST[ix_]; mww = WL[ix_]; mpos = pos; } \
            PG_VISSUE(DOLOAD) \
            if (!(DOCOMP)) { _Pragma("unroll") for (int k = 0; k < PVB; ++k) acc[j][k] ^= (int)(vr[k][0] ^ vr[k][1] ^ vr[k][2] ^ vr[k][3]); } else \
            _Pragma("unroll") for (int gq = 0; gq < PVB / 4; ++gq) { PG_VSKIP(gq) \
                const int w4_ = __builtin_amdgcn_readlane(wq_, 4 * gq) | (__builtin_amdgcn_readlane(wq_, 4 * gq + 1) << 8) | (__builtin_amdgcn_readlane(wq_, 4 * gq + 2) << 16) | (__builtin_amdgcn_readlane(wq_, 4 * gq + 3) << 24); \
                _Pragma("unroll") for (int q = 0; q < 4; ++q) { const unsigned r0 = vr[4 * gq][q], r1 = vr[4 * gq + 1][q], r2 = vr[4 * gq + 2][q], r3 = vr[4 * gq + 3][q]; \
                    const unsigned t0 = __builtin_amdgcn_perm(r1, r0, 0x05010400u), t1 = __builtin_amdgcn_perm(r1, r0, 0x07030602u), t2 = __builtin_amdgcn_perm(r3, r2, 0x05010400u), t3 = __builtin_amdgcn_perm(r3, r2, 0x07030602u); \
                    acc[j][4 * q + 0] = __builtin_amdgcn_sdot4((int)__builtin_amdgcn_perm(t2, t0, 0x05040100u), w4_, acc[j][4 * q + 0], false); \
                    acc[j][4 * q + 1] = __builtin_amdgcn_sdot4((int)__builtin_amdgcn_perm(t2, t0, 0x07060302u), w4_, acc[j][4 * q + 1], false); \
                    acc[j][4 * q + 2] = __builtin_amdgcn_sdot4((int)__builtin_amdgcn_perm(t3, t1, 0x05040100u), w4_, acc[j][4 * q + 2], false); \
                    acc[j][4 * q + 3] = __builtin_amdgcn_sdot4((int)__builtin_amdgcn_perm(t3, t1, 0x07060302u), w4_, acc[j][4 * q + 3], false); } } \
            pos += nv; } }
#endif
#if !defined(PG_VROLL) && !defined(PG_VDMA)
#define PG_RUN(j) PG_RUNX(j, 1, 1)
#endif
#ifndef PG_NO_V
#if defined(DUP_PHASE) && defined(PG_VROLL)
    if (F.flags & 32) { for (int g = 0; g < PG_NGRP; ++g) { PG_RUNR(0, 1, 0) PG_RUNR(1, 1, 0) PG_RUNR(2, 1, 0) PG_RUNR(3, 1, 0) PG_RUNR(4, 1, 0) PG_RUNR(5, 1, 0) PG_RUNR(6, 1, 0) PG_RUNR(7, 1, 0) } }
    else if (F.flags & 64) { for (int g = 0; g < PG_NGRP; ++g) { PG_RUNR(0, 0, 1) PG_RUNR(1, 0, 1) PG_RUNR(2, 0, 1) PG_RUNR(3, 0, 1) PG_RUNR(4, 0, 1) PG_RUNR(5, 0, 1) PG_RUNR(6, 0, 1) PG_RUNR(7, 0, 1) } }
    else
#endif
#if defined(DUP_PHASE) && !defined(PG_VROLL) && !defined(PG_VDMA)
    if (F.flags & 32) { for (int g = 0; g < PG_NGRP; ++g) { PG_GROUP_HEAD PG_RUNX(0, 1, 0) PG_RUNX(1, 1, 0) PG_RUNX(2, 1, 0) PG_RUNX(3, 1, 0) PG_RUNX(4, 1, 0) PG_RUNX(5, 1, 0) PG_RUNX(6, 1, 0) PG_RUNX(7, 1, 0) } }
    else if (F.flags & 64) { for (int g = 0; g < PG_NGRP; ++g) { PG_GROUP_HEAD PG_RUNX(0, 0, 1) PG_RUNX(1, 0, 1) PG_RUNX(2, 0, 1) PG_RUNX(3, 0, 1) PG_RUNX(4, 0, 1) PG_RUNX(5, 0, 1) PG_RUNX(6, 0, 1) PG_RUNX(7, 0, 1) } }
    else
#endif
#ifdef DUP_PHASE
    if (!(F.flags & 2))
#endif
    for (int g = 0; g < PG_NGRP; ++g) { PG_GROUP_HEAD PG_RUN(0) PG_RUN(1) PG_RUN(2) PG_RUN(3) PG_RUN(4) PG_RUN(5) PG_RUN(6) PG_RUN(7) }
#endif
#undef PG_RUNX
#undef PG_RUN
#undef PG_ISSUE
#ifdef DUP_PHASE
    if (F.flags & 256) { if (acc[0][0] == 0x12345678) F.out[lane] = 1.f; return; }
#endif
#ifdef VPERM
    { int tb = tok0; asm volatile("" : "+s"(tb));
      f32x4 fgv[4];
#pragma unroll
      for (int q = 0; q < 4; ++q) fgv[q] = *(const f32x4*)(fg + 256 * q + 4 * lane);
      typedef unsigned u32x2e __attribute__((ext_vector_type(2)));
      u32x2e nx[4];
#pragma unroll
      for (int q = 0; q < 4; ++q) nx[q] = P7LD((const u32x2e*)(X1B + (size_t)tb * DM + 256 * q + 4 * lane));
#pragma unroll
      for (int j = 0; j < 8; ++j) { const int t = tb + j; const float os = __uint_as_float(wmax_l[j]) * (1.0f / 127.0f);
        u32x2e xc[4];
#pragma unroll
        for (int q = 0; q < 4; ++q) xc[q] = nx[q];
        if (j + 1 < 8) {
#pragma unroll
            for (int q = 0; q < 4; ++q) nx[q] = P7LD((const u32x2e*)(X1B + (size_t)(t + 1) * DM + 256 * q + 4 * lane)); }
        float s = 0.f; f32x4 y[4];
#pragma unroll
        for (int q = 0; q < 4; ++q) {
            y[q] = (f32x4){__uint_as_float(xc[q][0] << 16) + (float)acc[j][4 * q] * os, __uint_as_float(xc[q][0] & 0xFFFF0000u) + (float)acc[j][4 * q + 1] * os,
                           __uint_as_float(xc[q][1] << 16) + (float)acc[j][4 * q + 2] * os, __uint_as_float(xc[q][1] & 0xFFFF0000u) + (float)acc[j][4 * q + 3] * os};
            s += (y[q][0] * y[q][0] + y[q][1] * y[q][1]) + (y[q][2] * y[q][2] + y[q][3] * y[q][3]); }
        const float rs = 1.0f / sqrtf(wave_sum(s) * (1.0f / 1024.0f) + NORM_EPS);
#pragma unroll
        for (int q = 0; q < 4; ++q) *(f32x4*)(F.out + (size_t)t * DM + 256 * q + 4 * lane) = y[q] * rs * fgv[q];
        asm volatile("" ::: "memory"); } }
    return;
#endif
    int tb = tok0; asm volatile("" : "+s"(tb));
    f32x4 fgv[4];
    { const f32x4* gp = (const f32x4*)(fg + 16 * lane);
#pragma unroll
      for (int q = 0; q < 4; ++q) fgv[q] = gp[q]; }
#ifdef EPI7_PRELOAD
    bf16x8 xa_[8], xb_[8];
#pragma unroll
    for (int j = 0; j < 8; ++j) { const bf16x8* xp = (const bf16x8*)(X1B + (size_t)(tb + j) * DM + 16 * lane); xa_[j] = xp[0]; xb_[j] = xp[1]; }
    __builtin_amdgcn_sched_barrier(0);
#pragma unroll
    for (int j = 0; j < 8; ++j) { const int t = tb + j;
        const bf16x8 xa = xa_[j], xb = xb_[j]; const float os = __uint_as_float(wmax_l[j]) * (1.0f / 127.0f);
        float s = 0.f; f32x4 y[4];
#pragma unroll
        for (int q = 0; q < 4; ++q) { const bf16x8 xs = q < 2 ? xa : xb; const int o = 4 * (q & 1);
            y[q] = (f32x4){bf2f((unsigned short)xs[o]) + (float)acc[j][4 * q] * os, bf2f((unsigned short)xs[o + 1]) + (float)acc[j][4 * q + 1] * os, bf2f((unsigned short)xs[o + 2]) + (float)acc[j][4 * q + 2] * os, bf2f((unsigned short)xs[o + 3]) + (float)acc[j][4 * q + 3] * os};
            s += (y[q][0] * y[q][0] + y[q][1] * y[q][1]) + (y[q][2] * y[q][2] + y[q][3] * y[q][3]); }
        const float rs = __builtin_amdgcn_rsqf(wave_sum(s) * (1.0f / 1024.0f) + NORM_EPS);
        f32x4* op = (f32x4*)(F.out + (size_t)t * DM + 16 * lane);
#pragma unroll
        for (int q = 0; q < 4; ++q) op[q] = y[q] * rs * fgv[q]; }
#else
    bf16x8 nxa, nxb;
    { const bf16x8* xp = (const bf16x8*)(X1B + (size_t)tb * DM + 16 * lane); nxa = xp[0]; nxb = xp[1]; }
#pragma unroll
    for (int j = 0; j < 8; ++j) { const int t = tb + j;
        const bf16x8 xa = nxa, xb = nxb; const float os = __uint_as_float(wmax_l[j]) * (1.0f / 127.0f);
        if (j + 1 < 8) { const bf16x8* xp = (const bf16x8*)(X1B + (size_t)(t + 1) * DM + 16 * lane); nxa = xp[0]; nxb = xp[1]; }
        float s = 0.f; f32x4 y[4];
#pragma unroll
        for (int q = 0; q < 4; ++q) { const bf16x8 xs = q < 2 ? xa : xb; const int o = 4 * (q & 1);
            y[q] = (f32x4){bf2f((unsigned short)xs[o]) + (float)acc[j][4 * q] * os, bf2f((unsigned short)xs[o + 1]) + (float)acc[j][4 * q + 1] * os, bf2f((unsigned short)xs[o + 2]) + (float)acc[j][4 * q + 2] * os, bf2f((unsigned short)xs[o + 3]) + (float)acc[j][4 * q + 3] * os};
            s += (y[q][0] * y[q][0] + y[q][1] * y[q][1]) + (y[q][2] * y[q][2] + y[q][3] * y[q][3]); }
        const float rs = 1.0f / sqrtf(wave_sum(s) * (1.0f / 1024.0f) + NORM_EPS);
        f32x4* op = (f32x4*)(F.out + (size_t)t * DM + 16 * lane);
#pragma unroll
#ifdef OUT_NT
        for (int q = 0; q < 4; ++q) __builtin_nontemporal_store(y[q] * rs * fgv[q], op + q);
#else
        for (int q = 0; q < 4; ++q) op[q] = y[q] * rs * fgv[q];
#endif
        asm volatile("" ::: "memory"); }
#endif
}
}


#ifndef MK_N_LAUNCHES
#define MK_N_LAUNCHES 1
#endif
constexpr int N_PHASES = 8;
#ifndef PG8_ALIGN
#define PG8_ALIGN true
#endif
#ifndef CVT_P1_QUOTA
#define CVT_P1_QUOTA 2
#endif
struct Args { const float* in[20]; float* out; unsigned char* ws; int ph_lo, ph_hi, flags; };

__global__ void __launch_bounds__(NTHR, 2) mega_fwd(Args args) {
    extern __shared__ __attribute__((aligned(16))) unsigned char lds_raw[];
    Frame F;
    F.lds = (LAS unsigned char*)lds_raw; F.ldsg = lds_raw;
    F.MISC = (volatile LAS unsigned*)(F.lds + MISC_OFF);
    F.tid = threadIdx.x; F.lane = F.tid & 63; F.wave = __builtin_amdgcn_readfirstlane(F.tid >> 6);
    F.G = gridDim.x; { const int bx = blockIdx.x; F.vcu = (F.G % 8 == 0) ? (bx % 8) * (F.G / 8) + bx / 8 : bx; }
#pragma unroll
    for (int i = 0; i < 20; ++i) F.in[i] = args.in[i];
    F.out = args.out; F.ws = args.ws; F.ctl = (gu32*)(args.ws + WS_CTL); F.flags = args.flags;
    for (int u = F.tid; u < 512 / 4; u += NTHR) ((LAS unsigned*)(F.lds + MISC_OFF))[u] = 0u;
    __syncthreads();
    const int lo = args.ph_lo, hi = args.ph_hi;
    const bool one = (hi - lo) > 1;
    XcdBarrier bar; bar.bar = (unsigned*)(F.ctl + CW_BAR); bar.x = 0; bar.st = nullptr;
    if (one) bar = xcd_barrier_post((unsigned*)(F.ctl + CW_BAR), F.MISC + 8);
#ifndef PH_MASK
#define PH_MASK 0xFF
#endif
#define IN(k) ((((PH_MASK) >> (k)) & 1) && lo <= (k) && (k) < hi)
#define SEAM(k) do { if (IN(k) && IN((k) + 1)) xcd_barrier(bar); } while (0)
#ifndef REP_PHASE
#define REP_PHASE -1
#endif
#define REPS(k) for (int rep_ = 0; rep_ < ((k) == REP_PHASE ? 2 : 1); ++rep_, ((k) == REP_PHASE && rep_ == 1 ? xcd_barrier(bar) : (void)0))

    if (IN(0)) REPS(0) { p0_prologue(F); } SEAM(0);

    if (IN(1)) REPS(1) {
        pg8::Gemm g{WSP(bf16, WS_H1), WSP(bf16, WS_WIN), M, NPROJ, DM}; pg8::StaticOrder S; S.init(M, NPROJ, F.G, (int)blockIdx.x);
        pg8::EpiBf16S E{WSP(bf16, WS_PROJ), PW, PW, PROJ_STRIDE, QSCALE, nullptr, 0.f};
        pg8::gemm_phase<pg8::EpiBf16S, pg8::StaticOrder, PG8_ALIGN, true>(F.lds, g, S, E);
        const int sb = (int)blockIdx.x - (F.G - 16);
        if (sb >= 0 && sb < 16 && F.wave == 0) gate_scan(F, sb);
        if ((int)blockIdx.x >= F.G / 2) cvt_peer_tables(F, CVT_P1_QUOTA);
    } SEAM(1);

    if (IN(2)) REPS(2) {
        const float lam = __expf(wave_sum(F.in[7][F.lane] * F.in[8][F.lane])) - __expf(wave_sum(F.in[9][F.lane] * F.in[10][F.lane])) + LAM_INIT;
#ifdef DATT_QUEUE
        for (;;) {
            if (F.tid == 0) F.MISC[16] = __hip_atomic_fetch_add(F.ctl + CW_Q, 1u, __ATOMIC_RELAXED, __HIP_MEMORY_SCOPE_AGENT);
            __syncthreads();
            const int it = (int)F.MISC[16];
            __syncthreads();
            if (it >= 512 + 240) break;
            int tid_ = F.tid; asm volatile("" : "+v"(tid_)); F.tid = tid_; F.lane = tid_ & 63;
            if (it < 512) { const int qb = 31 - (it >> 4), bh = it & 15; att::dattn_unit(F, bh >> 2, bh & 3, qb, lam); }
            else { const int v = it - 512; att::mlstm_state_item(F, v / 15, v % 15); }
        }
#else
#ifdef DUP_PHASE
        if (!(F.flags & 1))
#endif
        { const int v = F.vcu; if (v < 256) { const int bh = v >> 4, s = v & 15;
            att::dattn_unit(F, bh >> 2, bh & 3, 31 - s, lam); att::dattn_unit(F, bh >> 2, bh & 3, s, lam); } }
#ifdef DUP_PHASE
        if (!(F.flags & 2))
#endif
        { const int v = F.vcu; if (v < 16 * 15) att::mlstm_state_item(F, v / 15, v % 15); }
#ifdef CVT_IN_P2
        if (F.vcu >= 16 * 15) { __syncthreads(); cvt_peer_tables(F, CVT_IN_P2); }
#endif
#endif
    } SEAM(2);

    if (IN(3)) REPS(3) {
#ifdef DUP_PHASE
        if (!(F.flags & 32))
#endif
        { const int v = F.vcu; if (v < 256) att::mlstm_out_unit(F, v >> 4, v & 15); }
#ifdef DUP_PHASE
        if (!(F.flags & 16))
#endif
        {
        cvt_small_weights(F, F.vcu, F.G);
#ifndef FEWER_SYNCS
        __syncthreads();
#endif
#ifndef CVT_P3_QUOTA
#define CVT_P3_QUOTA (1 << 20)
#endif
        cvt_peer_tables(F, CVT_P3_QUOTA);
        }
    } SEAM(3);

    if (IN(4)) REPS(4) {
        pg8::Gemm g{WSP(bf16, WS_H1), WSP(bf16, WS_WOUT), M, DM, DM}; pg8::StaticOrder S; S.init(M, DM, F.G, (int)blockIdx.x);
#ifdef EPI_RESID_P
        pg8::EpiResidP E{F.in[0], nullptr, WSP(bf16, WS_X1B), WSP(float, WS_SSP), DM};
        pg8::gemm_phase<pg8::EpiResidP, pg8::StaticOrder, PG8_ALIGN, true>(F.lds, g, S, E);
#else
        pg8::EpiResid E{F.in[0], nullptr, WSP(bf16, WS_X1B), WSP(float, WS_SSP), DM};
        pg8::gemm_phase<pg8::EpiResid, pg8::StaticOrder, PG8_ALIGN, true>(F.lds, g, S, E);
#endif
    } SEAM(4);

    if (IN(5)) REPS(5) {
        pg8::Gemm g{WSP(bf16, WS_X1B), WSP(bf16, WS_WPQ), M, 2048, DM}; pg8::StaticOrder S; S.init(M, 2048, F.G, (int)blockIdx.x);
        pg8::EpiBf16S E{WSP(bf16, WS_H1), DM, DM, (size_t)(WS_QPB - WS_H1) / 2, 1.0f, WSP(float, WS_SSP), NORM_EPS};
        pg8::gemm_phase<pg8::EpiBf16S, pg8::StaticOrder, PG8_ALIGN, true>(F.lds, g, S, E);
#ifdef TOPK_IN_P5
        asm volatile("s_waitcnt vmcnt(0)" ::: "memory"); __builtin_amdgcn_fence(__ATOMIC_ACQUIRE, "agent"); asm volatile("s_waitcnt vmcnt(0)" ::: "memory");
        __syncthreads();
        { pg8::Unit u; for (int i = 0; S.next(i, u); ++i) peer::peer_topk_tile(F, u.pm, u.pn); }
#endif
    }
#ifndef TOPK_IN_P5
    SEAM(5);
#endif

    if (IN(6)) REPS(6) {
#ifndef TOPK_IN_P5
        peer::peer_topk_phase(F);
#endif
#ifdef CVT_IN_P6
        __syncthreads(); cvt_peer_tables(F, 1 << 20);
#endif
    } SEAM(6);
#ifdef EXTRA_BAR
    SEAM(6); SEAM(6);
#endif

    if (IN(7)) REPS(7) { peer::peer_gather_phase(F); }
#undef IN
#undef SEAM
}

#if defined(MK_CHECK)
#ifdef VPERM
#define VPOS(dd) (16 * (((dd) >> 2) & 63) + 4 * ((dd) >> 8) + ((dd) & 3))
#else
#define VPOS(dd) (dd)
#endif
__device__ __forceinline__ unsigned hsh(unsigned x) { x ^= x >> 16; x *= 0x7feb352dU; x ^= x >> 15; x *= 0x846ca68bU; x ^= x >> 16; return x; }
__device__ __forceinline__ void chk(unsigned* err, unsigned bit, float a, float ref, float rel, float ab) { if (!(fabsf(a - ref) <= ab + rel * fabsf(ref))) atomicOr(err, bit); }
#define CWS(T, off) ((T*)(a.ws + (off)))
#define CERR ((unsigned*)(a.ws) + CW_ERR)
__device__ __forceinline__ float blk_sum(float v, float* red, int n) { __syncthreads(); red[threadIdx.x] = v; __syncthreads(); for (int s = n / 2; s > 0; s >>= 1) { if ((int)threadIdx.x < s) red[threadIdx.x] += red[threadIdx.x + s]; __syncthreads(); } return red[0]; }
__device__ __forceinline__ float blk_max(float v, float* red, int n) { __syncthreads(); red[threadIdx.x] = v; __syncthreads(); for (int s = n / 2; s > 0; s >>= 1) { if ((int)threadIdx.x < s) red[threadIdx.x] = fmaxf(red[threadIdx.x], red[threadIdx.x + s]); __syncthreads(); } return red[0]; }

__device__ __forceinline__ float fp8dec(unsigned char b) { const int ex = (b >> 3) & 15, mn = b & 7; const float v = ex ? (1.0f + mn * 0.125f) * exp2f((float)(ex - 7)) : mn * 0.001953125f; return (b & 0x80) ? -v : v; }
__global__ void chk_p0(Args a) {
    __shared__ float hs[1024]; __shared__ float red[256];
    const unsigned sm = hsh(blockIdx.x * 256u + threadIdx.x + 77u);
    if (a.ph_lo == 1) {
        { const int n = sm % 1024, k = (sm >> 12) % 1024; chk(CERR, 0x100u, bf2f(CWS(bf16, WS_WOUT)[(size_t)n * 1024 + k]), a.in[13][(size_t)k * 1024 + n], 0.01f, 1e-4f); }
        { const int n = sm % 2048, k = (sm >> 12) % 1024; chk(CERR, 0x100u, bf2f(CWS(bf16, WS_WPQ)[(size_t)n * 1024 + k]), a.in[15][(size_t)k * 2048 + n] * a.in[14][k], 0.01f, 1e-4f); }
        { const int i = sm % 262144; chk(CERR, 0x100u, bf2f(CWS(bf16, WS_SUBK)[i]), a.in[16][i], 0.01f, 1e-4f); }
        { const size_t i = (size_t)(sm % 16777216u);
#ifdef PG_U4
            { const float su_ = CWS(float, WS_SU)[i >> 10]; const int k = (int)(i & 1023); const float q = ((float)((CWS(unsigned, WS_UB)[(i >> 10) * 128 + (k >> 3)] >> (8 * (k & 3) + 4 * ((k >> 2) & 1))) & 15u) - 7.5f) * su_;
              float ref = a.in[17][i] * a.in[14][k]; ref = fminf(fmaxf(ref, -7.5f * su_), 7.5f * su_); chk(CERR, 0x100u, q, ref, 0.f, 0.51f * su_ + 1e-7f); }
#else
            { const float su_ = CWS(float, WS_SU)[i >> 10]; chk(CERR, 0x100u, (float)(signed char)CWS(unsigned char, WS_UB)[i] * su_, a.in[17][i] * a.in[14][i & 1023], 0.f, 0.51f * su_ + 1e-7f); }
#endif
             { const float sv_ = CWS(float, WS_SU)[NEXP + (i >> 10)]; chk(CERR, 0x100u, (float)(signed char)CWS(unsigned char, WS_VB)[(i & ~(size_t)1023) + VPOS((int)(i & 1023))] * sv_, a.in[18][i], 0.f, 0.51f * sv_ + 1e-7f); } }
        return; }
    const int m = hsh(blockIdx.x * 7919u + 1u) % M; const float* x = a.in[0] + (size_t)m * DM; const float* g1 = a.in[1];
    float s = 0.f; for (int e = threadIdx.x; e < 1024; e += 256) s += x[e] * x[e];
    const float rstd = 1.0f / sqrtf(blk_sum(s, red, 256) / 1024.f + NORM_EPS);
    for (int e = threadIdx.x; e < 1024; e += 256) { hs[e] = x[e] * rstd * g1[e]; chk(CERR, 0x200u, bf2f(CWS(bf16, WS_H1)[(size_t)m * DM + e]), hs[e], 0.01f, 0.01f); }
    __syncthreads();
    if (threadIdx.x < 8) { const int g = threadIdx.x; float d = 0.f; for (int k = 0; k < 1024; ++k) d += hs[k] * a.in[2][(size_t)k * INCOLS + NPROJ + g];
        const int b = m / SEQ, t = m % SEQ, hh = g & 3; const size_t o = (size_t)(b * 4 + hh) * SEQ + t;
        if (g < 4) chk(CERR, 0x200u, CWS(float, WS_GI)[o], d + a.in[5][hh], 1e-3f, 2e-3f);
        else { const float f = d + a.in[6][hh]; chk(CERR, 0x200u, CWS(float, WS_GLF)[o], -log1pf(expf(-f)), 1e-3f, 2e-3f); } }
    { const int n = sm % NPROJ, k = (sm >> 12) % 1024; chk(CERR, 0x100u, bf2f(CWS(bf16, WS_WIN)[(size_t)n * 1024 + k]), a.in[2][(size_t)k * INCOLS + n], 0.01f, 1e-4f); }
}
__global__ void chk_gemm1(Args a) {
    const unsigned gid = blockIdx.x * 256u + threadIdx.x; const unsigned sm = hsh(gid + 1234567u);
    { const int t = sm % M, n = (sm >> 14) % NPROJ; const bf16* hr = CWS(bf16, WS_H1) + (size_t)t * DM; const bf16* wr = CWS(bf16, WS_WIN) + (size_t)n * DM;
      float d = 0.f; for (int k = 0; k < 1024; ++k) d += bf2f(hr[k]) * bf2f(wr[k]);
      const int bi = n / 512, col = n % 512; if (bi == 0) d *= QSCALE;
      chk(CERR, 0x80u, bf2f(CWS(bf16, WS_PROJ)[(size_t)bi * PROJ_STRIDE + (size_t)t * PW + col]), d, 0.02f, 0.02f); }
    if (gid < 256) { const int bh = sm % 16, t = (gid < 16) ? (int)(4095 - gid * 17) : (int)((sm >> 4) % SEQ); const float* gi = CWS(float, WS_GI) + (size_t)bh * SEQ; const float* glf = CWS(float, WS_GLF) + (size_t)bh * SEQ;
      float B = 0.f, Mx = -3.0e38f, av = 0.f; for (int s = 0; s <= t; ++s) { B += glf[s]; av = gi[s] - B; Mx = fmaxf(Mx, av); }
      chk(CERR, 0x40u, CWS(float, WS_A2)[(size_t)bh * SEQ + t], av * LOG2E, 1e-4f, 5e-3f); chk(CERR, 0x40u, CWS(float, WS_M2)[(size_t)bh * SEQ + t], Mx * LOG2E, 1e-4f, 5e-3f);
      chk(CERR, 0x40u, CWS(float, WS_NB2)[(size_t)bh * SEQ + t], -(B + Mx) * LOG2E, 1e-4f, 5e-3f); }
}
__global__ void __launch_bounds__(128) chk_attn(Args a) {
    __shared__ float sc[2][4096]; __shared__ float red[128]; __shared__ float qv[128];
    const unsigned sm = hsh(blockIdx.x * 31u + 5u); const int b = sm & 3, h = (sm >> 2) & 3, t = (blockIdx.x < 4) ? (int)(4095 - blockIdx.x * 129) : (int)((sm >> 4) % SEQ), d = threadIdx.x;
    const bf16* DAQ = CWS(bf16, WS_PROJ); const bf16* DAK = DAQ + PROJ_STRIDE; const bf16* DAV = DAQ + 2 * PROJ_STRIDE;
    qv[d] = bf2f(DAQ[((size_t)b * SEQ + t) * PW + h * 128 + d]); __syncthreads();
    const float slope2 = exp2f(-2.0f * (h + 1)) * LOG2E;
    float mx0 = -3.0e38f, mx1 = -3.0e38f;
    for (int s = d; s <= t; s += 128) { const bf16* kr = DAK + ((size_t)b * SEQ + s) * PW + h * 128; float d0 = 0.f, d1 = 0.f;
        for (int k = 0; k < 64; ++k) { d0 += qv[k] * bf2f(kr[k]); d1 += qv[64 + k] * bf2f(kr[64 + k]); }
        d0 -= slope2 * (t - s); d1 -= slope2 * (t - s); sc[0][s] = d0; sc[1][s] = d1; mx0 = fmaxf(mx0, d0); mx1 = fmaxf(mx1, d1); }
    mx0 = blk_max(mx0, red, 128); mx1 = blk_max(mx1, red, 128);
    float l0 = 0.f, l1 = 0.f; for (int s = d; s <= t; s += 128) { l0 += exp2f(sc[0][s] - mx0); l1 += exp2f(sc[1][s] - mx1); }
    l0 = blk_sum(l0, red, 128); l1 = blk_sum(l1, red, 128);
    float la = 0.f, lb = 0.f; for (int k = 0; k < 64; ++k) { la += a.in[7][k] * a.in[8][k]; lb += a.in[9][k] * a.in[10][k]; }
    const float lam = expf(la) - expf(lb) + LAM_INIT;
    float o = 0.f; for (int s = 0; s <= t; ++s) o += (exp2f(sc[0][s] - mx0) / l0 - lam * exp2f(sc[1][s] - mx1) / l1) * bf2f(DAV[((size_t)b * SEQ + s) * PW + h * 128 + d]);
    const float ms = blk_sum(o * o, red, 128) / 128.f;
    const float ref = o / sqrtf(ms + SUBLN_EPS) * a.in[11][d] * (1.0f - LAM_INIT);
    chk(CERR, 0x20u, bf2f(CWS(bf16, WS_H1)[((size_t)b * SEQ + t) * DM + h * 128 + d]), ref, 0.03f, 0.03f);
}
__device__ __forceinline__ float conv1(const bf16* raw, size_t rb, int t, int col, const float* cw, const float* cb, int ch) {
    float y = cb[ch]; for (int j = 0; j < 4; ++j) { const int tt = t - 3 + j; if (tt >= 0) y += cw[j * 1024 + ch] * bf2f(raw[(rb + tt) * PW + col]); } return y / (1.0f + expf(-y)); }
__global__ void __launch_bounds__(128) chk_mlstm(Args a) {
    __shared__ float sc[4096]; __shared__ float red[128]; __shared__ float qs[128];
    const unsigned sm = hsh(blockIdx.x * 131u + 9u); const int bh = sm & 15, b = bh >> 2, hh = bh & 3, d = threadIdx.x;
    const int t = (blockIdx.x < 8) ? (int)(blockIdx.x * 37) : (blockIdx.x < 16) ? (int)(4095 - (blockIdx.x - 8) * 300) : (int)((sm >> 4) % SEQ);
    const bf16* MLQ = CWS(bf16, WS_PROJ) + 3 * PROJ_STRIDE; const bf16* MLK = MLQ + PROJ_STRIDE; const bf16* MLV = MLQ + 2 * PROJ_STRIDE; const bf16* MLO = MLQ + 3 * PROJ_STRIDE;
    const size_t rb = (size_t)b * SEQ; const float* A2 = CWS(float, WS_A2) + (size_t)bh * SEQ; const float m2t = CWS(float, WS_M2)[(size_t)bh * SEQ + t], nb2t = CWS(float, WS_NB2)[(size_t)bh * SEQ + t];
    qs[d] = conv1(MLQ, rb, t, hh * 128 + d, a.in[3], a.in[4], hh * 128 + d); __syncthreads();
    float dp = 0.f;
    for (int s = d; s <= t; s += 128) { float dot = 0.f; for (int k = 0; k < 128; ++k) dot += qs[k] * conv1(MLK, rb, s, hh * 128 + k, a.in[3], a.in[4], 512 + hh * 128 + k);
        const float w = dot * MLK_SCALE * exp2f(A2[s] - m2t); sc[s] = w; dp += w; }
    const float den = blk_sum(dp, red, 128);
    float num = 0.f; for (int s = 0; s <= t; ++s) num += sc[s] * bf2f(MLV[(rb + s) * PW + hh * 128 + d]);
    const float hv = num / fmaxf(fabsf(den), exp2f(nb2t));
    const float ms = blk_sum(hv * hv, red, 128) / 128.f;
    const float og = bf2f(MLO[(rb + t) * PW + hh * 128 + d]);
    const float ref = hv / sqrtf(ms + NORM_EPS) * a.in[12][hh * 128 + d] / (1.0f + expf(-og));
    chk(CERR, 0x10u, bf2f(CWS(bf16, WS_H1)[(rb + t) * DM + 512 + hh * 128 + d]), ref, 0.03f, 0.03f);
}
__global__ void chk_gemm2(Args a) {
    const unsigned gid = blockIdx.x * 256u + threadIdx.x; const unsigned sm = hsh(gid + 99u);
    const int t = sm % M, n = (sm >> 14) % 1024; const bf16* ar = CWS(bf16, WS_H1) + (size_t)t * DM; const bf16* wr = CWS(bf16, WS_WOUT) + (size_t)n * DM;
    float d = a.in[0][(size_t)t * DM + n]; for (int k = 0; k < 1024; ++k) d += bf2f(ar[k]) * bf2f(wr[k]);
    chk(CERR, 0x8u, bf2f(CWS(bf16, WS_X1B)[(size_t)t * DM + n]), d, 0.015f, 0.015f);
    if (gid < 64) { float s = 0.f, p = 0.f; for (int k = 0; k < 1024; ++k) { const float v = bf2f(CWS(bf16, WS_X1B)[(size_t)t * DM + k]); s += v * v; } for (int k = 0; k < 16; ++k) p += CWS(float, WS_SSP)[(size_t)t * 16 + k];
        chk(CERR, 0x8u, p, s, 5e-3f, 1e-3f); }
}
__global__ void chk_gemm3(Args a) {
    const unsigned gid = blockIdx.x * 256u + threadIdx.x; const unsigned sm = hsh(gid + 4242u);
    const int t = sm % M, n = (sm >> 14) % 2048; const bf16* ar = CWS(bf16, WS_X1B) + (size_t)t * DM; const bf16* wr = CWS(bf16, WS_WPQ) + (size_t)n * DM;
    float p = 0.f; for (int k = 0; k < 16; ++k) p += CWS(float, WS_SSP)[(size_t)t * 16 + k];
    float d = 0.f; for (int k = 0; k < 1024; ++k) d += bf2f(ar[k]) * bf2f(wr[k]); d /= sqrtf(p / 1024.f + NORM_EPS);
    const bf16* qp = (n < 1024) ? CWS(bf16, WS_H1) + (size_t)t * DM + n : CWS(bf16, WS_QPB) + (size_t)t * DM + (n - 1024);
    chk(CERR, 0x4u, bf2f(*qp), d, 0.02f, 0.02f);
}
__global__ void chk_topk(Args a) {
    __shared__ float s12[256]; __shared__ float cand[256]; __shared__ int i12[32]; __shared__ float v12[32]; __shared__ int pe[16]; __shared__ float pg[16];
    const unsigned sm = hsh(blockIdx.x * 17u + 3u); const int t = sm % M, h = (sm >> 14) & 7, tid = threadIdx.x, c = tid >> 7, n = tid & 127;
    const bf16* q = ((h < 4) ? CWS(bf16, WS_H1) + h * 256 : CWS(bf16, WS_QPB) + (h - 4) * 256) + (size_t)t * DM + c * 128; const bf16* sk = CWS(bf16, WS_SUBK) + ((size_t)(h * 2 + c) * 128 + n) * 128;
    float d = 0.f; for (int k = 0; k < 128; ++k) d += bf2f(q[k]) * bf2f(sk[k]); s12[tid] = d; __syncthreads();
    if (tid < 2) { for (int k = 0; k < 16; ++k) { int bi = 0; float bv = -3.0e38f; for (int j = 0; j < 128; ++j) if (s12[tid * 128 + j] > bv) { bv = s12[tid * 128 + j]; bi = j; } i12[tid * 16 + k] = bi; v12[tid * 16 + k] = bv; s12[tid * 128 + bi] = -3.0e38f; } }
    __syncthreads(); cand[tid] = v12[tid >> 4] + v12[16 + (tid & 15)]; __syncthreads();
    if (tid == 0) { float mx = 0.f, es = 0.f; for (int k = 0; k < 16; ++k) { int bi = 0; float bv = -3.0e38f; for (int j = 0; j < 256; ++j) if (cand[j] > bv) { bv = cand[j]; bi = j; }
            pe[k] = i12[bi >> 4] * 128 + i12[16 + (bi & 15)]; if (k == 0) mx = bv; pg[k] = expf(bv - mx); es += pg[k]; cand[bi] = -3.0e38f; }
        const unsigned long long* P = CWS(unsigned long long, WS_PE) + (size_t)t * 128 + h * 16; int miss = 0;
        for (int k = 0; k < 16; ++k) { bool f = false; for (int j = 0; j < 16; ++j) if ((int)(unsigned)(P[j] & 0xFFFFFFFFull) == pe[k]) { f = true; const float g = __uint_as_float((unsigned)(P[j] >> 32)); if (!(fabsf(g - pg[k] / es) <= 0.003f + 0.03f * pg[k] / es)) miss += 4; } if (!f) ++miss; }
        if (miss > 2) atomicOr(CERR, 0x2u); }
}
__global__ void chk_gather(Args a) {
    __shared__ float wv[128]; __shared__ int ev[128]; __shared__ float red[256];
    const int t = hsh(blockIdx.x * 13u + 11u) % M, tid = threadIdx.x; const bf16* x1 = CWS(bf16, WS_X1B) + (size_t)t * DM;
    float p = 0.f; for (int k = 0; k < 16; ++k) p += CWS(float, WS_SSP)[(size_t)t * 16 + k]; const float rstd = 1.0f / sqrtf(p / 1024.f + NORM_EPS);
    if (tid < 128) { const unsigned long long e = CWS(unsigned long long, WS_PE)[(size_t)t * 128 + tid]; const int ei = (int)(unsigned)(e & 0xFFFFFFFFull);
#ifdef PG_U4
        const unsigned* u4 = CWS(unsigned, WS_UB) + (size_t)ei * (DM / 8);
        float d = 0.f; for (int k = 0; k < 1024; ++k) d += ((float)((u4[k >> 3] >> (8 * (k & 3) + 4 * ((k >> 2) & 1))) & 15u) - 7.5f) * bf2f(x1[k]); d *= rstd
#else
        const unsigned char* u = CWS(unsigned char, WS_UB) + (size_t)ei * DM;
        float d = 0.f; for (int k = 0; k < 1024; ++k) d += (float)(signed char)u[k] * bf2f(x1[k]); d *= rstd
#endif
         * CWS(float, WS_SU)[ei]; ev[tid] = ei; wv[tid] = __uint_as_float((unsigned)(e >> 32)) * 0.5f * d * (1.0f + erff(d * 0.70710678f)); }
    __syncthreads();
    float y[4], s = 0.f; for (int i = 0; i < 4; ++i) { const int dd = tid * 4 + i; float acc = bf2f(x1[dd]); for (int k = 0; k < 128; ++k) acc += wv[k] * CWS(float, WS_SU)[NEXP + ev[k]] * (float)(signed char)CWS(unsigned char, WS_VB)[(size_t)ev[k] * DM + VPOS(dd)]; y[i] = acc; s += acc * acc; }
    const float rs = 1.0f / sqrtf(blk_sum(s, red, 256) / 1024.f + NORM_EPS);
    for (int i = 0; i < 4; ++i) { const int dd = tid * 4 + i; chk(CERR, 0x1u, a.out[(size_t)t * DM + dd], y[i] * rs * a.in[19][dd], 0.03f, 0.03f); }
}
__global__ void chk_poison(Args a) { const unsigned e = *CERR; if (e) { const float f = 1.0f + 10.0f * (float)e; for (size_t i = blockIdx.x * 256u + threadIdx.x; i < (size_t)M * DM; i += (size_t)gridDim.x * 256u) a.out[i] *= f; } }
#endif

extern "C" void kernel_launch(void* const* d_in, const int* in_sizes, int n_in, void* d_out, int out_size, void* d_ws, size_t ws_size, hipStream_t stream) {
    static int grid = 0;
    if (grid == 0) {
        if (n_in != 20 || in_sizes[0] != M * DM || out_size != M * DM || ws_size < WS_END) { fprintf(stderr, "kernel_launch: unexpected shapes (n_in %d, in0 %d, out %d, ws %zu); nothing launched\n", n_in, n_in > 0 ? in_sizes[0] : -1, out_size, ws_size); grid = -1; return; }
        int dev = 0, cus = 0, per_cu = 0;
        if (hipGetDevice(&dev) != hipSuccess || hipDeviceGetAttribute(&cus, hipDeviceAttributeMultiprocessorCount, dev) != hipSuccess) { grid = -1; return; }
        if (hipFuncSetAttribute((const void*)mega_fwd, hipFuncAttributeMaxDynamicSharedMemorySize, LDS_BYTES) != hipSuccess) { fprintf(stderr, "kernel_launch: hipFuncSetAttribute failed\n"); grid = -1; return; }
        if (hipOccupancyMaxActiveBlocksPerMultiprocessor(&per_cu, (const void*)mega_fwd, NTHR, LDS_BYTES) != hipSuccess || per_cu < 1) fprintf(stderr, "kernel_launch: occupancy query reports %d\n", per_cu);
        (void)hipGetLastError();
        grid = 256;
        if (cus < 256) { fprintf(stderr, "kernel_launch: %d CUs, need 256\n", cus); grid = -1; return; }
    }
    if (grid < 0) return;
    (void)hipMemsetAsync((char*)d_ws + WS_CTL, 0, CTL_ZERO_BYTES, stream);
    Args a{};
    for (int i = 0; i < 20; ++i) a.in[i] = (const float*)d_in[i];
    a.out = (float*)d_out; a.ws = (unsigned char*)d_ws;
#if MK_N_LAUNCHES == 1
    a.ph_lo = 0; a.ph_hi = N_PHASES;
    hipLaunchKernelGGL(mega_fwd, dim3(grid), dim3(NTHR), LDS_BYTES, stream, a);
#else
    for (int p = 0; p < N_PHASES; ++p) { a.ph_lo = p; a.ph_hi = p + 1;
#if defined(DUP_PHASE)
#ifndef DUP_FLAGS
#define DUP_FLAGS 0
#endif
        if (p == DUP_PHASE) { a.flags = DUP_FLAGS; hipLaunchKernelGGL(mega_fwd, dim3(grid), dim3(NTHR), LDS_BYTES, stream, a); a.flags = 0; }
#endif
        hipLaunchKernelGGL(mega_fwd, dim3(grid), dim3(NTHR), LDS_BYTES, stream, a);
#if defined(MK_CHECK)
        a.ph_lo = 0; a.ph_hi = 0;
        if (p == 0) hipLaunchKernelGGL(chk_p0, dim3(256), dim3(256), 0, stream, a);
        if (p == 3) { a.ph_lo = 1; hipLaunchKernelGGL(chk_p0, dim3(256), dim3(256), 0, stream, a); a.ph_lo = 0; }
        if (p == 1) hipLaunchKernelGGL(chk_gemm1, dim3(16), dim3(256), 0, stream, a);
        if (p == 3) { hipLaunchKernelGGL(chk_attn, dim3(64), dim3(128), 0, stream, a); hipLaunchKernelGGL(chk_mlstm, dim3(64), dim3(128), 0, stream, a); }
        if (p == 4) hipLaunchKernelGGL(chk_gemm2, dim3(16), dim3(256), 0, stream, a);
        if (p == 5) hipLaunchKernelGGL(chk_gemm3, dim3(16), dim3(256), 0, stream, a);
        if (p == 6) hipLaunchKernelGGL(chk_topk, dim3(128), dim3(256), 0, stream, a);
        if (p == 7) { hipLaunchKernelGGL(chk_gather, dim3(32), dim3(256), 0, stream, a); hipLaunchKernelGGL(chk_poison, dim3(1024), dim3(256), 0, stream, a); }
#endif
    }
#endif
    const hipError_t le = hipPeekAtLastError();
    if (le != hipSuccess) fprintf(stderr, "kernel_launch: launch failed: %s\n", hipGetErrorName(le));
}
```
